# Optimizing an MI355X kernel written in HIP

```python
import math
import numpy as np
import jax
import jax.numpy as jnp
from jax import lax

D_MODEL = 1024
BATCH = 4
SEQ = 4096
DEPTH = 4

F32 = jnp.float32
PLE_DIM = 256
ROPE_THETA = 500000.0
HEAD_DIM = 64
ROT_DIM = HEAD_DIM // 4
EPS = 1e-6
QBLK = 128
NEG = -1e30
BIG = 1e30

A_HEADS = 8
A_KV_GROUPS = 2
A_GQA = A_HEADS // A_KV_GROUPS
A_WIDTH = A_HEADS * HEAD_DIM
CMP_LEN = 32
CMP_STRIDE = 16
CMP_HID = 256
SLC_LEN = 64
SLC_TOPK = 16
WIN = 512

B_HEADS = 8
Q_LORA = 384
KV_LORA = 128
QK_NOPE = 64
QK_ROPE = 32
V_DIM = 64
B_WIDTH = B_HEADS * V_DIM

C_PAIRS = ((128, 1), (512, 4), (2048, 16))
C_GROUPS = len(C_PAIRS)
C_HEADS = 8
C_WIDTH = C_HEADS * HEAD_DIM

IN_SIZES = (
    A_WIDTH,
    6 * A_KV_GROUPS * HEAD_DIM,
    3 * A_HEADS,
    A_WIDTH,
    Q_LORA,
    KV_LORA,
    QK_ROPE,
    B_WIDTH,
    C_GROUPS * 3 * C_WIDTH,
    C_WIDTH,
    3 * D_MODEL,
)
D_IN = sum(IN_SIZES)
IN_OFFSETS = tuple(int(v) for v in np.cumsum(IN_SIZES)[:-1])

kernel_name = "hybrid_nsa_mla_dilated_trunk"


def rms_norm(x, g):
    xf = x.astype(F32)
    y = xf * lax.rsqrt(jnp.mean(xf * xf, axis=-1, keepdims=True) + EPS)
    return (y * g.astype(F32)).astype(x.dtype)


def rope_tables(positions, dim):
    inv = ROPE_THETA ** (-jnp.arange(0, dim, 2, dtype=F32) / dim)
    ang = positions.astype(F32)[..., None] * inv
    return jnp.cos(ang), jnp.sin(ang)


def apply_rope(x, cos, sin, dim):
    xf = x.astype(F32)
    half = dim // 2
    c = cos[:, :, None, :]
    s = sin[:, :, None, :]
    x1 = xf[..., :half]
    x2 = xf[..., half:dim]
    out = jnp.concatenate([x1 * c - x2 * s, x2 * c + x1 * s, xf[..., dim:]], axis=-1)
    return out.astype(x.dtype)


def banded_attention(q, k, v, max_dist):
    n, L, hkv, g, d = q.shape
    nblk = -(-L // QBLK)
    lp = nblk * QBLK
    nb = -(-max_dist // QBLK)
    pad = lp - L
    qp = jnp.pad(q.astype(F32), ((0, 0), (0, pad), (0, 0), (0, 0), (0, 0))).reshape(n, nblk, QBLK, hkv, g, d)
    kp = jnp.pad(k.astype(F32), ((0, 0), (nb * QBLK, pad), (0, 0), (0, 0)))
    vp = jnp.pad(v.astype(F32), ((0, 0), (nb * QBLK, pad), (0, 0), (0, 0)))
    kb = jnp.concatenate([kp[:, sft * QBLK: sft * QBLK + lp].reshape(n, nblk, QBLK, hkv, d) for sft in range(nb + 1)], axis=2)
    vb = jnp.concatenate([vp[:, sft * QBLK: sft * QBLK + lp].reshape(n, nblk, QBLK, hkv, d) for sft in range(nb + 1)], axis=2)
    qpos = jnp.arange(lp).reshape(nblk, QBLK)
    kpos = (jnp.arange(nblk)[:, None] - nb) * QBLK + jnp.arange((nb + 1) * QBLK)[None, :]
    rel = qpos[:, :, None] - kpos[:, None, :]
    valid = (rel >= 0) & (rel <= max_dist) & (kpos[:, None, :] >= 0)
    sc = jnp.einsum('nbqhgd,nbkhd->nbhgqk', qp, kb) * (d ** -0.5)
    sc = jnp.where(valid[None, :, None, None], sc, NEG)
    m = jnp.max(sc, axis=-1, keepdims=True)
    e = jnp.exp(sc - m)
    den = jnp.sum(e, axis=-1, keepdims=True)
    out = jnp.einsum('nbhgqk,nbkhd->nbqhgd', e / den, vb).reshape(n, lp, hkv, g, d)[:, :L]
    lse = (m + jnp.log(den))[..., 0]
    lse = lse.transpose(0, 1, 4, 2, 3).reshape(n, lp, hkv, g)[:, :L]
    return out, lse


def causal_block_attention(q, k, v):
    b, s, h, dqk = q.shape
    dv = v.shape[-1]
    nq = s // QBLK
    kf = k.astype(F32)
    vf = v.astype(F32)
    scale = dqk ** -0.5
    kpos = jnp.arange(s)
    qs = q.astype(F32).reshape(b, nq, QBLK, h, dqk).swapaxes(0, 1)
    ps = jnp.arange(s).reshape(nq, QBLK)

    def block(args):
        qi, pi = args
        sc = jnp.einsum('bqhd,bkhd->bhqk', qi, kf) * scale
        sc = jnp.where(kpos[None, :] <= pi[:, None], sc, NEG)
        return jnp.einsum('bhqk,bkhd->bqhd', jax.nn.softmax(sc, axis=-1), vf)

    o = lax.map(block, (qs, ps))
    return o.swapaxes(0, 1).reshape(b, s, h, dv)


def nsa_compress(x, pe, w1, w2):
    b, s, h, d = x.shape
    nch = s // CMP_STRIDE
    r = CMP_LEN // CMP_STRIDE
    nc = nch - r + 1
    ch = x.reshape(b, nch, CMP_STRIDE, h, d)
    blocks = jnp.concatenate([ch[:, i:i + nc] for i in range(r)], axis=2)
    blocks = blocks + pe[None, None, :, None, :].astype(x.dtype)
    flat = blocks.transpose(0, 1, 3, 2, 4).reshape(b, nc, h, CMP_LEN * d)
    return jax.nn.silu(flat @ w1) @ w2


def nsa_selected(q, k, v, idx, scale):
    b, s, hkv, g, d = q.shape
    ns = s // SLC_LEN
    nq = s // QBLK
    n = idx.shape[-1]
    kb = k.astype(F32).reshape(b, ns, SLC_LEN, hkv, d).transpose(0, 3, 1, 2, 4)
    vb = v.astype(F32).reshape(b, ns, SLC_LEN, hkv, d).transpose(0, 3, 1, 2, 4)
    bi = jnp.arange(b)[:, None, None, None]
    hi = jnp.arange(hkv)[None, None, :, None]
    off = jnp.arange(SLC_LEN)

    def block(args):
        qi, ii, ti = args
        kg = kb[bi, hi, ii]
        vg = vb[bi, hi, ii]
        sc = jnp.einsum('bqhgd,bqhnkd->bqhgnk', qi, kg) * scale
        kpos = ii[..., None] * SLC_LEN + off
        ok = (kpos <= ti[None, :, None, None, None])[:, :, :, None]
        sc = jnp.where(ok, sc, NEG).reshape(b, QBLK, hkv, g, n * SLC_LEN)
        pr = jax.nn.softmax(sc, axis=-1).reshape(b, QBLK, hkv, g, n, SLC_LEN)
        return jnp.einsum('bqhgnk,bqhnkd->bqhgd', pr, vg)

    qs = q.reshape(b, nq, QBLK, hkv, g, d).swapaxes(0, 1)
    iss = idx.reshape(b, nq, QBLK, hkv, n).swapaxes(0, 1)
    ts = jnp.arange(s).reshape(nq, QBLK)
    o = lax.map(block, (qs, iss, ts))
    return o.swapaxes(0, 1).reshape(b, s, hkv, g, d)


def nsa_mixer(a_q, a_kv, a_gate, cos, sin, cmp_pe, cmp_w1, cmp_w2):
    b, s, _ = a_q.shape
    d, hkv, g = HEAD_DIM, A_KV_GROUPS, A_GQA
    scale = d ** -0.5
    q = apply_rope(a_q.reshape(b, s, A_HEADS, d), cos, sin, ROT_DIM).reshape(b, s, hkv, g, d).astype(F32)
    kv = a_kv.reshape(b, s, 6, hkv, d)
    k_cmp = apply_rope(kv[:, :, 0], cos, sin, ROT_DIM)
    k_slc = apply_rope(kv[:, :, 2], cos, sin, ROT_DIM)
    k_win = apply_rope(kv[:, :, 4], cos, sin, ROT_DIM)
    v_cmp, v_slc, v_win = kv[:, :, 1], kv[:, :, 3], kv[:, :, 5]
    t = jnp.arange(s)
    kc = nsa_compress(k_cmp, cmp_pe[0], cmp_w1[0], cmp_w2[0]).astype(F32)
    vc = nsa_compress(v_cmp, cmp_pe[1], cmp_w1[1], cmp_w2[1]).astype(F32)
    nc = kc.shape[1]
    c_end = jnp.arange(nc) * CMP_STRIDE + CMP_LEN - 1
    cv = (c_end[None, :] <= t[:, None])[None, :, None, None, :]
    sc = jnp.einsum('bshgd,bchd->bshgc', q, kc) * scale
    pc = jax.nn.softmax(jnp.where(cv, sc, NEG), axis=-1) * cv
    o_cmp = jnp.einsum('bshgc,bchd->bshgd', pc, vc)
    ns = s // SLC_LEN
    cs = jnp.arange(nc)[:, None] * CMP_STRIDE
    js = jnp.arange(ns)[None, :] * SLC_LEN
    overlap = jnp.clip(jnp.minimum(cs + CMP_LEN, js + SLC_LEN) - jnp.maximum(cs, js), 0, None).astype(F32) / CMP_LEN
    imp = jnp.einsum('bshgc,cj->bshj', pc, overlap)
    cur = t // SLC_LEN
    jj = jnp.arange(ns)
    valid = (jj[None, :] <= cur[:, None])[None, :, None, :]
    forced = ((jj[None, :] == 0) | (jj[None, :] == cur[:, None]) | (jj[None, :] == cur[:, None] - 1))[None, :, None, :]
    score = jnp.where(forced, BIG, jnp.where(valid, imp, NEG))
    _, idx = lax.top_k(score, min(SLC_TOPK, ns))
    o_slc = nsa_selected(q, k_slc, v_slc, idx, scale)
    o_win, _ = banded_attention(q, k_win, v_win, WIN - 1)
    gt = jax.nn.sigmoid(a_gate.astype(F32)).reshape(b, s, hkv, g, 3)
    o = gt[..., 0:1] * o_cmp + gt[..., 1:2] * o_slc + gt[..., 2:3] * o_win
    return o.reshape(b, s, A_WIDTH)


def mla_mixer(b_cq, b_ckv, b_kr, cos, sin, g_q, w_uq, g_kv, w_ukv):
    b, s, _ = b_cq.shape
    q = (rms_norm(b_cq, g_q) @ w_uq).reshape(b, s, B_HEADS, QK_NOPE + QK_ROPE)
    q = jnp.concatenate([q[..., :QK_NOPE], apply_rope(q[..., QK_NOPE:], cos, sin, QK_ROPE)], axis=-1)
    kvu = (rms_norm(b_ckv, g_kv) @ w_ukv).reshape(b, s, B_HEADS, QK_NOPE + V_DIM)
    k_rope = apply_rope(b_kr[:, :, None, :], cos, sin, QK_ROPE)
    k = jnp.concatenate([kvu[..., :QK_NOPE], jnp.broadcast_to(k_rope, (b, s, B_HEADS, QK_ROPE))], axis=-1)
    v = kvu[..., QK_NOPE:]
    return causal_block_attention(q, k, v).reshape(b, s, B_WIDTH)


def dilated_mixer(c_qkv, cos, sin):
    b, s, _ = c_qkv.shape
    h, d = C_HEADS, HEAD_DIM
    qkv = c_qkv.reshape(b, s, C_GROUPS, 3, h, d)
    outs, lses = [], []
    for gi, (window, dil) in enumerate(C_PAIRS):
        L = s // dil
        q = apply_rope(qkv[:, :, gi, 0], cos, sin, ROT_DIM)
        k = apply_rope(qkv[:, :, gi, 1], cos, sin, ROT_DIM)
        v = qkv[:, :, gi, 2]

        def sub(z):
            return z.reshape(b, L, dil, h, d).transpose(0, 2, 1, 3, 4).reshape(b * dil, L, h, d)

        o, lse = banded_attention(sub(q)[:, :, :, None], sub(k), sub(v), window // dil)
        outs.append(o[:, :, :, 0].reshape(b, dil, L, h, d).transpose(0, 2, 1, 3, 4).reshape(b, s, h, d))
        lses.append(lse[:, :, :, 0].reshape(b, dil, L, h).transpose(0, 2, 1, 3).reshape(b, s, h))
    wts = jax.nn.softmax(jnp.stack(lses, axis=-1), axis=-1)
    o = jnp.einsum('bshg,gbshd->bshd', wts, jnp.stack(outs, axis=0))
    return o.reshape(b, s, C_WIDTH)


def setup_inputs(seed: int = 0) -> dict:
    key = jax.random.key(seed)
    ks = jax.random.split(key, 24)
    nrm = lambda k, shape, scale: jax.random.normal(k, shape, F32) * scale
    x = nrm(ks[0], (BATCH, SEQ, D_MODEL), 1.0)
    p = nrm(ks[1], (DEPTH, BATCH, SEQ, PLE_DIM), 1.0)
    start = jax.random.randint(ks[2], (BATCH, 1), 0, 8192, dtype=jnp.int32)
    positions = (start + jnp.arange(SEQ, dtype=jnp.int32)[None, :]).astype(jnp.int32)
    return {
        "x": x,
        "p": p,
        "positions": positions,
        "g_pre": 1.0 + nrm(ks[3], (DEPTH, D_MODEL), 0.01),
        "g_post": 1.0 + nrm(ks[4], (DEPTH, D_MODEL), 0.01),
        "w_in": nrm(ks[5], (DEPTH, D_MODEL, D_IN), D_MODEL ** -0.5),
        "nsa_cmp_pe": nrm(ks[6], (DEPTH, 2, CMP_LEN, HEAD_DIM), 0.02),
        "nsa_cmp_w1": nrm(ks[7], (DEPTH, 2, CMP_LEN * HEAD_DIM, CMP_HID), (CMP_LEN * HEAD_DIM) ** -0.5),
        "nsa_cmp_w2": nrm(ks[8], (DEPTH, 2, CMP_HID, HEAD_DIM), CMP_HID ** -0.5),
        "w_a": nrm(ks[9], (DEPTH, A_WIDTH, D_MODEL), A_WIDTH ** -0.5),
        "mla_g_q": 1.0 + nrm(ks[10], (DEPTH, Q_LORA), 0.01),
        "mla_w_uq": nrm(ks[11], (DEPTH, Q_LORA, B_HEADS * (QK_NOPE + QK_ROPE)), Q_LORA ** -0.5),
        "mla_g_kv": 1.0 + nrm(ks[12], (DEPTH, KV_LORA), 0.01),
        "mla_w_ukv": nrm(ks[13], (DEPTH, KV_LORA, B_HEADS * (QK_NOPE + V_DIM)), KV_LORA ** -0.5),
        "w_b": nrm(ks[14], (DEPTH, B_WIDTH, D_MODEL), B_WIDTH ** -0.5),
        "w_c": nrm(ks[15], (DEPTH, C_WIDTH, D_MODEL), C_WIDTH ** -0.5),
        "w_out": nrm(ks[16], (DEPTH, D_MODEL, D_MODEL), D_MODEL ** -0.5),
        "w_ple": nrm(ks[17], (DEPTH, PLE_DIM, D_MODEL), 0.5 * PLE_DIM ** -0.5),
        "w_plg": nrm(ks[18], (DEPTH, D_MODEL, D_MODEL), D_MODEL ** -0.5),
    }


def reference(x, p, positions, g_pre, g_post, w_in, nsa_cmp_pe, nsa_cmp_w1, nsa_cmp_w2, w_a,
              mla_g_q, mla_w_uq, mla_g_kv, mla_w_ukv, w_b, w_c, w_out, w_ple, w_plg):
    cos_p, sin_p = rope_tables(positions, ROT_DIM)
    cos_m, sin_m = rope_tables(positions, QK_ROPE)
    for i in range(DEPTH):
        h = rms_norm(x, g_pre[i])
        u = h @ w_in[i]
        (a_q, a_kv, a_g, a_z, b_cq, b_ckv, b_kr, b_z, c_qkv, c_z, m_g) = jnp.split(u, IN_OFFSETS, axis=-1)
        o_a = nsa_mixer(a_q, a_kv, a_g, cos_p, sin_p, nsa_cmp_pe[i], nsa_cmp_w1[i], nsa_cmp_w2[i]).astype(x.dtype)
        o_b = mla_mixer(b_cq, b_ckv, b_kr, cos_m, sin_m, mla_g_q[i], mla_w_uq[i], mla_g_kv[i], mla_w_ukv[i]).astype(x.dtype)
        o_c = dilated_mixer(c_qkv, cos_p, sin_p).astype(x.dtype)
        y_a = (o_a * jax.nn.silu(a_z)) @ w_a[i]
        y_b = (o_b * jax.nn.silu(b_z)) @ w_b[i]
        y_c = (o_c * jax.nn.silu(c_z)) @ w_c[i]
        gm = jax.nn.sigmoid(m_g).reshape(m_g.shape[:-1] + (3, D_MODEL))
        y = (gm[..., 0, :] * y_a + gm[..., 1, :] * y_b + gm[..., 2, :] * y_c) @ w_out[i]
        x = x + rms_norm(y, g_post[i])
        x = x + jax.nn.sigmoid(x @ w_plg[i]) * (p[i] @ w_ple[i])
    return x
```

```cpp
#include <hip/hip_runtime.h>
#include <stdint.h>
#include <math.h>

typedef unsigned short bf16_t;
#define DI __device__ __forceinline__

constexpr int NB = 4, S = 4096, T = NB * S, D = 1024, DEPTH = 4;
constexpr int DIN = 11064;
constexpr int A_AQ = 0, A_AKV = 512, A_BCQ = 1280, A_BCKV = 1664, A_BKR = 1792, A_CQKV = 1824, LDA = 6432;
constexpr int B_ZA = 0, B_ZB = 512, B_ZC = 1024, B_MG = 1536, B_GATE = 4608, LDB = 4640;
constexpr int NC = 255;
constexpr int CROWS = 2048;

constexpr size_t al256(size_t x) { return (x + 255) & ~(size_t)255; }
constexpr size_t WS_CTL = 0;
constexpr size_t WS_UA = 1 << 20;
constexpr size_t WS_UB = WS_UA + al256((size_t)T * LDA * 2);
constexpr size_t WS_H = WS_UB + al256((size_t)T * LDB * 2);
constexpr size_t WS_O7 = WS_H + al256((size_t)T * 1024 * 2);
constexpr size_t O7_STRIDE = (size_t)T * 512;
constexpr size_t WS_LSE = WS_O7 + al256(7 * O7_STRIDE * 2);
constexpr size_t WS_QM = WS_LSE + al256((size_t)3 * T * 8 * 4);
constexpr size_t WS_KVU = WS_QM + al256((size_t)T * 768 * 2);
constexpr size_t WS_FLAT = WS_KVU + al256((size_t)T * 1024 * 2);
constexpr size_t WS_HID = WS_FLAT + al256((size_t)2 * CROWS * 2048 * 2);
constexpr size_t WS_KC = WS_HID + al256((size_t)2 * CROWS * 256 * 4);
constexpr size_t WS_SEL = WS_KC + al256((size_t)2 * CROWS * 64 * 2);
constexpr size_t WS_TAB = WS_SEL + al256((size_t)T * 2 * 8);
constexpr size_t WS_END = WS_TAB + al256((size_t)T * 48 * 4);
constexpr size_t WS_YMIX = WS_UA;
constexpr size_t WS_YMIXB = WS_YMIX + (size_t)T * 1024 * 4;
constexpr size_t WS_Y2 = WS_YMIXB + (size_t)T * 1024 * 2;
constexpr size_t WS_E = WS_YMIX;
static_assert(WS_Y2 + (size_t)T * 1024 * 4 <= WS_UB, "alias region fits in UA");
constexpr size_t WS_QN = WS_H;
constexpr size_t WS_KVN = WS_H + (size_t)T * 384 * 2;

DI float bf2f(bf16_t v) { return __uint_as_float(((unsigned)v) << 16); }
DI bf16_t f2bf(float f) { unsigned u = __float_as_uint(f); u += 0x7fffu + ((u >> 16) & 1u); return (bf16_t)(u >> 16); }
DI float sigm(float x) { return 1.f / (1.f + __expf(-x)); }
DI float wave_sum(float v) { for (int o = 32; o > 0; o >>= 1) v += __shfl_xor(v, o); return v; }
DI float wave_max(float v) { for (int o = 32; o > 0; o >>= 1) v = fmaxf(v, __shfl_xor(v, o)); return v; }
DI float ldf(const float* p) { return *p; }
DI float ldf(const bf16_t* p) { return bf2f(*p); }

__global__ void k_tables(const int* pos, float* tab) {
    int i = blockIdx.x * blockDim.x + threadIdx.x;
    if (i >= T * 24) return;
    int t = i / 24, j = i % 24;
    float p = (float)pos[t];
    if (j < 8) {
        float inv = powf(500000.0f, -(float)(2 * j) / 16.0f);
        float a = p * inv;
        tab[(size_t)t * 48 + j] = cosf(a); tab[(size_t)t * 48 + 8 + j] = sinf(a);
    } else {
        int jj = j - 8;
        float inv = powf(500000.0f, -(float)(2 * jj) / 32.0f);
        float a = p * inv;
        tab[(size_t)t * 48 + 16 + jj] = cosf(a); tab[(size_t)t * 48 + 32 + jj] = sinf(a);
    }
}

template <typename TIN>
__global__ void k_rmsnorm(const TIN* in, int ld_in, int ncols, const float* g, bf16_t* out, int ld_out, int nrows) {
    int row = blockIdx.x * (blockDim.x >> 6) + (threadIdx.x >> 6), lane = threadIdx.x & 63;
    if (row >= nrows) return;
    const TIN* r = in + (size_t)row * ld_in;
    float ss = 0.f;
    for (int c = lane; c < ncols; c += 64) { float v = ldf(r + c); ss += v * v; }
    ss = wave_sum(ss);
    float rs = rsqrtf(ss / (float)ncols + 1e-6f);
    for (int c = lane; c < ncols; c += 64) out[(size_t)row * ld_out + c] = f2bf(ldf(r + c) * rs * g[c]);
}

__global__ void k_post(float* x, const float* y2, const float* g, bf16_t* xb) {
    int row = blockIdx.x * (blockDim.x >> 6) + (threadIdx.x >> 6), lane = threadIdx.x & 63;
    if (row >= T) return;
    const float* r = y2 + (size_t)row * D;
    float ss = 0.f;
    for (int c = lane; c < D; c += 64) { float v = r[c]; ss += v * v; }
    ss = wave_sum(ss);
    float rs = rsqrtf(ss / (float)D + 1e-6f);
    for (int c = lane; c < D; c += 64) { float v = x[(size_t)row * D + c] + r[c] * rs * g[c]; x[(size_t)row * D + c] = v; xb[(size_t)row * D + c] = f2bf(v); }
}

struct EpiU { bf16_t* ua; bf16_t* ub;
    DI void operator()(int r, int c, float v) const {
        int buf, col;
        if (c < 512) { buf = 0; col = A_AQ + c; }
        else if (c < 1280) { buf = 0; col = A_AKV + c - 512; }
        else if (c < 1304) { buf = 1; col = B_GATE + c - 1280; }
        else if (c < 1816) { buf = 1; col = B_ZA + c - 1304; }
        else if (c < 2200) { buf = 0; col = A_BCQ + c - 1816; }
        else if (c < 2328) { buf = 0; col = A_BCKV + c - 2200; }
        else if (c < 2360) { buf = 0; col = A_BKR + c - 2328; }
        else if (c < 2872) { buf = 1; col = B_ZB + c - 2360; }
        else if (c < 7480) { buf = 0; col = A_CQKV + c - 2872; }
        else if (c < 7992) { buf = 1; col = B_ZC + c - 7480; }
        else { buf = 1; col = B_MG + c - 7992; }
        if (buf == 0) ua[(size_t)r * LDA + col] = f2bf(v); else ub[(size_t)r * LDB + col] = f2bf(v);
    } };
struct EpiBf { bf16_t* c; int ldc; int pad; DI void operator()(int r, int col, float v) const { c[(size_t)r * ldc + col] = f2bf(v); } };
struct EpiF { float* c; int ldc; int pad; DI void operator()(int r, int col, float v) const { c[(size_t)r * ldc + col] = v; } };
struct EpiSilu { float* c; int ldc; int pad; DI void operator()(int r, int col, float v) const { c[(size_t)r * ldc + col] = v * sigm(v); } };
struct EpiYmix { float* ymix; bf16_t* ymixb; const bf16_t* ub; int x; int pad;
    DI void operator()(int r, int col, float v) const {
        float gsc = sigm(bf2f(ub[(size_t)r * LDB + B_MG + x * 1024 + col]));
        float acc = gsc * v;
        if (x > 0) acc += ymix[(size_t)r * D + col];
        ymix[(size_t)r * D + col] = acc;
        if (x == 2) ymixb[(size_t)r * D + col] = f2bf(acc);
    } };
struct EpiPlg { float* x; const float* e; DI void operator()(int r, int col, float v) const { x[(size_t)r * D + col] += sigm(v) * e[(size_t)r * D + col]; } };

template <typename TA, class Epi>
__global__ __launch_bounds__(256) void k_gemm(const TA* A, int lda, const float* Bm, int ldb, int M, int N, int K, Epi epi) {
    __shared__ float As[16][68];
    __shared__ float Bs[16][68];
    const int tid = threadIdx.x, tx = tid & 15, ty = tid >> 4;
    const int m0 = blockIdx.y * 64, n0 = blockIdx.x * 64;
    float acc[4][4] = {};
    for (int k0 = 0; k0 < K; k0 += 16) {
        for (int e = tid; e < 1024; e += 256) { int r = e >> 4, c = e & 15; As[c][r] = ldf(A + (size_t)(m0 + r) * lda + k0 + c); }
        for (int e = tid; e < 1024; e += 256) { int r = e >> 6, c = e & 63; int n = n0 + c; Bs[r][c] = (n < N) ? Bm[(size_t)(k0 + r) * ldb + n] : 0.f; }
        __syncthreads();
#pragma unroll
        for (int k = 0; k < 16; ++k) {
            float a[4], b[4];
#pragma unroll
            for (int i = 0; i < 4; ++i) { a[i] = As[k][ty * 4 + i]; b[i] = Bs[k][tx * 4 + i]; }
#pragma unroll
            for (int i = 0; i < 4; ++i)
#pragma unroll
                for (int j = 0; j < 4; ++j) acc[i][j] += a[i] * b[j];
        }
        __syncthreads();
    }
#pragma unroll
    for (int i = 0; i < 4; ++i)
#pragma unroll
        for (int j = 0; j < 4; ++j) { int r = m0 + ty * 4 + i, c = n0 + tx * 4 + j; if (r < M && c < N) epi(r, c, acc[i][j]); }
}

__global__ void k_rope_ua(bf16_t* ua, const float* tab) {
    size_t i = (size_t)blockIdx.x * blockDim.x + threadIdx.x;
    if (i >= (size_t)T * 512) return;
    int t = (int)(i / 512), w = (int)(i % 512);
    bf16_t* row = ua + (size_t)t * LDA;
    const float* tb = tab + (size_t)t * 48;
    if (w < 496) {
        int item = w / 8, j = w % 8, base;
        if (item < 8) base = A_AQ + item * 64;
        else if (item < 14) { int q = item - 8; int jj = (q / 2) * 2, hk = q % 2; base = A_AKV + jj * 128 + hk * 64; }
        else { int q = item - 14; int gi = q / 16, wh = (q / 8) % 2, h = q % 8; base = A_CQKV + gi * 1536 + wh * 512 + h * 64; }
        float c = tb[j], s = tb[8 + j];
        float x1 = bf2f(row[base + j]), x2 = bf2f(row[base + 8 + j]);
        row[base + j] = f2bf(x1 * c - x2 * s); row[base + 8 + j] = f2bf(x2 * c + x1 * s);
    } else {
        int j = w - 496;
        float c = tb[16 + j], s = tb[32 + j];
        float x1 = bf2f(row[A_BKR + j]), x2 = bf2f(row[A_BKR + 16 + j]);
        row[A_BKR + j] = f2bf(x1 * c - x2 * s); row[A_BKR + 16 + j] = f2bf(x2 * c + x1 * s);
    }
}
__global__ void k_rope_qm(bf16_t* qm, const float* tab) {
    size_t i = (size_t)blockIdx.x * blockDim.x + threadIdx.x;
    if (i >= (size_t)T * 128) return;
    int t = (int)(i / 128), w = (int)(i % 128), h = w / 16, j = w % 16;
    bf16_t* p = qm + (size_t)t * 768 + h * 96 + 64;
    const float* tb = tab + (size_t)t * 48;
    float c = tb[16 + j], s = tb[32 + j];
    float x1 = bf2f(p[j]), x2 = bf2f(p[16 + j]);
    p[j] = f2bf(x1 * c - x2 * s); p[16 + j] = f2bf(x2 * c + x1 * s);
}

__global__ void k_flat(const bf16_t* ua, const float* pe  , bf16_t* flat) {
    size_t i = (size_t)blockIdx.x * blockDim.x + threadIdx.x;
    if (i >= (size_t)2 * CROWS * 2048) return;
    int kv = (int)(i / ((size_t)CROWS * 2048));
    size_t rem = i % ((size_t)CROWS * 2048);
    int row = (int)(rem / 2048), col = (int)(rem % 2048);
    float v = 0.f;
    if (row < NB * NC * 2) {
        int hk = row & 1, bc = row >> 1, b = bc / NC, c = bc % NC, l = col >> 6, d = col & 63;
        int tok = b * S + 16 * c + l;
        v = bf2f(ua[(size_t)tok * LDA + A_AKV + kv * 128 + hk * 64 + d]) + pe[(kv * 32 + l) * 64 + d];
    }
    flat[i] = f2bf(v);
}

DI float dot8(const float* q, uint4 w) {
    float r = q[0] * __uint_as_float(w.x << 16) + q[1] * __uint_as_float(w.x & 0xffff0000u);
    r += q[2] * __uint_as_float(w.y << 16) + q[3] * __uint_as_float(w.y & 0xffff0000u);
    r += q[4] * __uint_as_float(w.z << 16) + q[5] * __uint_as_float(w.z & 0xffff0000u);
    r += q[6] * __uint_as_float(w.w << 16) + q[7] * __uint_as_float(w.w & 0xffff0000u);
    return r;
}
__global__ __launch_bounds__(256) void k_topk(const bf16_t* ua, const bf16_t* kc  , unsigned long long* sel) {
    __shared__ float qs[4][64];
    const int wv = threadIdx.x >> 6, lane = threadIdx.x & 63;
    const int item = blockIdx.x * 4 + wv;
    const int t = item >> 1, hk = item & 1, b = t / S, s = t % S;
    float mine = 0.f;
    for (int g = 0; g < 4; ++g) {
        __syncthreads();
        qs[wv][lane] = bf2f(ua[(size_t)t * LDA + A_AQ + (hk * 4 + g) * 64 + lane]);
        __syncthreads();
        float sc[4]; bool ok[4]; float mx = -INFINITY;
#pragma unroll
        for (int e = 0; e < 4; ++e) {
            int c = lane * 4 + e;
            ok[e] = (c < NC) && (16 * c + 31 <= s);
            float dsum = 0.f;
            if (ok[e]) { const bf16_t* kr = kc + ((size_t)(b * NC + c) * 2 + hk) * 64;
#pragma unroll
                for (int d8 = 0; d8 < 8; ++d8) dsum += dot8(&qs[wv][d8 * 8], *(const uint4*)(kr + d8 * 8)); }
            sc[e] = ok[e] ? dsum * 0.125f : -INFINITY;
            mx = fmaxf(mx, sc[e]);
        }
        mx = wave_max(mx);
        float p[4], sum = 0.f;
#pragma unroll
        for (int e = 0; e < 4; ++e) { p[e] = ok[e] ? __expf(sc[e] - mx) : 0.f; sum += p[e]; }
        sum = wave_sum(sum);
        float inv = sum > 0.f ? 1.f / sum : 0.f;
#pragma unroll
        for (int e = 0; e < 4; ++e) p[e] *= inv;
        float carry = 0.5f * p[3];
        float up = __shfl_up(carry, 1); if (lane == 0) up = 0.f;
        mine += p[0] + p[1] + p[2] + 0.5f * p[3] + up;
    }
    const int cur = s >> 6;
    const bool valid = lane <= cur;
    const bool forced = (lane == 0) || (lane == cur) || (lane == cur - 1);
    const float score = forced ? 1e30f : (valid ? mine : -1e30f);
    int rank = 0;
    for (int jj = 0; jj < 64; ++jj) { float v = __shfl(score, jj); rank += (v > score || (v == score && jj < lane)) ? 1 : 0; }
    unsigned long long m = __ballot((rank < 16) && valid);
    if (lane == 0) sel[(size_t)t * 2 + hk] = m;
}

struct AttnArgs { const bf16_t* ua; const bf16_t* kc; const bf16_t* qm; const bf16_t* kvu; const unsigned long long* sel; bf16_t* out; float* lse; };
template <int MODE>
__global__ __launch_bounds__(128) void k_attn(AttnArgs a) {
    __shared__ float sc_s[2][4096];
    __shared__ float q_s[2][96];
    const int wv = threadIdx.x >> 6, lane = threadIdx.x & 63;
    const int item = blockIdx.x * 2 + wv;
    const int t = item >> 3, hq = item & 7, b = t / S, s = t % S;
    constexpr int DQK = (MODE == 3) ? 96 : 64;
    const float scale = (MODE == 3) ? 0.10206207261596577f : 0.125f;
    float* sc = sc_s[wv]; float* q = q_s[wv];
    if (MODE == 3) { q[lane] = bf2f(a.qm[(size_t)t * 768 + hq * 96 + lane]); if (lane < 32) q[64 + lane] = bf2f(a.qm[(size_t)t * 768 + hq * 96 + 64 + lane]); }
    else if (MODE <= 2) q[lane] = bf2f(a.ua[(size_t)t * LDA + A_AQ + hq * 64 + lane]);
    else q[lane] = bf2f(a.ua[(size_t)t * LDA + A_CQKV + (MODE - 4) * 1536 + hq * 64 + lane]);
    __syncthreads();
    const int hk = hq >> 2;
    const int dil = (MODE == 5) ? 4 : (MODE == 6) ? 16 : 1;
    int nk;
    if (MODE == 0) nk = NC; else if (MODE == 1) nk = ((s >> 6) + 1) * 64; else if (MODE == 2) nk = 512; else if (MODE == 3) nk = s + 1; else nk = 129;
    unsigned long long selm = 0ull;
    if (MODE == 1) selm = a.sel[(size_t)t * 2 + hk];
    auto keyinfo = [&](int i, bool& ok, const bf16_t*& kp, const bf16_t*& kp2, const bf16_t*& vp) {
        kp2 = nullptr;
        if (MODE == 0) { ok = (16 * i + 31 <= s); size_t r = ((size_t)(b * NC + i) * 2 + hk) * 64; kp = a.kc + r; vp = a.kc + (size_t)CROWS * 64 + r; }
        else if (MODE == 1) { ok = (i <= s) && ((selm >> (i >> 6)) & 1ull); size_t r = (size_t)(b * S + i) * LDA + A_AKV + hk * 64; kp = a.ua + r + 2 * 128; vp = a.ua + r + 3 * 128; }
        else if (MODE == 2) { int kt = s - 511 + i; ok = kt >= 0; if (!ok) kt = 0; size_t r = (size_t)(b * S + kt) * LDA + A_AKV + hk * 64; kp = a.ua + r + 4 * 128; vp = a.ua + r + 5 * 128; }
        else if (MODE == 3) { ok = true; size_t r = (size_t)(b * S + i); kp = a.kvu + r * 1024 + hq * 128; vp = kp + 64; kp2 = a.ua + r * LDA + A_BKR; }
        else { int kt = s - dil * i; ok = kt >= 0; if (!ok) kt = 0; size_t r = (size_t)(b * S + kt) * LDA + A_CQKV + (MODE - 4) * 1536 + hq * 64; kp = a.ua + r + 512; vp = a.ua + r + 1024; }
    };
    float mx = -INFINITY;
    for (int i = lane; i < nk; i += 64) {
        bool ok; const bf16_t *kp, *kp2, *vp; keyinfo(i, ok, kp, kp2, vp);
        float v = -INFINITY;
        if (ok) {
            float dsum = 0.f;
#pragma unroll
            for (int d8 = 0; d8 < 8; ++d8) dsum += dot8(q + d8 * 8, *(const uint4*)(kp + d8 * 8));
            if (MODE == 3) {
#pragma unroll
                for (int d8 = 0; d8 < 4; ++d8) dsum += dot8(q + 64 + d8 * 8, *(const uint4*)(kp2 + d8 * 8)); }
            v = dsum * scale;
        }
        sc[i] = v; mx = fmaxf(mx, v);
    }
    mx = wave_max(mx);
    float sum = 0.f;
    for (int i = lane; i < nk; i += 64) { float v = sc[i]; float e = (v == -INFINITY) ? 0.f : __expf(v - mx); sc[i] = e; sum += e; }
    sum = wave_sum(sum);
    __syncthreads();
    const int kg = lane >> 3, dc = lane & 7;
    float acc8[8];
#pragma unroll
    for (int j = 0; j < 8; ++j) acc8[j] = 0.f;
    for (int i0 = 0; i0 < nk; i0 += 8) {
        const int i = i0 + kg;
        const float p = (i < nk) ? sc[i] : 0.f;
        if (p != 0.f) {
            bool ok; const bf16_t *kp, *kp2, *vp; keyinfo(i, ok, kp, kp2, vp);
            const uint4 w = *(const uint4*)(vp + dc * 8);
            acc8[0] += p * __uint_as_float(w.x << 16); acc8[1] += p * __uint_as_float(w.x & 0xffff0000u);
            acc8[2] += p * __uint_as_float(w.y << 16); acc8[3] += p * __uint_as_float(w.y & 0xffff0000u);
            acc8[4] += p * __uint_as_float(w.z << 16); acc8[5] += p * __uint_as_float(w.z & 0xffff0000u);
            acc8[6] += p * __uint_as_float(w.w << 16); acc8[7] += p * __uint_as_float(w.w & 0xffff0000u);
        }
    }
    const float inv = (sum > 0.f) ? 1.f / sum : 0.f;
#pragma unroll
    for (int j = 0; j < 8; ++j) { float v = acc8[j]; v += __shfl_xor(v, 8); v += __shfl_xor(v, 16); v += __shfl_xor(v, 32); acc8[j] = v * inv; }
    if (kg == 0) {
        uint4 w;
        w.x = (unsigned)f2bf(acc8[0]) | ((unsigned)f2bf(acc8[1]) << 16); w.y = (unsigned)f2bf(acc8[2]) | ((unsigned)f2bf(acc8[3]) << 16);
        w.z = (unsigned)f2bf(acc8[4]) | ((unsigned)f2bf(acc8[5]) << 16); w.w = (unsigned)f2bf(acc8[6]) | ((unsigned)f2bf(acc8[7]) << 16);
        *(uint4*)(a.out + (size_t)t * 512 + hq * 64 + dc * 8) = w;
    }
    if (MODE >= 4 && lane == 0) a.lse[((size_t)(MODE - 4) * T + t) * 8 + hq] = mx + __logf(sum);
}

__global__ void k_combine(bf16_t* o7, const float* lse, const bf16_t* ub) {
    size_t i = (size_t)blockIdx.x * blockDim.x + threadIdx.x;
    if (i >= (size_t)T * 512) return;
    int t = (int)(i / 512), col = (int)(i % 512), hq = col >> 6;
    const bf16_t* u = ub + (size_t)t * LDB;
    bf16_t* ocmp = o7; bf16_t* ob = o7 + O7_STRIDE; bf16_t* od0 = o7 + 2 * O7_STRIDE; bf16_t* oslc = o7 + 3 * O7_STRIDE; bf16_t* owin = o7 + 4 * O7_STRIDE; bf16_t* od1 = o7 + 5 * O7_STRIDE; bf16_t* od2 = o7 + 6 * O7_STRIDE;
    float g0 = sigm(bf2f(u[B_GATE + hq * 3 + 0])), g1 = sigm(bf2f(u[B_GATE + hq * 3 + 1])), g2 = sigm(bf2f(u[B_GATE + hq * 3 + 2]));
    float za = bf2f(u[B_ZA + col]), zb = bf2f(u[B_ZB + col]), zc = bf2f(u[B_ZC + col]);
    float oa = (g0 * bf2f(ocmp[i]) + g1 * bf2f(oslc[i]) + g2 * bf2f(owin[i])) * (za * sigm(za));
    float obv = bf2f(ob[i]) * (zb * sigm(zb));
    float l0 = lse[((size_t)0 * T + t) * 8 + hq], l1 = lse[((size_t)1 * T + t) * 8 + hq], l2 = lse[((size_t)2 * T + t) * 8 + hq];
    float m = fmaxf(l0, fmaxf(l1, l2));
    float w0 = __expf(l0 - m), w1 = __expf(l1 - m), w2 = __expf(l2 - m);
    float oc = (w0 * bf2f(od0[i]) + w1 * bf2f(od1[i]) + w2 * bf2f(od2[i])) / (w0 + w1 + w2) * (zc * sigm(zc));
    ocmp[i] = f2bf(oa); ob[i] = f2bf(obv); od0[i] = f2bf(oc);
}

template <typename TA, class Epi>
static void gemm(hipStream_t st, const TA* A, int lda, const float* Bm, int ldb, int M, int N, int K, Epi epi) {
    dim3 grid((N + 63) / 64, M / 64);
    hipLaunchKernelGGL((k_gemm<TA, Epi>), grid, dim3(256), 0, st, A, lda, Bm, ldb, M, N, K, epi);
}

extern "C" void kernel_launch(void* const* d_in, const int* in_sizes, int n_in, void* d_out, int out_size, void* d_ws, size_t ws_size, hipStream_t stream) {
    if (ws_size < WS_END) return;
    const float* x_in = (const float*)d_in[0];
    const float* p_in = (const float*)d_in[1];
    const int* pos = (const int*)d_in[2];
    const float* g_pre = (const float*)d_in[3];
    const float* g_post = (const float*)d_in[4];
    const float* w_in = (const float*)d_in[5];
    const float* cmp_pe = (const float*)d_in[6];
    const float* cmp_w1 = (const float*)d_in[7];
    const float* cmp_w2 = (const float*)d_in[8];
    const float* w_a = (const float*)d_in[9];
    const float* g_q = (const float*)d_in[10];
    const float* w_uq = (const float*)d_in[11];
    const float* g_kv = (const float*)d_in[12];
    const float* w_ukv = (const float*)d_in[13];
    const float* w_b = (const float*)d_in[14];
    const float* w_c = (const float*)d_in[15];
    const float* w_out = (const float*)d_in[16];
    const float* w_ple = (const float*)d_in[17];
    const float* w_plg = (const float*)d_in[18];
    unsigned char* ws = (unsigned char*)d_ws;
    float* x = (float*)d_out;
    bf16_t* UA = (bf16_t*)(ws + WS_UA); bf16_t* UB = (bf16_t*)(ws + WS_UB); bf16_t* H = (bf16_t*)(ws + WS_H);
    bf16_t* O7 = (bf16_t*)(ws + WS_O7); float* LSE = (float*)(ws + WS_LSE);
    bf16_t* QM = (bf16_t*)(ws + WS_QM); bf16_t* KVU = (bf16_t*)(ws + WS_KVU); bf16_t* FLAT = (bf16_t*)(ws + WS_FLAT);
    float* HID = (float*)(ws + WS_HID); bf16_t* KC = (bf16_t*)(ws + WS_KC); unsigned long long* SEL = (unsigned long long*)(ws + WS_SEL);
    float* TAB = (float*)(ws + WS_TAB);
    float* YMIX = (float*)(ws + WS_YMIX); bf16_t* YMIXB = (bf16_t*)(ws + WS_YMIXB); float* Y2 = (float*)(ws + WS_Y2); float* E = (float*)(ws + WS_E);
    bf16_t* QN = (bf16_t*)(ws + WS_QN); bf16_t* KVN = (bf16_t*)(ws + WS_KVN);

    (void)hipMemcpyAsync(x, x_in, (size_t)T * D * 4, hipMemcpyDeviceToDevice, stream);
    hipLaunchKernelGGL(k_tables, dim3((T * 24 + 255) / 256), dim3(256), 0, stream, pos, TAB);
    for (int L = 0; L < DEPTH; ++L) {
        hipLaunchKernelGGL((k_rmsnorm<float>), dim3(T / 4), dim3(256), 0, stream, (const float*)x, D, D, g_pre + (size_t)L * D, H, D, T);
        gemm(stream, (const bf16_t*)H, D, w_in + (size_t)L * D * DIN, DIN, T, DIN, D, EpiU{UA, UB});
        hipLaunchKernelGGL(k_rope_ua, dim3((unsigned)(((size_t)T * 512 + 255) / 256)), dim3(256), 0, stream, UA, (const float*)TAB);
        hipLaunchKernelGGL((k_rmsnorm<bf16_t>), dim3(T / 4), dim3(256), 0, stream, (const bf16_t*)(UA + A_BCQ), LDA, 384, g_q + (size_t)L * 384, QN, 384, T);
        hipLaunchKernelGGL((k_rmsnorm<bf16_t>), dim3(T / 4), dim3(256), 0, stream, (const bf16_t*)(UA + A_BCKV), LDA, 128, g_kv + (size_t)L * 128, KVN, 128, T);
        gemm(stream, (const bf16_t*)QN, 384, w_uq + (size_t)L * 384 * 768, 768, T, 768, 384, EpiBf{QM, 768, 0});
        hipLaunchKernelGGL(k_rope_qm, dim3((unsigned)(((size_t)T * 128 + 255) / 256)), dim3(256), 0, stream, QM, (const float*)TAB);
        gemm(stream, (const bf16_t*)KVN, 128, w_ukv + (size_t)L * 128 * 1024, 1024, T, 1024, 128, EpiBf{KVU, 1024, 0});
        hipLaunchKernelGGL(k_flat, dim3((unsigned)(((size_t)2 * CROWS * 2048 + 255) / 256)), dim3(256), 0, stream, (const bf16_t*)UA, cmp_pe + (size_t)L * 2 * 32 * 64, FLAT);
        for (int kv = 0; kv < 2; ++kv) {
            gemm(stream, (const bf16_t*)(FLAT + (size_t)kv * CROWS * 2048), 2048, cmp_w1 + ((size_t)L * 2 + kv) * 2048 * 256, 256, CROWS, 256, 2048, EpiSilu{HID + (size_t)kv * CROWS * 256, 256, 0});
            gemm(stream, (const float*)(HID + (size_t)kv * CROWS * 256), 256, cmp_w2 + ((size_t)L * 2 + kv) * 256 * 64, 64, CROWS, 64, 256, EpiBf{KC + (size_t)kv * CROWS * 64, 64, 0});
        }
        hipLaunchKernelGGL(k_topk, dim3(T * 2 / 4), dim3(256), 0, stream, (const bf16_t*)UA, (const bf16_t*)KC, SEL);
        AttnArgs aa{UA, KC, QM, KVU, SEL, nullptr, LSE};
        aa.out = O7 + 0 * O7_STRIDE; hipLaunchKernelGGL((k_attn<0>), dim3(T * 8 / 2), dim3(128), 0, stream, aa);
        aa.out = O7 + 3 * O7_STRIDE; hipLaunchKernelGGL((k_attn<1>), dim3(T * 8 / 2), dim3(128), 0, stream, aa);
        aa.out = O7 + 4 * O7_STRIDE; hipLaunchKernelGGL((k_attn<2>), dim3(T * 8 / 2), dim3(128), 0, stream, aa);
        aa.out = O7 + 1 * O7_STRIDE; hipLaunchKernelGGL((k_attn<3>), dim3(T * 8 / 2), dim3(128), 0, stream, aa);
        aa.out = O7 + 2 * O7_STRIDE; hipLaunchKernelGGL((k_attn<4>), dim3(T * 8 / 2), dim3(128), 0, stream, aa);
        aa.out = O7 + 5 * O7_STRIDE; hipLaunchKernelGGL((k_attn<5>), dim3(T * 8 / 2), dim3(128), 0, stream, aa);
        aa.out = O7 + 6 * O7_STRIDE; hipLaunchKernelGGL((k_attn<6>), dim3(T * 8 / 2), dim3(128), 0, stream, aa);
        hipLaunchKernelGGL(k_combine, dim3((unsigned)(((size_t)T * 512 + 255) / 256)), dim3(256), 0, stream, O7, (const float*)LSE, (const bf16_t*)UB);
        gemm(stream, (const bf16_t*)(O7 + 0 * O7_STRIDE), 512, w_a + (size_t)L * 512 * D, D, T, D, 512, EpiYmix{YMIX, YMIXB, UB, 0, 0});
        gemm(stream, (const bf16_t*)(O7 + 1 * O7_STRIDE), 512, w_b + (size_t)L * 512 * D, D, T, D, 512, EpiYmix{YMIX, YMIXB, UB, 1, 0});
        gemm(stream, (const bf16_t*)(O7 + 2 * O7_STRIDE), 512, w_c + (size_t)L * 512 * D, D, T, D, 512, EpiYmix{YMIX, YMIXB, UB, 2, 0});
        gemm(stream, (const bf16_t*)YMIXB, D, w_out + (size_t)L * D * D, D, T, D, D, EpiF{Y2, D, 0});
        hipLaunchKernelGGL(k_post, dim3(T / 4), dim3(256), 0, stream, x, (const float*)Y2, g_post + (size_t)L * D, H);
        gemm(stream, p_in + (size_t)L * T * 256, 256, w_ple + (size_t)L * 256 * D, D, T, D, 256, EpiF{E, D, 0});
        gemm(stream, (const bf16_t*)H, D, w_plg + (size_t)L * D * D, D, T, D, D, EpiPlg{x, E});
    }
}
```

```cpp
#include <hip/hip_runtime.h>
#include <stdint.h>
#include <math.h>

typedef unsigned short bf16_t;
#define DI __device__ __forceinline__

constexpr int NB = 4, S = 4096, T = NB * S, D = 1024, DEPTH = 4;
constexpr int DIN = 11064;
constexpr int A_AQ = 0, A_AKV = 512, A_BCQ = 1280, A_BCKV = 1664, A_BKR = 1792, A_CQKV = 1824, LDA = 6432;
constexpr int B_ZA = 0, B_ZB = 512, B_ZC = 1024, B_MG = 1536, B_GATE = 4608, LDB = 4640;
constexpr int NC = 255;
constexpr int CROWS = 2048;

constexpr size_t al256(size_t x) { return (x + 255) & ~(size_t)255; }
constexpr size_t WS_CTL = 0;
constexpr size_t WS_UA = 1 << 20;
constexpr size_t WS_UB = WS_UA + al256((size_t)T * LDA * 2);
constexpr size_t WS_H = WS_UB + al256((size_t)T * LDB * 2);
constexpr size_t WS_O7 = WS_H + al256((size_t)T * 1024 * 2);
constexpr size_t O7_STRIDE = (size_t)T * 512;
constexpr size_t WS_LSE = WS_O7 + al256(7 * O7_STRIDE * 2);
constexpr size_t WS_QM = WS_LSE + al256((size_t)3 * T * 8 * 4);
constexpr size_t WS_KVU = WS_QM + al256((size_t)T * 768 * 2);
constexpr size_t WS_FLAT = WS_KVU + al256((size_t)T * 1024 * 2);
constexpr size_t WS_HID = WS_FLAT + al256((size_t)2 * CROWS * 2048 * 2);
constexpr size_t WS_KC = WS_HID + al256((size_t)2 * CROWS * 256 * 4);
constexpr size_t WS_SEL = WS_KC + al256((size_t)2 * CROWS * 64 * 2);
constexpr size_t WS_TAB = WS_SEL + al256((size_t)T * 2 * 8);
constexpr size_t WS_END = WS_TAB + al256((size_t)T * 48 * 4);
constexpr size_t WS_YMIX = WS_UA;
constexpr size_t WS_YMIXB = WS_YMIX + (size_t)T * 1024 * 4;
constexpr size_t WS_Y2 = WS_YMIXB + (size_t)T * 1024 * 2;
constexpr size_t WS_E = WS_YMIX;
static_assert(WS_Y2 + (size_t)T * 1024 * 4 <= WS_UB, "alias region fits in UA");
constexpr size_t WS_QN = WS_H;
constexpr size_t WS_KVN = WS_H + (size_t)T * 384 * 2;

DI float bf2f(bf16_t v) { return __uint_as_float(((unsigned)v) << 16); }
DI bf16_t f2bf(float f) { unsigned u = __float_as_uint(f); u += 0x7fffu + ((u >> 16) & 1u); return (bf16_t)(u >> 16); }
DI float sigm(float x) { return 1.f / (1.f + __expf(-x)); }
DI float wave_sum(float v) { for (int o = 32; o > 0; o >>= 1) v += __shfl_xor(v, o); return v; }
DI float wave_max(float v) { for (int o = 32; o > 0; o >>= 1) v = fmaxf(v, __shfl_xor(v, o)); return v; }
DI float ldf(const float* p) { return *p; }
DI float ldf(const bf16_t* p) { return bf2f(*p); }

__global__ void k_tables(const int* pos, float* tab) {
    int i = blockIdx.x * blockDim.x + threadIdx.x;
    if (i >= T * 24) return;
    int t = i / 24, j = i % 24;
    float p = (float)pos[t];
    if (j < 8) {
        float inv = powf(500000.0f, -(float)(2 * j) / 16.0f);
        float a = p * inv;
        tab[(size_t)t * 48 + j] = cosf(a); tab[(size_t)t * 48 + 8 + j] = sinf(a);
    } else {
        int jj = j - 8;
        float inv = powf(500000.0f, -(float)(2 * jj) / 32.0f);
        float a = p * inv;
        tab[(size_t)t * 48 + 16 + jj] = cosf(a); tab[(size_t)t * 48 + 32 + jj] = sinf(a);
    }
}

template <typename TIN>
__global__ void k_rmsnorm(const TIN* in, int ld_in, int ncols, const float* g, bf16_t* out, int ld_out, int nrows) {
    int row = blockIdx.x * (blockDim.x >> 6) + (threadIdx.x >> 6), lane = threadIdx.x & 63;
    if (row >= nrows) return;
    const TIN* r = in + (size_t)row * ld_in;
    float ss = 0.f;
    for (int c = lane; c < ncols; c += 64) { float v = ldf(r + c); ss += v * v; }
    ss = wave_sum(ss);
    float rs = rsqrtf(ss / (float)ncols + 1e-6f);
    for (int c = lane; c < ncols; c += 64) out[(size_t)row * ld_out + c] = f2bf(ldf(r + c) * rs * g[c]);
}

__global__ void k_post(float* x, const float* y2, const float* g, bf16_t* xb) {
    int row = blockIdx.x * (blockDim.x >> 6) + (threadIdx.x >> 6), lane = threadIdx.x & 63;
    if (row >= T) return;
    const float* r = y2 + (size_t)row * D;
    float ss = 0.f;
    for (int c = lane; c < D; c += 64) { float v = r[c]; ss += v * v; }
    ss = wave_sum(ss);
    float rs = rsqrtf(ss / (float)D + 1e-6f);
    for (int c = lane; c < D; c += 64) { float v = x[(size_t)row * D + c] + r[c] * rs * g[c]; x[(size_t)row * D + c] = v; xb[(size_t)row * D + c] = f2bf(v); }
}

struct EpiU { bf16_t* ua; bf16_t* ub;
    DI void operator()(int r, int c, float v) const {
        int buf, col;
        if (c < 512) { buf = 0; col = A_AQ + c; }
        else if (c < 1280) { buf = 0; col = A_AKV + c - 512; }
        else if (c < 1304) { buf = 1; col = B_GATE + c - 1280; }
        else if (c < 1816) { buf = 1; col = B_ZA + c - 1304; }
        else if (c < 2200) { buf = 0; col = A_BCQ + c - 1816; }
        else if (c < 2328) { buf = 0; col = A_BCKV + c - 2200; }
        else if (c < 2360) { buf = 0; col = A_BKR + c - 2328; }
        else if (c < 2872) { buf = 1; col = B_ZB + c - 2360; }
        else if (c < 7480) { buf = 0; col = A_CQKV + c - 2872; }
        else if (c < 7992) { buf = 1; col = B_ZC + c - 7480; }
        else { buf = 1; col = B_MG + c - 7992; }
        if (buf == 0) ua[(size_t)r * LDA + col] = f2bf(v); else ub[(size_t)r * LDB + col] = f2bf(v);
    } };
struct EpiBf { bf16_t* c; int ldc; int pad; DI void operator()(int r, int col, float v) const { c[(size_t)r * ldc + col] = f2bf(v); } };
struct EpiF { float* c; int ldc; int pad; DI void operator()(int r, int col, float v) const { c[(size_t)r * ldc + col] = v; } };
struct EpiSilu { float* c; int ldc; int pad; DI void operator()(int r, int col, float v) const { c[(size_t)r * ldc + col] = v * sigm(v); } };
struct EpiYmix { float* ymix; bf16_t* ymixb; const bf16_t* ub; int x; int pad;
    DI void operator()(int r, int col, float v) const {
        float gsc = sigm(bf2f(ub[(size_t)r * LDB + B_MG + x * 1024 + col]));
        float acc = gsc * v;
        if (x > 0) acc += ymix[(size_t)r * D + col];
        ymix[(size_t)r * D + col] = acc;
        if (x == 2) ymixb[(size_t)r * D + col] = f2bf(acc);
    } };
struct EpiPlg { float* x; const float* e; DI void operator()(int r, int col, float v) const { x[(size_t)r * D + col] += sigm(v) * e[(size_t)r * D + col]; } };

template <typename TA, class Epi>
__global__ __launch_bounds__(256) void k_gemm(const TA* A, int lda, const float* Bm, int ldb, int M, int N, int K, Epi epi) {
    __shared__ float As[16][68];
    __shared__ float Bs[16][68];
    const int tid = threadIdx.x, tx = tid & 15, ty = tid >> 4;
    const int m0 = blockIdx.y * 64, n0 = blockIdx.x * 64;
    float acc[4][4] = {};
    for (int k0 = 0; k0 < K; k0 += 16) {
        for (int e = tid; e < 1024; e += 256) { int r = e >> 4, c = e & 15; As[c][r] = ldf(A + (size_t)(m0 + r) * lda + k0 + c); }
        for (int e = tid; e < 1024; e += 256) { int r = e >> 6, c = e & 63; int n = n0 + c; Bs[r][c] = (n < N) ? Bm[(size_t)(k0 + r) * ldb + n] : 0.f; }
        __syncthreads();
#pragma unroll
        for (int k = 0; k < 16; ++k) {
            float a[4], b[4];
#pragma unroll
            for (int i = 0; i < 4; ++i) { a[i] = As[k][ty * 4 + i]; b[i] = Bs[k][tx * 4 + i]; }
#pragma unroll
            for (int i = 0; i < 4; ++i)
#pragma unroll
                for (int j = 0; j < 4; ++j) acc[i][j] += a[i] * b[j];
        }
        __syncthreads();
    }
#pragma unroll
    for (int i = 0; i < 4; ++i)
#pragma unroll
        for (int j = 0; j < 4; ++j) { int r = m0 + ty * 4 + i, c = n0 + tx * 4 + j; if (r < M && c < N) epi(r, c, acc[i][j]); }
}

__global__ void k_rope_ua(bf16_t* ua, const float* tab) {
    size_t i = (size_t)blockIdx.x * blockDim.x + threadIdx.x;
    if (i >= (size_t)T * 512) return;
    int t = (int)(i / 512), w = (int)(i % 512);
    bf16_t* row = ua + (size_t)t * LDA;
    const float* tb = tab + (size_t)t * 48;
    if (w < 496) {
        int item = w / 8, j = w % 8, base;
        if (item < 8) base = A_AQ + item * 64;
        else if (item < 14) { int q = item - 8; int jj = (q / 2) * 2, hk = q % 2; base = A_AKV + jj * 128 + hk * 64; }
        else { int q = item - 14; int gi = q / 16, wh = (q / 8) % 2, h = q % 8; base = A_CQKV + gi * 1536 + wh * 512 + h * 64; }
        float c = tb[j], s = tb[8 + j];
        float x1 = bf2f(row[base + j]), x2 = bf2f(row[base + 8 + j]);
        row[base + j] = f2bf(x1 * c - x2 * s); row[base + 8 + j] = f2bf(x2 * c + x1 * s);
    } else {
        int j = w - 496;
        float c = tb[16 + j], s = tb[32 + j];
        float x1 = bf2f(row[A_BKR + j]), x2 = bf2f(row[A_BKR + 16 + j]);
        row[A_BKR + j] = f2bf(x1 * c - x2 * s); row[A_BKR + 16 + j] = f2bf(x2 * c + x1 * s);
    }
}
__global__ void k_rope_qm(bf16_t* qm, const float* tab) {
    size_t i = (size_t)blockIdx.x * blockDim.x + threadIdx.x;
    if (i >= (size_t)T * 128) return;
    int t = (int)(i / 128), w = (int)(i % 128), h = w / 16, j = w % 16;
    bf16_t* p = qm + (size_t)t * 768 + h * 96 + 64;
    const float* tb = tab + (size_t)t * 48;
    float c = tb[16 + j], s = tb[32 + j];
    float x1 = bf2f(p[j]), x2 = bf2f(p[16 + j]);
    p[j] = f2bf(x1 * c - x2 * s); p[16 + j] = f2bf(x2 * c + x1 * s);
}

__global__ void k_flat(const bf16_t* ua, const float* pe  , bf16_t* flat) {
    size_t i = (size_t)blockIdx.x * blockDim.x + threadIdx.x;
    if (i >= (size_t)2 * CROWS * 2048) return;
    int kv = (int)(i / ((size_t)CROWS * 2048));
    size_t rem = i % ((size_t)CROWS * 2048);
    int row = (int)(rem / 2048), col = (int)(rem % 2048);
    float v = 0.f;
    if (row < NB * NC * 2) {
        int hk = row & 1, bc = row >> 1, b = bc / NC, c = bc % NC, l = col >> 6, d = col & 63;
        int tok = b * S + 16 * c + l;
        v = bf2f(ua[(size_t)tok * LDA + A_AKV + kv * 128 + hk * 64 + d]) + pe[(kv * 32 + l) * 64 + d];
    }
    flat[i] = f2bf(v);
}

DI float dot8(const float* q, uint4 w) {
    float r = q[0] * __uint_as_float(w.x << 16) + q[1] * __uint_as_float(w.x & 0xffff0000u);
    r += q[2] * __uint_as_float(w.y << 16) + q[3] * __uint_as_float(w.y & 0xffff0000u);
    r += q[4] * __uint_as_float(w.z << 16) + q[5] * __uint_as_float(w.z & 0xffff0000u);
    r += q[6] * __uint_as_float(w.w << 16) + q[7] * __uint_as_float(w.w & 0xffff0000u);
    return r;
}
__global__ __launch_bounds__(256) void k_topk(const bf16_t* ua, const bf16_t* kc  , unsigned long long* sel) {
    __shared__ float qs[4][64];
    const int wv = threadIdx.x >> 6, lane = threadIdx.x & 63;
    const int item = blockIdx.x * 4 + wv;
    const int t = item >> 1, hk = item & 1, b = t / S, s = t % S;
    float mine = 0.f;
    for (int g = 0; g < 4; ++g) {
        __syncthreads();
        qs[wv][lane] = bf2f(ua[(size_t)t * LDA + A_AQ + (hk * 4 + g) * 64 + lane]);
        __syncthreads();
        float sc[4]; bool ok[4]; float mx = -INFINITY;
#pragma unroll
        for (int e = 0; e < 4; ++e) {
            int c = lane * 4 + e;
            ok[e] = (c < NC) && (16 * c + 31 <= s);
            float dsum = 0.f;
            if (ok[e]) { const bf16_t* kr = kc + ((size_t)(b * NC + c) * 2 + hk) * 64;
#pragma unroll
                for (int d8 = 0; d8 < 8; ++d8) dsum += dot8(&qs[wv][d8 * 8], *(const uint4*)(kr + d8 * 8)); }
            sc[e] = ok[e] ? dsum * 0.125f : -INFINITY;
            mx = fmaxf(mx, sc[e]);
        }
        mx = wave_max(mx);
        float p[4], sum = 0.f;
#pragma unroll
        for (int e = 0; e < 4; ++e) { p[e] = ok[e] ? __expf(sc[e] - mx) : 0.f; sum += p[e]; }
        sum = wave_sum(sum);
        float inv = sum > 0.f ? 1.f / sum : 0.f;
#pragma unroll
        for (int e = 0; e < 4; ++e) p[e] *= inv;
        float carry = 0.5f * p[3];
        float up = __shfl_up(carry, 1); if (lane == 0) up = 0.f;
        mine += p[0] + p[1] + p[2] + 0.5f * p[3] + up;
    }
    const int cur = s >> 6;
    const bool valid = lane <= cur;
    const bool forced = (lane == 0) || (lane == cur) || (lane == cur - 1);
    const float score = forced ? 1e30f : (valid ? mine : -1e30f);
    int rank = 0;
    for (int jj = 0; jj < 64; ++jj) { float v = __shfl(score, jj); rank += (v > score || (v == score && jj < lane)) ? 1 : 0; }
    unsigned long long m = __ballot((rank < 16) && valid);
    if (lane == 0) sel[(size_t)t * 2 + hk] = m;
}

struct AttnArgs { const bf16_t* ua; const bf16_t* kc; const bf16_t* qm; const bf16_t* kvu; const unsigned long long* sel; bf16_t* out; float* lse; };
template <int MODE>
__global__ __launch_bounds__(128) void k_attn(AttnArgs a) {
    __shared__ float sc_s[2][4096];
    __shared__ float q_s[2][96];
    const int wv = threadIdx.x >> 6, lane = threadIdx.x & 63;
    const int item = blockIdx.x * 2 + wv;
    const int t = item >> 3, hq = item & 7, b = t / S, s = t % S;
    constexpr int DQK = (MODE == 3) ? 96 : 64;
    const float scale = (MODE == 3) ? 0.10206207261596577f : 0.125f;
    float* sc = sc_s[wv]; float* q = q_s[wv];
    if (MODE == 3) { q[lane] = bf2f(a.qm[(size_t)t * 768 + hq * 96 + lane]); if (lane < 32) q[64 + lane] = bf2f(a.qm[(size_t)t * 768 + hq * 96 + 64 + lane]); }
    else if (MODE <= 2) q[lane] = bf2f(a.ua[(size_t)t * LDA + A_AQ + hq * 64 + lane]);
    else q[lane] = bf2f(a.ua[(size_t)t * LDA + A_CQKV + (MODE - 4) * 1536 + hq * 64 + lane]);
    __syncthreads();
    const int hk = hq >> 2;
    const int dil = (MODE == 5) ? 4 : (MODE == 6) ? 16 : 1;
    int nk;
    if (MODE == 0) nk = NC; else if (MODE == 1) nk = ((s >> 6) + 1) * 64; else if (MODE == 2) nk = 512; else if (MODE == 3) nk = s + 1; else nk = 129;
    unsigned long long selm = 0ull;
    if (MODE == 1) selm = a.sel[(size_t)t * 2 + hk];
    auto keyinfo = [&](int i, bool& ok, const bf16_t*& kp, const bf16_t*& kp2, const bf16_t*& vp) {
        kp2 = nullptr;
        if (MODE == 0) { ok = (16 * i + 31 <= s); size_t r = ((size_t)(b * NC + i) * 2 + hk) * 64; kp = a.kc + r; vp = a.kc + (size_t)CROWS * 64 + r; }
        else if (MODE == 1) { ok = (i <= s) && ((selm >> (i >> 6)) & 1ull); size_t r = (size_t)(b * S + i) * LDA + A_AKV + hk * 64; kp = a.ua + r + 2 * 128; vp = a.ua + r + 3 * 128; }
        else if (MODE == 2) { int kt = s - 511 + i; ok = kt >= 0; if (!ok) kt = 0; size_t r = (size_t)(b * S + kt) * LDA + A_AKV + hk * 64; kp = a.ua + r + 4 * 128; vp = a.ua + r + 5 * 128; }
        else if (MODE == 3) { ok = true; size_t r = (size_t)(b * S + i); kp = a.kvu + r * 1024 + hq * 128; vp = kp + 64; kp2 = a.ua + r * LDA + A_BKR; }
        else { int kt = s - dil * i; ok = kt >= 0; if (!ok) kt = 0; size_t r = (size_t)(b * S + kt) * LDA + A_CQKV + (MODE - 4) * 1536 + hq * 64; kp = a.ua + r + 512; vp = a.ua + r + 1024; }
    };
    float mx = -INFINITY;
    for (int i = lane; i < nk; i += 64) {
        bool ok; const bf16_t *kp, *kp2, *vp; keyinfo(i, ok, kp, kp2, vp);
        float v = -INFINITY;
        if (ok) {
            float dsum = 0.f;
#pragma unroll
            for (int d8 = 0; d8 < 8; ++d8) dsum += dot8(q + d8 * 8, *(const uint4*)(kp + d8 * 8));
            if (MODE == 3) {
#pragma unroll
                for (int d8 = 0; d8 < 4; ++d8) dsum += dot8(q + 64 + d8 * 8, *(const uint4*)(kp2 + d8 * 8)); }
            v = dsum * scale;
        }
        sc[i] = v; mx = fmaxf(mx, v);
    }
    mx = wave_max(mx);
    float sum = 0.f;
    for (int i = lane; i < nk; i += 64) { float v = sc[i]; float e = (v == -INFINITY) ? 0.f : __expf(v - mx); sc[i] = e; sum += e; }
    sum = wave_sum(sum);
    __syncthreads();
    const int kg = lane >> 3, dc = lane & 7;
    float acc8[8];
#pragma unroll
    for (int j = 0; j < 8; ++j) acc8[j] = 0.f;
    for (int i0 = 0; i0 < nk; i0 += 8) {
        const int i = i0 + kg;
        const float p = (i < nk) ? sc[i] : 0.f;
        if (p != 0.f) {
            bool ok; const bf16_t *kp, *kp2, *vp; keyinfo(i, ok, kp, kp2, vp);
            const uint4 w = *(const uint4*)(vp + dc * 8);
            acc8[0] += p * __uint_as_float(w.x << 16); acc8[1] += p * __uint_as_float(w.x & 0xffff0000u);
            acc8[2] += p * __uint_as_float(w.y << 16); acc8[3] += p * __uint_as_float(w.y & 0xffff0000u);
            acc8[4] += p * __uint_as_float(w.z << 16); acc8[5] += p * __uint_as_float(w.z & 0xffff0000u);
            acc8[6] += p * __uint_as_float(w.w << 16); acc8[7] += p * __uint_as_float(w.w & 0xffff0000u);
        }
    }
    const float inv = (sum > 0.f) ? 1.f / sum : 0.f;
#pragma unroll
    for (int j = 0; j < 8; ++j) { float v = acc8[j]; v += __shfl_xor(v, 8); v += __shfl_xor(v, 16); v += __shfl_xor(v, 32); acc8[j] = v * inv; }
    if (kg == 0) {
        uint4 w;
        w.x = (unsigned)f2bf(acc8[0]) | ((unsigned)f2bf(acc8[1]) << 16); w.y = (unsigned)f2bf(acc8[2]) | ((unsigned)f2bf(acc8[3]) << 16);
        w.z = (unsigned)f2bf(acc8[4]) | ((unsigned)f2bf(acc8[5]) << 16); w.w = (unsigned)f2bf(acc8[6]) | ((unsigned)f2bf(acc8[7]) << 16);
        *(uint4*)(a.out + (size_t)t * 512 + hq * 64 + dc * 8) = w;
    }
    if (MODE >= 4 && lane == 0) a.lse[((size_t)(MODE - 4) * T + t) * 8 + hq] = mx + __logf(sum);
}

__global__ void k_combine(bf16_t* o7, const float* lse, const bf16_t* ub) {
    size_t i = (size_t)blockIdx.x * blockDim.x + threadIdx.x;
    if (i >= (size_t)T * 512) return;
    int t = (int)(i / 512), col = (int)(i % 512), hq = col >> 6;
    const bf16_t* u = ub + (size_t)t * LDB;
    bf16_t* ocmp = o7; bf16_t* ob = o7 + O7_STRIDE; bf16_t* od0 = o7 + 2 * O7_STRIDE; bf16_t* oslc = o7 + 3 * O7_STRIDE; bf16_t* owin = o7 + 4 * O7_STRIDE; bf16_t* od1 = o7 + 5 * O7_STRIDE; bf16_t* od2 = o7 + 6 * O7_STRIDE;
    float g0 = sigm(bf2f(u[B_GATE + hq * 3 + 0])), g1 = sigm(bf2f(u[B_GATE + hq * 3 + 1])), g2 = sigm(bf2f(u[B_GATE + hq * 3 + 2]));
    float za = bf2f(u[B_ZA + col]), zb = bf2f(u[B_ZB + col]), zc = bf2f(u[B_ZC + col]);
    float oa = (g0 * bf2f(ocmp[i]) + g1 * bf2f(oslc[i]) + g2 * bf2f(owin[i])) * (za * sigm(za));
    float obv = bf2f(ob[i]) * (zb * sigm(zb));
    float l0 = lse[((size_t)0 * T + t) * 8 + hq], l1 = lse[((size_t)1 * T + t) * 8 + hq], l2 = lse[((size_t)2 * T + t) * 8 + hq];
    float m = fmaxf(l0, fmaxf(l1, l2));
    float w0 = __expf(l0 - m), w1 = __expf(l1 - m), w2 = __expf(l2 - m);
    float oc = (w0 * bf2f(od0[i]) + w1 * bf2f(od1[i]) + w2 * bf2f(od2[i])) / (w0 + w1 + w2) * (zc * sigm(zc));
    ocmp[i] = f2bf(oa); ob[i] = f2bf(obv); od0[i] = f2bf(oc);
}


namespace pg8 {
#define PG8_LAS __attribute__((address_space(3)))
typedef unsigned short bf16_t;
typedef short bf16x8 __attribute__((ext_vector_type(8)));
typedef float f32x4 __attribute__((ext_vector_type(4)));
typedef unsigned u32x4 __attribute__((ext_vector_type(4)));
constexpr int BM = 256, BK = 64, HALF = 128, HTB = HALF * BK * 2  , STAGE_BYTES = 8 * HTB, NXCD = 8, WGM = 8;

__host__ __device__ __forceinline__ int lds_byte(int r, int c) { const int st = (r >> 4) * 2 + (c >> 5), rr = r & 15, cc = c & 31, ob = rr * 64 + cc * 2; return st * 1024 + (ob ^ (((ob >> 9) & 1) << 5)); }
__host__ __device__ __forceinline__ void stage_rc(int b, int& R, int& C) { const int st = b / 1024, sb = b % 1024, swz = sb ^ (((sb >> 9) & 1) << 5); R = (st >> 1) * 16 + swz / 64; C = (st & 1) * 32 + (swz % 64) / 2; }
__host__ __device__ __forceinline__ int perm32(int rho) { const int n = rho >> 4, i = rho & 15; return 8 * (i >> 2) + 4 * n + (i & 3); }

constexpr int HWTID_OFF = 131072 + 1024;
__device__ __forceinline__ unsigned hw_slot() { const unsigned h = (unsigned)__builtin_amdgcn_s_getreg((6 << 11) | (0 << 6) | 4); return h & 63u; }
__device__ __forceinline__ void hw_tid_init(PG8_LAS unsigned char* lds) { if ((threadIdx.x & 63) == 0) *(PG8_LAS unsigned*)(lds + HWTID_OFF + 4 * hw_slot()) = threadIdx.x >> 6; }
__device__ __forceinline__ int hw_tid(PG8_LAS unsigned char* lds) {
    const unsigned w = *(PG8_LAS unsigned*)(lds + HWTID_OFF + 4 * hw_slot());
    int lane; asm volatile("v_mbcnt_lo_u32_b32 %0, -1, 0\n\tv_mbcnt_hi_u32_b32 %0, -1, %0" : "=v"(lane));
    return (int)__builtin_amdgcn_readfirstlane(w) * 64 + lane;
}
struct Unit { int pm, pn; };
struct Gemm { const bf16_t* A; const bf16_t* Bt; int M, N, K; };

struct StaticOrder {
    int nM, nN, nwg, G, c;
    __host__ __device__ void init(int M, int N, int G_, int c_) { nM = M / BM; nN = N / BM; nwg = nM * nN; G = G_; c = c_; }
    __host__ __device__ bool next(int i, Unit& u) const {
        const long L = (long)i * G + c; if (L >= nwg) return false;
        int wgid = (int)L; { const int q = nwg / NXCD, r = nwg % NXCD, xcd = wgid % NXCD, off = wgid / NXCD; wgid = (xcd < r ? xcd * (q + 1) : r * (q + 1) + (xcd - r) * q) + off; }
        const int nig = WGM * nN, gid = wgid / nig, fm = gid * WGM, gsz = (nM - fm) < WGM ? (nM - fm) : WGM;
        u.pm = fm + ((wgid % nig) % gsz); u.pn = (wgid % nig) / gsz; return true;
    }
    __device__ __forceinline__ void a_ready(const Unit&) const {}
    __device__ __forceinline__ void done(const Unit&) const {}
};

__device__ __forceinline__ unsigned cvt_pk_bf16(float lo, float hi) { unsigned r; asm volatile("v_cvt_pk_bf16_f32 %0, %1, %2" : "=v"(r) : "v"(lo), "v"(hi)); return r; }

template <class Epi, class Sched, bool ALIGN_EPI = false, bool SP2 = false>
__device__ __forceinline__ void gemm_phase(PG8_LAS unsigned char* lds, const Gemm g, const Sched& S, const Epi& E) {
    int tid_ = hw_tid(lds); asm volatile("" : "+v"(tid_));
    const int tid = tid_, wid = __builtin_amdgcn_readfirstlane(tid >> 6), lane = tid & 63, wr = wid >> 2, wc = wid & 3, fr = lane & 15, fq = lane >> 4;
    int K_ = g.K; asm volatile("" : "+s"(K_));
    __builtin_assume(K_ >= 128 && K_ % 128 == 0);
    const int K = K_, nt = K / BK;
    unsigned voffA[2], voffB[2];
#pragma unroll
    for (int i = 0; i < 2; ++i) { int R, C; stage_rc(tid * 16 + i * 8192, R, C); const int Rb = Epi::PERM ? ((R & ~31) + perm32(R & 31)) : R;
        voffA[i] = (unsigned)(R * K + C) * 2u; voffB[i] = (unsigned)(Rb * K + C) * 2u; }
    const size_t kstep = (size_t)(BK * 2);
    const size_t hstep = (size_t)HALF * K * 2;
    const size_t tstep = 2 * hstep;
    const unsigned ldsw = (unsigned)wid * 1024u;
    const int aoff = lds_byte(wr * 64 + fr, fq * 8), boff = lds_byte(wc * 32 + fr, fq * 8);
#define PG8_SA(b, h) (((b) * 2 + (h)) * HTB)
#define PG8_SB(b, h) ((4 + (b) * 2 + (h)) * HTB)
#define PG8_STAGE(bufoff, gbase, voff) do { _Pragma("unroll") for (int _i = 0; _i < 2; ++_i) \
        __builtin_amdgcn_global_load_lds((const unsigned*)((const char*)(gbase) + (voff)[_i]), (PG8_LAS unsigned*)(lds + (bufoff) + ldsw + _i * 8192), 16, 0, 0); } while (0)
#define PG8_LDA(dst, b, h) do { _Pragma("unroll") for (int m = 0; m < 4; ++m) _Pragma("unroll") for (int k = 0; k < 2; ++k) dst[m][k] = *(const PG8_LAS bf16x8*)(lds + PG8_SA(b, h) + aoff + m * 2048 + k * 1024); } while (0)
#define PG8_LDB(dst, b, h) do { _Pragma("unroll") for (int n = 0; n < 2; ++n) _Pragma("unroll") for (int k = 0; k < 2; ++k) dst[n][k] = *(const PG8_LAS bf16x8*)(lds + PG8_SB(b, h) + boff + n * 2048 + k * 1024); } while (0)
#define PG8_MMA(ai, bj, At, Bt) do { __builtin_amdgcn_s_setprio(1); _Pragma("unroll") for (int m = 0; m < 4; ++m) _Pragma("unroll") for (int n = 0; n < 2; ++n) _Pragma("unroll") for (int k = 0; k < 2; ++k) \
        acc[ai][bj][m][n] = __builtin_amdgcn_mfma_f32_16x16x32_bf16(Bt[n][k], At[m][k], acc[ai][bj][m][n], 0, 0, 0); __builtin_amdgcn_s_setprio(0); } while (0)
#define PG8_WAIT_V(n) asm volatile("s_waitcnt vmcnt(" #n ")" ::: "memory")
#define PG8_WAIT_L(n) asm volatile("s_waitcnt lgkmcnt(" #n ")" ::: "memory")
#define PG8_BAR __builtin_amdgcn_s_barrier()
#define PG8_SCHED __builtin_amdgcn_sched_barrier(0)
    Unit cur, nxt; int ui = 0;
    if (!S.next(0, cur)) return;
    float zf_ = 0.f; asm volatile("" : "+v"(zf_));
    f32x4 acc[2][2][4][2];
#pragma unroll
    for (int a = 0; a < 2; ++a)
#pragma unroll
        for (int b = 0; b < 2; ++b)
#pragma unroll
            for (int m = 0; m < 4; ++m)
#pragma unroll
                for (int n = 0; n < 2; ++n) acc[a][b][m][n] = (f32x4){zf_, zf_, zf_, zf_};
    bf16x8 At[4][2], B0[2][2], B1[2][2];
    const char* cA = (const char*)g.A + (size_t)cur.pm * tstep; const char* cB = (const char*)g.Bt + (size_t)cur.pn * tstep;
    S.a_ready(cur);
    if constexpr (SP2) {
        PG8_STAGE(PG8_SB(0, 0), cB, voffB); PG8_STAGE(PG8_SB(0, 1), cB + hstep, voffB); PG8_STAGE(PG8_SA(0, 0), cA, voffA); PG8_STAGE(PG8_SA(0, 1), cA + hstep, voffA);
        if (wr == 1) PG8_BAR;
        PG8_WAIT_V(2); PG8_BAR;
        PG8_STAGE(PG8_SB(1, 0), cB + kstep, voffB); PG8_STAGE(PG8_SA(1, 0), cA + kstep, voffA); PG8_STAGE(PG8_SB(1, 1), cB + hstep + kstep, voffB);
        PG8_WAIT_V(6); PG8_BAR;
    } else {
        PG8_STAGE(PG8_SB(0, 0), cB, voffB); PG8_STAGE(PG8_SA(0, 0), cA, voffA); PG8_STAGE(PG8_SB(0, 1), cB + hstep, voffB); PG8_STAGE(PG8_SA(0, 1), cA + hstep, voffA);
        if (wr == 1) PG8_BAR;
        PG8_WAIT_V(4); PG8_BAR;
        PG8_STAGE(PG8_SB(1, 0), cB + kstep, voffB); PG8_STAGE(PG8_SA(1, 0), cA + kstep, voffA); PG8_STAGE(PG8_SB(1, 1), cB + hstep + kstep, voffB);
        PG8_WAIT_V(6); PG8_BAR;
    }
    for (;;) {
        const bool has_next = S.next(ui + 1, nxt);
        const char* nA = has_next ? (const char*)g.A + (size_t)nxt.pm * tstep : cA; const char* nB = has_next ? (const char*)g.Bt + (size_t)nxt.pn * tstep : cB;
        for (int t = 0; t < nt; t += 2) {
            const bool last = (t == nt - 2);
            const char* a1 = cA + (size_t)(t + 1) * kstep;
            const char* a2 = last ? nA : cA + (size_t)(t + 2) * kstep; const char* b2 = last ? nB : cB + (size_t)(t + 2) * kstep;
            const char* a3 = a2 + kstep; const char* b3 = b2 + kstep;
            if (last && has_next) S.a_ready(nxt);
            if constexpr (SP2) {
            PG8_LDB(B0, 0, 0); PG8_LDB(B1, 0, 1); PG8_SCHED; PG8_LDA(At, 0, 0); PG8_STAGE(PG8_SA(1, 1), a1 + hstep, voffA);
            PG8_WAIT_V(8); PG8_WAIT_L(0); PG8_BAR; PG8_MMA(0, 0, At, B0); PG8_MMA(0, 1, At, B1); PG8_BAR; PG8_SCHED;
            PG8_LDA(At, 0, 1); PG8_STAGE(PG8_SB(0, 0), b2, voffB); PG8_STAGE(PG8_SB(0, 1), b2 + hstep, voffB); PG8_STAGE(PG8_SA(0, 0), a2, voffA);
            PG8_WAIT_V(8); PG8_WAIT_L(0); PG8_BAR; PG8_MMA(1, 0, At, B0); PG8_MMA(1, 1, At, B1); PG8_BAR; PG8_SCHED;
            PG8_LDB(B0, 1, 0); PG8_LDB(B1, 1, 1); PG8_SCHED; PG8_LDA(At, 1, 0); PG8_STAGE(PG8_SA(0, 1), a2 + hstep, voffA);
            PG8_WAIT_V(8); PG8_WAIT_L(0); PG8_BAR; PG8_MMA(0, 0, At, B0); PG8_MMA(0, 1, At, B1); PG8_BAR; PG8_SCHED;
            PG8_LDA(At, 1, 1); PG8_STAGE(PG8_SB(1, 0), b3, voffB); PG8_STAGE(PG8_SB(1, 1), b3 + hstep, voffB); PG8_STAGE(PG8_SA(1, 0), a3, voffA);
            PG8_WAIT_V(8); PG8_WAIT_L(0); PG8_BAR; PG8_MMA(1, 0, At, B0); PG8_MMA(1, 1, At, B1); PG8_BAR; PG8_SCHED;
            } else {
            PG8_LDB(B0, 0, 0); PG8_SCHED; PG8_LDA(At, 0, 0); PG8_STAGE(PG8_SA(1, 1), a1 + hstep, voffA);
            PG8_WAIT_L(8); PG8_BAR; PG8_WAIT_L(0); PG8_MMA(0, 0, At, B0); PG8_BAR; PG8_SCHED;
            PG8_LDB(B1, 0, 1); PG8_STAGE(PG8_SB(0, 0), b2, voffB);
            PG8_BAR; PG8_WAIT_L(0); PG8_MMA(0, 1, At, B1); PG8_BAR;
            PG8_LDA(At, 0, 1); PG8_STAGE(PG8_SA(0, 0), a2, voffA);
            PG8_BAR; PG8_WAIT_L(0); PG8_MMA(1, 0, At, B0); PG8_BAR; PG8_SCHED;
            PG8_STAGE(PG8_SB(0, 1), b2 + hstep, voffB);
            PG8_WAIT_V(6); PG8_BAR; PG8_MMA(1, 1, At, B1); PG8_BAR;
            PG8_LDB(B0, 1, 0); PG8_SCHED; PG8_LDA(At, 1, 0); PG8_STAGE(PG8_SA(0, 1), a2 + hstep, voffA);
            PG8_WAIT_L(8); PG8_BAR; PG8_WAIT_L(0); PG8_MMA(0, 0, At, B0); PG8_BAR; PG8_SCHED;
            PG8_LDB(B1, 1, 1); PG8_STAGE(PG8_SB(1, 0), b3, voffB);
            PG8_BAR; PG8_WAIT_L(0); PG8_MMA(0, 1, At, B1); PG8_BAR;
            PG8_LDA(At, 1, 1); PG8_STAGE(PG8_SA(1, 0), a3, voffA);
            PG8_BAR; PG8_WAIT_L(0); PG8_MMA(1, 0, At, B0); PG8_BAR; PG8_SCHED;
            PG8_STAGE(PG8_SB(1, 1), b3 + hstep, voffB);
            PG8_WAIT_V(6); PG8_BAR; PG8_MMA(1, 1, At, B1); PG8_BAR;
            }
        }
        if constexpr (ALIGN_EPI) { if (wr == 0) PG8_BAR; }
        if constexpr (!Epi::AFTER_DRAIN) { E(acc, cur, wr, wc, fr, fq); S.done(cur); }
        if (!has_next) break;
#pragma unroll
        for (int a = 0; a < 2; ++a)
#pragma unroll
            for (int b = 0; b < 2; ++b)
#pragma unroll
                for (int m = 0; m < 4; ++m)
#pragma unroll
                    for (int n = 0; n < 2; ++n) acc[a][b][m][n] = (f32x4){zf_, zf_, zf_, zf_};
        asm volatile("" : "+v"(zf_));
        cur = nxt; cA = nA; cB = nB; ++ui;
        if constexpr (ALIGN_EPI) { if (wr == 1) PG8_BAR; }
    }
    PG8_WAIT_V(0);
    if constexpr (!ALIGN_EPI) { if (wr == 0) PG8_BAR; }
    PG8_BAR;
    if constexpr (Epi::AFTER_DRAIN) { E.fused(acc, cur, wr, wc, fr, fq, lds, wid, lane); S.done(cur); }
#undef PG8_SA
#undef PG8_SB
#undef PG8_STAGE
#undef PG8_LDA
#undef PG8_LDB
#undef PG8_MMA
#undef PG8_WAIT_V
#undef PG8_WAIT_L
#undef PG8_BAR
#undef PG8_SCHED
}
}

#define GAS __attribute__((address_space(1)))
#define LAS __attribute__((address_space(3)))
typedef float f32x4 __attribute__((ext_vector_type(4)));
typedef unsigned u32x4 __attribute__((ext_vector_type(4)));
constexpr int NWAVES = 8, NTHREADS = 512;
constexpr int RING_BYTES = 131072, LDSCTL_OFF = RING_BYTES, LDS_BYTES = 147456;
constexpr int NPAD = 11264;
constexpr size_t WS_WIN = WS_END;
constexpr size_t WS_WUQ = WS_WIN + (size_t)NPAD * 1024 * 2;
constexpr size_t WS_WUKV = WS_WUQ + (size_t)768 * 384 * 2;
constexpr size_t WS_W1 = WS_WUKV + (size_t)1024 * 128 * 2;
constexpr size_t WS_WABC = WS_W1 + (size_t)2 * 256 * 2048 * 2;
constexpr size_t WS_WOUT = WS_WABC + (size_t)3 * 1024 * 512 * 2;
constexpr size_t WS_WPLG = WS_WOUT + (size_t)1024 * 1024 * 2;
constexpr size_t WS_WPLE = WS_WPLG + (size_t)1024 * 1024 * 2;
constexpr size_t WS_PBF = WS_WPLE + (size_t)1024 * 256 * 2;
constexpr size_t WS_END2 = WS_PBF + (size_t)T * 256 * 2;
constexpr int CW_BAR = 4096;

DI unsigned pk2(float lo, float hi) { return (unsigned)f2bf(lo) | ((unsigned)f2bf(hi) << 16); }
DI u32x4 pack8(f32x4 a, f32x4 b) { u32x4 w; w.x = pg8::cvt_pk_bf16(a[0], a[1]); w.y = pg8::cvt_pk_bf16(a[2], a[3]); w.z = pg8::cvt_pk_bf16(b[0], b[1]); w.w = pg8::cvt_pk_bf16(b[2], b[3]); return w; }
DI float shx(float v, int lane, int m) { return __int_as_float(__builtin_amdgcn_ds_bpermute((lane ^ m) << 2, __float_as_int(v))); }
DI float sigf(float x) { return __builtin_amdgcn_rcpf(1.f + __expf(-x)); }
DI int epi_lane() { int lane; asm volatile("v_mbcnt_lo_u32_b32 %0, -1, 0\n\tv_mbcnt_hi_u32_b32 %0, -1, %0" : "=v"(lane)); return lane; }
DI float bflo(unsigned w) { return __uint_as_float(w << 16); }
DI float bfhi(unsigned w) { return __uint_as_float(w & 0xffff0000u); }

DI int win_rowmap(int c) {
    if (c < 512) return A_AQ + c;
    if (c < 1280) return A_AKV + c - 512;
    if (c < 1304) return LDA + B_GATE + c - 1280;
    if (c < 1816) return LDA + B_ZA + c - 1304;
    if (c < 2200) return A_BCQ + c - 1816;
    if (c < 2328) return A_BCKV + c - 2200;
    if (c < 2360) return A_BKR + c - 2328;
    if (c < 2872) return LDA + B_ZB + c - 2360;
    if (c < 7480) return A_CQKV + c - 2872;
    if (c < 7992) return LDA + B_ZC + c - 7480;
    return LDA + B_MG + c - 7992;
}
constexpr int WIN_VALID = LDA + B_GATE + 24;

using pg8::Unit;
struct EpiWin { static constexpr bool PERM = true, AFTER_DRAIN = false;
    bf16_t* ua; bf16_t* ub; const float* tab;
    DI void operator()(const f32x4 (&acc)[2][2][4][2], const Unit& u, int wr, int wc, int, int) const {
        const int tl_ = epi_lane(); const int fr = tl_ & 15, fq = tl_ >> 4;
        const int lane = fr + 16 * fq;
#pragma unroll
        for (int bj = 0; bj < 2; ++bj) {
            const int c32 = u.pn * 256 + bj * 128 + wc * 32;
            const int n0 = c32 + 8 * fq;
            int kind = 0;
            if (c32 < 512) kind = ((c32 & 63) == 0) ? 1 : 0;
            else if (c32 < 1280) kind = (((((c32 - 512) >> 7) & 1) == 0) && ((c32 & 63) == 0)) ? 1 : 0;
            else if (c32 >= A_BKR && c32 < A_CQKV) kind = 2;
            else if (c32 >= A_CQKV && c32 < LDA) { const int cc = c32 - A_CQKV; kind = (((cc % 1536) < 1024) && ((cc & 63) == 0)) ? 1 : 0; }
            bf16_t* dst; int ld;
            if (n0 < LDA) { dst = ua + n0; ld = LDA; } else { dst = ub + (n0 - LDA); ld = LDB; }
            const bool wr_ok = n0 < WIN_VALID;
#pragma unroll
            for (int ai = 0; ai < 2; ++ai)
#pragma unroll
                for (int m = 0; m < 4; ++m) { __builtin_amdgcn_sched_barrier(0);
                    const int row = u.pm * 256 + ai * 128 + wr * 64 + m * 16 + fr;
                    f32x4 v0 = acc[ai][bj][m][0], v1 = acc[ai][bj][m][1];
                    if (kind == 1) {
                        f32x4 p0, p1;
#pragma unroll
                        for (int e = 0; e < 4; ++e) { p0[e] = shx(v0[e], lane, 16); p1[e] = shx(v1[e], lane, 16); }
                        if (fq < 2) {
                            const float* tb = tab + (size_t)row * 48;
                            const f32x4 c0 = *(const f32x4*)(tb), c1 = *(const f32x4*)(tb + 4), s0 = *(const f32x4*)(tb + 8), s1 = *(const f32x4*)(tb + 12);
                            const float sg = (fq == 0) ? -1.f : 1.f;
                            v0 = v0 * c0 + sg * (p0 * s0); v1 = v1 * c1 + sg * (p1 * s1);
                        }
                    } else if (kind == 2) {
                        f32x4 p0, p1;
#pragma unroll
                        for (int e = 0; e < 4; ++e) { p0[e] = shx(v0[e], lane, 32); p1[e] = shx(v1[e], lane, 32); }
                        const float* tb = tab + (size_t)row * 48 + 16 + (fq & 1) * 8;
                        const f32x4 c0 = *(const f32x4*)(tb), c1 = *(const f32x4*)(tb + 4), s0 = *(const f32x4*)(tb + 16), s1 = *(const f32x4*)(tb + 20);
                        const float sg = (fq < 2) ? -1.f : 1.f;
                        v0 = v0 * c0 + sg * (p0 * s0); v1 = v1 * c1 + sg * (p1 * s1);
                    }
                    if (wr_ok) *(u32x4*)(dst + (size_t)row * ld) = pack8(v0, v1);
                }
        }
    }
};
struct EpiQm { static constexpr bool PERM = true, AFTER_DRAIN = false;
    bf16_t* qm; const float* tab;
    DI void operator()(const f32x4 (&acc)[2][2][4][2], const Unit& u, int wr, int wc, int, int) const {
        const int tl_ = epi_lane(); const int fr = tl_ & 15, fq = tl_ >> 4;
        const int lane = fr + 16 * fq;
#pragma unroll
        for (int bj = 0; bj < 2; ++bj) {
            const int c32 = u.pn * 256 + bj * 128 + wc * 32;
            const int n0 = c32 + 8 * fq;
            const bool rope = ((c32 >> 5) % 3) == 2;
#pragma unroll
            for (int ai = 0; ai < 2; ++ai)
#pragma unroll
                for (int m = 0; m < 4; ++m) { __builtin_amdgcn_sched_barrier(0);
                    const int row = u.pm * 256 + ai * 128 + wr * 64 + m * 16 + fr;
                    f32x4 v0 = acc[ai][bj][m][0], v1 = acc[ai][bj][m][1];
                    if (rope) {
                        f32x4 p0, p1;
#pragma unroll
                        for (int e = 0; e < 4; ++e) { p0[e] = shx(v0[e], lane, 32); p1[e] = shx(v1[e], lane, 32); }
                        const float* tb = tab + (size_t)row * 48 + 16 + (fq & 1) * 8;
                        const f32x4 c0 = *(const f32x4*)(tb), c1 = *(const f32x4*)(tb + 4), s0 = *(const f32x4*)(tb + 16), s1 = *(const f32x4*)(tb + 20);
                        const float sg = (fq < 2) ? -1.f : 1.f;
                        v0 = v0 * c0 + sg * (p0 * s0); v1 = v1 * c1 + sg * (p1 * s1);
                    }
                    *(u32x4*)(qm + (size_t)row * 768 + n0) = pack8(v0, v1);
                }
        }
    }
};
struct EpiBfPlain { static constexpr bool PERM = true, AFTER_DRAIN = false;
    bf16_t* c; int ldc; int pad;
    DI void operator()(const f32x4 (&acc)[2][2][4][2], const Unit& u, int wr, int wc, int, int) const {
        const int tl_ = epi_lane(); const int fr = tl_ & 15, fq = tl_ >> 4;
#pragma unroll
        for (int bj = 0; bj < 2; ++bj) { const int n0 = u.pn * 256 + bj * 128 + wc * 32 + 8 * fq;
#pragma unroll
            for (int ai = 0; ai < 2; ++ai)
#pragma unroll
                for (int m = 0; m < 4; ++m) { __builtin_amdgcn_sched_barrier(0); const int row = u.pm * 256 + ai * 128 + wr * 64 + m * 16 + fr;
                    *(u32x4*)(c + (size_t)row * ldc + n0) = pack8(acc[ai][bj][m][0], acc[ai][bj][m][1]); } }
    }
};
template <int ACT  > struct EpiF32 { static constexpr bool PERM = true, AFTER_DRAIN = false;
    float* c; int ldc; int pnmask;
    DI void operator()(const f32x4 (&acc)[2][2][4][2], const Unit& u, int wr, int wc, int, int) const {
        const int tl_ = epi_lane(); const int fr = tl_ & 15, fq = tl_ >> 4;
#pragma unroll
        for (int bj = 0; bj < 2; ++bj) { const int n0 = (u.pn & pnmask) * 256 + bj * 128 + wc * 32 + 8 * fq;
#pragma unroll
            for (int ai = 0; ai < 2; ++ai)
#pragma unroll
                for (int m = 0; m < 4; ++m) { __builtin_amdgcn_sched_barrier(0); const int row = u.pm * 256 + ai * 128 + wr * 64 + m * 16 + fr;
                    f32x4 v0 = acc[ai][bj][m][0], v1 = acc[ai][bj][m][1];
                    if (ACT == 1) {
#pragma unroll
                        for (int e = 0; e < 4; ++e) { v0[e] = v0[e] * sigf(v0[e]); v1[e] = v1[e] * sigf(v1[e]); } }
                    float* p = c + (size_t)row * ldc + n0; *(f32x4*)p = v0; *(f32x4*)(p + 4) = v1; } }
    }
};
struct EpiYabc { static constexpr bool PERM = true, AFTER_DRAIN = false;
    float* ymix; bf16_t* ymixb; const bf16_t* ub;
    DI void operator()(const f32x4 (&acc)[2][2][4][2], const Unit& u, int wr, int wc, int, int) const {
        const int tl_ = epi_lane(); const int fr = tl_ & 15, fq = tl_ >> 4;
        const int x = u.pm >> 6, pm = u.pm & 63, pn = u.pn & 3;
#pragma unroll
        for (int bj = 0; bj < 2; ++bj) { const int n0 = pn * 256 + bj * 128 + wc * 32 + 8 * fq;
#pragma unroll
            for (int ai = 0; ai < 2; ++ai)
#pragma unroll
                for (int m = 0; m < 4; ++m) { __builtin_amdgcn_sched_barrier(0); const int row = pm * 256 + ai * 128 + wr * 64 + m * 16 + fr;
                    const u32x4 gw = *(const u32x4*)(ub + (size_t)row * LDB + B_MG + x * 1024 + n0);
                    f32x4 g0, g1; g0[0] = sigf(bflo(gw.x)); g0[1] = sigf(bfhi(gw.x)); g0[2] = sigf(bflo(gw.y)); g0[3] = sigf(bfhi(gw.y));
                    g1[0] = sigf(bflo(gw.z)); g1[1] = sigf(bfhi(gw.z)); g1[2] = sigf(bflo(gw.w)); g1[3] = sigf(bfhi(gw.w));
                    f32x4 v0 = acc[ai][bj][m][0] * g0, v1 = acc[ai][bj][m][1] * g1;
                    float* p = ymix + (size_t)row * D + n0;
                    if (x > 0) { v0 = v0 + *(const f32x4*)p; v1 = v1 + *(const f32x4*)(p + 4); }
                    if (x < 2) { *(f32x4*)p = v0; *(f32x4*)(p + 4) = v1; }
                    else *(u32x4*)(ymixb + (size_t)row * D + n0) = pack8(v0, v1); } }
    }
};
struct EpiPlgF { static constexpr bool PERM = true, AFTER_DRAIN = false;
    float* x; const float* e;
    DI void operator()(const f32x4 (&acc)[2][2][4][2], const Unit& u, int wr, int wc, int, int) const {
        const int tl_ = epi_lane(); const int fr = tl_ & 15, fq = tl_ >> 4;
#pragma unroll
        for (int bj = 0; bj < 2; ++bj) { const int n0 = u.pn * 256 + bj * 128 + wc * 32 + 8 * fq;
#pragma unroll
            for (int ai = 0; ai < 2; ++ai)
#pragma unroll
                for (int m = 0; m < 4; ++m) { __builtin_amdgcn_sched_barrier(0); const int row = u.pm * 256 + ai * 128 + wr * 64 + m * 16 + fr;
                    const size_t o = (size_t)row * D + n0;
                    f32x4 v0 = acc[ai][bj][m][0], v1 = acc[ai][bj][m][1];
                    const f32x4 e0 = *(const f32x4*)(e + o), e1 = *(const f32x4*)(e + o + 4);
                    f32x4 x0 = *(const f32x4*)(x + o), x1 = *(const f32x4*)(x + o + 4);
#pragma unroll
                    for (int k = 0; k < 4; ++k) { x0[k] += sigf(v0[k]) * e0[k]; x1[k] += sigf(v1[k]) * e1[k]; }
                    *(f32x4*)(x + o) = x0; *(f32x4*)(x + o + 4) = x1; } }
    }
};
struct YabcOrder {
    int G, vcu;
    DI bool next(int i, Unit& u) const { const int tile = (i / 3) * G + vcu, x = i % 3; if (tile >= 256) return false; u.pm = x * 64 + (tile >> 2); u.pn = x * 4 + (tile & 3); return true; }
    DI void a_ready(const Unit&) const {}
    DI void done(const Unit&) const {}
};
struct HidOrder {
    int G, c;
    DI bool next(int i, Unit& u) const { const int id = c - (G - 16); if (i > 0 || id < 0) return false; u.pm = id; u.pn = id >> 3; return true; }
    DI void a_ready(const Unit&) const {}
    DI void done(const Unit&) const {}
};
DI void tr_item(const float* W, int K, int N, bf16_t* WT, LAS float* scr, int item, int lane, bool perm) {
    const int nblk = (N + 31) / 32, kb = item / nblk, nb = item % nblk, k0 = 64 * kb, n0 = 32 * nb;
    const int nn = n0 + (lane & 31);
#pragma unroll 8
    for (int i = 0; i < 32; ++i) { const int kk = 2 * i + (lane >> 5); scr[kk * 33 + (lane & 31)] = (nn < N) ? W[(size_t)(k0 + kk) * N + nn] : 0.f; }
    asm volatile("s_waitcnt lgkmcnt(0)" ::: "memory");
    const int c = lane & 7;
#pragma unroll
    for (int j = 0; j < 4; ++j) { const int n = (lane >> 3) + 8 * j; const LAS float* s = scr + (8 * c) * 33 + n;
        u32x4 o; o.x = pk2(s[0 * 33], s[1 * 33]); o.y = pk2(s[2 * 33], s[3 * 33]); o.z = pk2(s[4 * 33], s[5 * 33]); o.w = pk2(s[6 * 33], s[7 * 33]);
        if (n0 + n < N) { const int rr = perm ? win_rowmap(n0 + n) : (n0 + n); *(u32x4*)(WT + (size_t)rr * K + k0 + 8 * c) = o; } }
    asm volatile("s_waitcnt lgkmcnt(0)" ::: "memory");
}
struct RmIdent { int off; DI int operator()(int n) const { return off + n; } };
struct RmWin { DI int operator()(int n) const { return win_rowmap(n); } };

DI float wsum(float v, int lane) {
#pragma unroll
    for (int o = 1; o < 64; o <<= 1) v += shx(v, lane, o);
    return v;
}
DI void rms_row_f32(const float* xrow, const float* g, bf16_t* orow, int lane) {
    const f32x4* xr = (const f32x4*)xrow + lane; const f32x4* gr = (const f32x4*)g + lane;
    f32x4 v[4]; float s = 0.f;
#pragma unroll
    for (int j = 0; j < 4; ++j) { v[j] = xr[64 * j]; s += (v[j][0] * v[j][0] + v[j][1] * v[j][1]) + (v[j][2] * v[j][2] + v[j][3] * v[j][3]); }
    const float rs = rsqrtf(wsum(s, lane) * (1.f / 1024.f) + 1e-6f);
    unsigned long long* o8 = (unsigned long long*)orow + lane;
#pragma unroll
    for (int j = 0; j < 4; ++j) { const f32x4 gg = gr[64 * j];
        o8[64 * j] = (unsigned long long)pk2(v[j][0] * rs * gg[0], v[j][1] * rs * gg[1]) | ((unsigned long long)pk2(v[j][2] * rs * gg[2], v[j][3] * rs * gg[3]) << 32); }
}

#define XB_TMO      128
#define XB_XCNT(j)  (256  + 64 * (j))
#define XB_XSUB(j)  (1280 + 64 * (j))
#define XB_XGEN(j)  (2304 + 64 * (j))
#define XB_TOP      3328
#define XB_TOPGEN   3392
#define XCD_BAR_WORDS 3456
#define XB_SPIN_CAP (1u << 18)

__device__ __forceinline__ unsigned xb_ld(unsigned* p)              { return __hip_atomic_load(p, __ATOMIC_RELAXED, __HIP_MEMORY_SCOPE_AGENT); }
__device__ __forceinline__ unsigned xb_add(unsigned* p, unsigned v) { return __hip_atomic_fetch_add(p, v, __ATOMIC_RELAXED, __HIP_MEMORY_SCOPE_AGENT); }
__device__ __forceinline__ unsigned xb_xcc_id() { return (unsigned)__builtin_amdgcn_s_getreg((3 << 11) | 20) & 0xFu; }
#define XB_SPIN(cond, bar) do { unsigned _sp = 0; while (cond) { __builtin_amdgcn_s_sleep(1); \
    if ((++_sp & 255u) == 0u) { if (xb_ld(&(bar)[XB_TMO])) break; if (_sp > XB_SPIN_CAP) { atomicAdd(&(bar)[XB_TMO], 1u); break; } } } } while (0)

struct XcdBarrier {
    unsigned* bar; unsigned x;
    volatile LAS unsigned* st;
};

__device__ __forceinline__ XcdBarrier xcd_barrier_post(unsigned* bar, volatile LAS unsigned* st) {
    XcdBarrier b; b.bar = bar; b.x = xb_xcc_id(); b.st = st;
    if (threadIdx.x == 0) (void)xb_add(&bar[XB_XCNT(b.x)], 1u);
    return b;
}
__device__ __forceinline__ void xcd_barrier_complete(unsigned* bar, unsigned x, unsigned& nloc, unsigned& nx) {
    const unsigned G = gridDim.x * gridDim.y * gridDim.z;
    unsigned sum, cnt, mine, sp = 0u;
    for (;;) {
        sum = 0u; cnt = 0u; mine = 0u;
#pragma unroll
        for (unsigned j = 0; j < 16; ++j) { const unsigned c = xb_ld(&bar[XB_XCNT(j)]); sum += c; cnt += (c > 0u) ? 1u : 0u; mine = (j == x) ? c : mine; }
        if (sum == G) break;
        __builtin_amdgcn_s_sleep(1);
        if ((++sp & 255u) == 0u) { if (xb_ld(&bar[XB_TMO])) break; if (sp > XB_SPIN_CAP) { atomicAdd(&bar[XB_TMO], 1u); break; } }
    }
    nloc = mine > 0u ? mine : 1u; nx = cnt > 0u ? cnt : 1u;
}

__device__ __forceinline__ void xcd_barrier(const XcdBarrier& b) {
    asm volatile("s_waitcnt vmcnt(0)" ::: "memory");
    __syncthreads();
    if (threadIdx.x == 0) {
        unsigned* bar = b.bar;
        __builtin_amdgcn_s_waitcnt(0);
        unsigned nloc = b.st[0], nx = b.st[1];
        if (nloc == 0u) { xcd_barrier_complete(bar, b.x, nloc, nx); b.st[0] = nloc; b.st[1] = nx; }
        const unsigned old = xb_add(&bar[XB_XSUB(b.x)], 1u);
        const unsigned gen = old / nloc;
        if (old + 1u == (gen + 1u) * nloc) {
            __builtin_amdgcn_fence(__ATOMIC_RELEASE, "agent");
            asm volatile("s_waitcnt vmcnt(0)" ::: "memory");
            const unsigned og = xb_add(&bar[XB_TOP], 1u);
            const unsigned tg = og / nx;
            if (og + 1u == (tg + 1u) * nx) xb_add(&bar[XB_TOPGEN], 1u);
            else XB_SPIN(xb_ld(&bar[XB_TOPGEN]) == tg, bar);
            __builtin_amdgcn_fence(__ATOMIC_ACQUIRE, "agent");
            xb_add(&bar[XB_XGEN(b.x)], 1u);
            asm volatile("s_waitcnt vmcnt(0)" ::: "memory");
        } else {
            XB_SPIN(xb_ld(&bar[XB_XGEN(b.x)]) == gen, bar);
            __builtin_amdgcn_fence(__ATOMIC_ACQUIRE, "agent");
            asm volatile("s_waitcnt vmcnt(0)" ::: "memory");
        }
    }
    __syncthreads();
}

enum { PH_CONV = 0, PH_WIN, PH_PREP, PH_G2, PH_KC, PH_ATT1, PH_ATT2, PH_COMB, PH_YABC, PH_WOUT, PH_POST, PH_PLE, PH_COUNT };
struct MArgs { const void* in[19]; float* out; unsigned char* ws; int ph_lo, ph_hi, l_lo, l_hi; };
static_assert(sizeof(MArgs) == 19 * 8 + 8 + 8 + 16, "no padding");

typedef __attribute__((address_space(4))) const char* kptr_t;
DI kptr_t kbase() { kptr_t p = (kptr_t)__builtin_amdgcn_kernarg_segment_ptr(); asm volatile("" : "+s"(p)); return p; }
template <typename Tp> DI Tp* kload_ptr(int off) { typedef Tp* ptr_t; typedef __attribute__((address_space(4))) const ptr_t* slot_t; return *(slot_t)(kbase() + off); }
DI int kload_int(int off) { typedef __attribute__((address_space(4))) const int* slot_t; return *(slot_t)(kbase() + off); }
#define KIN(type, i) kload_ptr<type>(8 * (i))
#define KOUT() kload_ptr<float>(152)
#define KWS() kload_ptr<unsigned char>(160)
#define KINT(off) kload_int(off)
#define WSP(type, off) ((type*)(KWS() + (off)))

DI void grid_barrier(unsigned* barw) {
    extern __shared__ __attribute__((aligned(16))) unsigned char lds_raw[];
    XcdBarrier b; b.bar = barw; b.x = xb_xcc_id(); b.st = (volatile LAS unsigned*)((LAS unsigned char*)lds_raw + LDSCTL_OFF + 64);
    xcd_barrier(b);
}

__global__ void __launch_bounds__(NTHREADS, 2) mega(MArgs) {
    extern __shared__ __attribute__((aligned(16))) unsigned char lds_raw[];
    LAS unsigned char* lds = (LAS unsigned char*)lds_raw;
#define G ((int)gridDim.x)
#define bx ((int)blockIdx.x)
#define vcu ((G % 8 == 0) ? (bx % 8) * (G / 8) + bx / 8 : bx)
#define NGW (G * NWAVES)
    for (int u = threadIdx.x; u < (LDS_BYTES - LDSCTL_OFF) / 4; u += NTHREADS) ((LAS unsigned*)(lds + LDSCTL_OFF))[u] = 0u;
    __syncthreads();
    pg8::hw_tid_init(lds);
    __syncthreads();
    (void)xcd_barrier_post(WSP(unsigned, WS_CTL) + CW_BAR, (volatile LAS unsigned*)(lds + LDSCTL_OFF + 64));
#define GRID_BAR() grid_barrier(WSP(unsigned, WS_CTL) + CW_BAR)

#define IN(k) (KINT(168) <= (k) && (k) < KINT(172))
#define SEAM(k) do { if (IN(k) && (IN((k) + 1) || ((k) == PH_COUNT - 1 && L + 1 < KINT(180) && KINT(168) == 0))) GRID_BAR(); } while (0)

    for (int L = KINT(176); L < KINT(180); ++L) {
        if (IN(PH_CONV)) {
            const float* w_in = KIN(const float, 5); const float* w_uq = KIN(const float, 11); const float* w_ukv = KIN(const float, 13); const float* cmp_w1 = KIN(const float, 7);
            const float* w_a = KIN(const float, 9); const float* w_b = KIN(const float, 14); const float* w_c = KIN(const float, 15); const float* w_out = KIN(const float, 16);
            const float* w_ple = KIN(const float, 17); const float* w_plg = KIN(const float, 18);
            bf16_t* WinT = WSP(bf16_t, WS_WIN); bf16_t* WuqT = WSP(bf16_t, WS_WUQ); bf16_t* WukvT = WSP(bf16_t, WS_WUKV); bf16_t* W1T = WSP(bf16_t, WS_W1);
            bf16_t* WabcT = WSP(bf16_t, WS_WABC); bf16_t* WoutT = WSP(bf16_t, WS_WOUT); bf16_t* WplgT = WSP(bf16_t, WS_WPLG); bf16_t* WpleT = WSP(bf16_t, WS_WPLE);
            int tid_ = pg8::hw_tid(lds); asm volatile("" : "+v"(tid_)); const int tid = tid_, lane = tid & 63, wave = __builtin_amdgcn_readfirstlane(tid >> 6); const int gw = vcu * NWAVES + wave;
            LAS float* scr = (LAS float*)(lds + wave * 16384);
            constexpr int I_IN = 16 * 346, I_UQ = 6 * 24, I_UKV = 2 * 32, I_W1 = 32 * 8, I_ABC = 8 * 32, I_OUT = 16 * 32, I_PLE = 4 * 32;
            constexpr int NITEMS = I_IN + I_UQ + I_UKV + 2 * I_W1 + 3 * I_ABC + 2 * I_OUT + I_PLE;
            for (int it = gw; it < NITEMS; it += NGW) {
                int r = it; const float* src; bf16_t* dst; int K_, N_; bool perm = false;
                if (r < I_IN) { src = w_in + (size_t)L * D * DIN; dst = WinT; K_ = D; N_ = DIN; perm = true; }
                else if ((r -= I_IN) < I_UQ) { src = w_uq + (size_t)L * 384 * 768; dst = WuqT; K_ = 384; N_ = 768; }
                else if ((r -= I_UQ) < I_UKV) { src = w_ukv + (size_t)L * 128 * 1024; dst = WukvT; K_ = 128; N_ = 1024; }
                else if ((r -= I_UKV) < 2 * I_W1) { const int kv = r / I_W1; r %= I_W1; src = cmp_w1 + ((size_t)L * 2 + kv) * 2048 * 256; dst = W1T + (size_t)kv * 256 * 2048; K_ = 2048; N_ = 256; }
                else if ((r -= 2 * I_W1) < 3 * I_ABC) { const int x = r / I_ABC; r %= I_ABC; src = (x == 0 ? w_a : x == 1 ? w_b : w_c) + (size_t)L * 512 * D; dst = WabcT + (size_t)x * 1024 * 512; K_ = 512; N_ = D; }
                else if ((r -= 3 * I_ABC) < I_OUT) { src = w_out + (size_t)L * D * D; dst = WoutT; K_ = D; N_ = D; }
                else if ((r -= I_OUT) < I_OUT) { src = w_plg + (size_t)L * D * D; dst = WplgT; K_ = D; N_ = D; }
                else { r -= I_OUT; src = w_ple + (size_t)L * 256 * D; dst = WpleT; K_ = 256; N_ = D; }
                tr_item(src, K_, N_, dst, scr, r, lane, perm);
            }
            { const int nz = (NPAD - WIN_VALID) * 1024 / 8; unsigned z0 = 0u; asm volatile("" : "+v"(z0)); u32x4 z = {z0, z0, z0, z0};
              for (int i = gw * 64 + lane; i < nz; i += NGW * 64) *(u32x4*)(WinT + (size_t)WIN_VALID * 1024 + (size_t)i * 8) = z; }
            { const float* p_in = KIN(const float, 1); bf16_t* PBF = WSP(bf16_t, WS_PBF); const float* ps = p_in + (size_t)L * T * 256; const int n8 = T * 256 / 8;
              for (int i = gw * 64 + lane; i < n8; i += NGW * 64) { const f32x4 a = *(const f32x4*)(ps + (size_t)i * 8), b = *(const f32x4*)(ps + (size_t)i * 8 + 4);
                  u32x4 w; w.x = pk2(a[0], a[1]); w.y = pk2(a[2], a[3]); w.z = pk2(b[0], b[1]); w.w = pk2(b[2], b[3]); *(u32x4*)(PBF + (size_t)i * 8) = w; } }
            if (L == 0) {
                const int* pos = KIN(const int, 2); float* TAB = WSP(float, WS_TAB);
                for (int i = gw * 64 + lane; i < T * 24; i += NGW * 64) {
                    const int t = i / 24, j = i % 24; const float p = (float)pos[t];
                    if (j < 8) { const float a = p * powf(500000.0f, -(float)(2 * j) / 16.0f); TAB[(size_t)t * 48 + j] = cosf(a); TAB[(size_t)t * 48 + 8 + j] = sinf(a); }
                    else { const int jj = j - 8; const float a = p * powf(500000.0f, -(float)(2 * jj) / 32.0f); TAB[(size_t)t * 48 + 16 + jj] = cosf(a); TAB[(size_t)t * 48 + 32 + jj] = sinf(a); }
                }
            }
            { const float* xout = KOUT(); const float* g_pre = KIN(const float, 3); bf16_t* H = WSP(bf16_t, WS_H);
              for (int m = gw; m < T; m += NGW) rms_row_f32(xout + (size_t)m * D, g_pre + (size_t)L * D, H + (size_t)m * D, lane); }
        }
        SEAM(PH_CONV);
        if (IN(PH_WIN)) {
            pg8::Gemm g{WSP(bf16_t, WS_H), WSP(bf16_t, WS_WIN), T, NPAD, D}; pg8::StaticOrder S; S.init(T, NPAD, G, bx);
            EpiWin Ep{WSP(bf16_t, WS_UA), WSP(bf16_t, WS_UB), WSP(float, WS_TAB)};
            pg8::gemm_phase<EpiWin, pg8::StaticOrder, true, true>(lds, g, S, Ep);
        }
        SEAM(PH_WIN);
        SEAM(PH_PREP);
        if (IN(PH_G2)) {
            { pg8::Gemm g{WSP(bf16_t, WS_QN), WSP(bf16_t, WS_WUQ), T, 768, 384}; pg8::StaticOrder S; S.init(T, 768, G, bx); EpiQm Ep{WSP(bf16_t, WS_QM), WSP(float, WS_TAB)};
              pg8::gemm_phase<EpiQm, pg8::StaticOrder, true, true>(lds, g, S, Ep); }
            __syncthreads();
            { pg8::Gemm g{WSP(bf16_t, WS_KVN), WSP(bf16_t, WS_WUKV), T, 1024, 128}; pg8::StaticOrder S; S.init(T, 1024, G, bx); EpiBfPlain Ep{WSP(bf16_t, WS_KVU), 1024, 0};
              pg8::gemm_phase<EpiBfPlain, pg8::StaticOrder, true, true>(lds, g, S, Ep); }
            __syncthreads();
            { pg8::Gemm g{WSP(bf16_t, WS_FLAT), WSP(bf16_t, WS_W1), 2 * CROWS, 512, 2048}; HidOrder S{G, bx};
              EpiF32<1> Ep{WSP(float, WS_HID), 256, 0};
              pg8::gemm_phase<EpiF32<1>, HidOrder, true, true>(lds, g, S, Ep); }
        }
        SEAM(PH_G2);
        SEAM(PH_KC); SEAM(PH_ATT1); SEAM(PH_ATT2); SEAM(PH_COMB);
        if (IN(PH_YABC)) {
            pg8::Gemm g{WSP(bf16_t, WS_O7), WSP(bf16_t, WS_WABC), 3 * T, 3 * 1024, 512}; YabcOrder S{G, vcu};
            EpiYabc Ep{WSP(float, WS_YMIX), WSP(bf16_t, WS_YMIXB), WSP(bf16_t, WS_UB)};
            pg8::gemm_phase<EpiYabc, YabcOrder, true, true>(lds, g, S, Ep);
        }
        SEAM(PH_YABC);
        if (IN(PH_WOUT)) {
            pg8::Gemm g{WSP(bf16_t, WS_YMIXB), WSP(bf16_t, WS_WOUT), T, D, D}; pg8::StaticOrder S; S.init(T, D, G, bx);
            EpiF32<0> Ep{WSP(float, WS_Y2), D, -1};
            pg8::gemm_phase<EpiF32<0>, pg8::StaticOrder, true, true>(lds, g, S, Ep);
        }
        SEAM(PH_WOUT);
        SEAM(PH_POST);
        if (IN(PH_PLE)) {
            { pg8::Gemm g{WSP(bf16_t, WS_PBF), WSP(bf16_t, WS_WPLE), T, D, 256}; pg8::StaticOrder S; S.init(T, D, G, bx); EpiF32<0> Ep{WSP(float, WS_E), D, -1};
              pg8::gemm_phase<EpiF32<0>, pg8::StaticOrder, true, true>(lds, g, S, Ep); }
            __syncthreads();
            { pg8::Gemm g{WSP(bf16_t, WS_H), WSP(bf16_t, WS_WPLG), T, D, D}; pg8::StaticOrder S; S.init(T, D, G, bx); EpiPlgF Ep{KOUT(), WSP(float, WS_E)};
              pg8::gemm_phase<EpiPlgF, pg8::StaticOrder, true, true>(lds, g, S, Ep); }
        }
        SEAM(PH_PLE);
    }
#undef IN
#undef SEAM
#undef G
#undef bx
#undef vcu
#undef NGW
}

static void launch_mega(hipStream_t st, void* const* d_in, void* d_out, void* d_ws, int ph_lo, int ph_hi, int l_lo, int l_hi) {
    MArgs a{};
    for (int i = 0; i < 19; ++i) a.in[i] = d_in[i];
    a.out = (float*)d_out; a.ws = (unsigned char*)d_ws; a.ph_lo = ph_lo; a.ph_hi = ph_hi; a.l_lo = l_lo; a.l_hi = l_hi;
    (void)hipMemsetAsync((char*)d_ws + WS_CTL, 0, 1 << 20, st);
    hipLaunchKernelGGL(mega, dim3(256), dim3(NTHREADS), LDS_BYTES, st, a);
}
template <typename TA, class Epi>
static void gemm(hipStream_t st, const TA* A, int lda, const float* Bm, int ldb, int M, int N, int K, Epi epi) {
    dim3 grid((N + 63) / 64, M / 64);
    hipLaunchKernelGGL((k_gemm<TA, Epi>), grid, dim3(256), 0, st, A, lda, Bm, ldb, M, N, K, epi);
}

extern "C" void kernel_launch(void* const* d_in, const int* in_sizes, int n_in, void* d_out, int out_size, void* d_ws, size_t ws_size, hipStream_t stream) {
    if (ws_size < WS_END2) return;
    (void)hipFuncSetAttribute((const void*)mega, hipFuncAttributeMaxDynamicSharedMemorySize, LDS_BYTES);
    const float* x_in = (const float*)d_in[0];
    const float* g_post = (const float*)d_in[4];
    const float* cmp_pe = (const float*)d_in[6];
    const float* cmp_w2 = (const float*)d_in[8];
    const float* g_q = (const float*)d_in[10];
    const float* g_kv = (const float*)d_in[12];
    unsigned char* ws = (unsigned char*)d_ws;
    float* x = (float*)d_out;
    bf16_t* UA = (bf16_t*)(ws + WS_UA); bf16_t* UB = (bf16_t*)(ws + WS_UB); bf16_t* H = (bf16_t*)(ws + WS_H);
    bf16_t* O7 = (bf16_t*)(ws + WS_O7); float* LSE = (float*)(ws + WS_LSE);
    bf16_t* QM = (bf16_t*)(ws + WS_QM); bf16_t* KVU = (bf16_t*)(ws + WS_KVU); bf16_t* FLAT = (bf16_t*)(ws + WS_FLAT);
    float* HID = (float*)(ws + WS_HID); bf16_t* KC = (bf16_t*)(ws + WS_KC); unsigned long long* SEL = (unsigned long long*)(ws + WS_SEL);
    float* Y2 = (float*)(ws + WS_Y2);
    bf16_t* QN = (bf16_t*)(ws + WS_QN); bf16_t* KVN = (bf16_t*)(ws + WS_KVN);
    (void)hipMemcpyAsync(x, x_in, (size_t)T * D * 4, hipMemcpyDeviceToDevice, stream);
    for (int L = 0; L < DEPTH; ++L) {
        launch_mega(stream, d_in, d_out, d_ws, PH_CONV, PH_WIN + 1, L, L + 1);
        hipLaunchKernelGGL((k_rmsnorm<bf16_t>), dim3(T / 4), dim3(256), 0, stream, (const bf16_t*)(UA + A_BCQ), LDA, 384, g_q + (size_t)L * 384, QN, 384, T);
        hipLaunchKernelGGL((k_rmsnorm<bf16_t>), dim3(T / 4), dim3(256), 0, stream, (const bf16_t*)(UA + A_BCKV), LDA, 128, g_kv + (size_t)L * 128, KVN, 128, T);
        hipLaunchKernelGGL(k_flat, dim3((unsigned)(((size_t)2 * CROWS * 2048 + 255) / 256)), dim3(256), 0, stream, (const bf16_t*)UA, cmp_pe + (size_t)L * 2 * 32 * 64, FLAT);
        launch_mega(stream, d_in, d_out, d_ws, PH_G2, PH_G2 + 1, L, L + 1);
        for (int kv = 0; kv < 2; ++kv)
            gemm(stream, (const float*)(HID + (size_t)kv * CROWS * 256), 256, cmp_w2 + ((size_t)L * 2 + kv) * 256 * 64, 64, CROWS, 64, 256, EpiBf{KC + (size_t)kv * CROWS * 64, 64, 0});
        hipLaunchKernelGGL(k_topk, dim3(T * 2 / 4), dim3(256), 0, stream, (const bf16_t*)UA, (const bf16_t*)KC, SEL);
        AttnArgs aa{UA, KC, QM, KVU, SEL, nullptr, LSE};
        aa.out = O7 + 0 * O7_STRIDE; hipLaunchKernelGGL((k_attn<0>), dim3(T * 8 / 2), dim3(128), 0, stream, aa);
        aa.out = O7 + 3 * O7_STRIDE; hipLaunchKernelGGL((k_attn<1>), dim3(T * 8 / 2), dim3(128), 0, stream, aa);
        aa.out = O7 + 4 * O7_STRIDE; hipLaunchKernelGGL((k_attn<2>), dim3(T * 8 / 2), dim3(128), 0, stream, aa);
        aa.out = O7 + 1 * O7_STRIDE; hipLaunchKernelGGL((k_attn<3>), dim3(T * 8 / 2), dim3(128), 0, stream, aa);
        aa.out = O7 + 2 * O7_STRIDE; hipLaunchKernelGGL((k_attn<4>), dim3(T * 8 / 2), dim3(128), 0, stream, aa);
        aa.out = O7 + 5 * O7_STRIDE; hipLaunchKernelGGL((k_attn<5>), dim3(T * 8 / 2), dim3(128), 0, stream, aa);
        aa.out = O7 + 6 * O7_STRIDE; hipLaunchKernelGGL((k_attn<6>), dim3(T * 8 / 2), dim3(128), 0, stream, aa);
        hipLaunchKernelGGL(k_combine, dim3((unsigned)(((size_t)T * 512 + 255) / 256)), dim3(256), 0, stream, O7, (const float*)LSE, (const bf16_t*)UB);
        launch_mega(stream, d_in, d_out, d_ws, PH_YABC, PH_WOUT + 1, L, L + 1);
        hipLaunchKernelGGL(k_post, dim3(T / 4), dim3(256), 0, stream, x, (const float*)Y2, g_post + (size_t)L * D, H);
        launch_mega(stream, d_in, d_out, d_ws, PH_PLE, PH_PLE + 1, L, L + 1);
    }
}
```

```cpp
#include <hip/hip_runtime.h>
#include <stdint.h>
#include <math.h>

typedef unsigned short bf16_t;
#define DI __device__ __forceinline__

constexpr int NB = 4, S = 4096, T = NB * S, D = 1024, DEPTH = 4;
constexpr int DIN = 11064;
constexpr int A_AQ = 0, A_AKV = 512, A_BCQ = 1280, A_BCKV = 1664, A_BKR = 1792, A_CQKV = 1824, LDA = 6432;
constexpr int B_ZA = 0, B_ZB = 512, B_ZC = 1024, B_MG = 1536, B_GATE = 4608, LDB = 4640;
constexpr int NC = 255;
constexpr int CROWS = 2048;

constexpr size_t al256(size_t x) { return (x + 255) & ~(size_t)255; }
constexpr size_t WS_CTL = 0;
constexpr size_t WS_UA = 1 << 20;
constexpr size_t WS_UB = WS_UA + al256((size_t)T * LDA * 2);
constexpr size_t WS_H = WS_UB + al256((size_t)T * LDB * 2);
constexpr size_t WS_O7 = WS_H + al256((size_t)T * 1024 * 2);
constexpr size_t O7_STRIDE = (size_t)T * 512;
constexpr size_t WS_LSE = WS_O7 + al256(7 * O7_STRIDE * 2);
constexpr size_t WS_QM = WS_LSE + al256((size_t)3 * T * 8 * 4);
constexpr size_t WS_KVU = WS_QM + al256((size_t)T * 768 * 2);
constexpr size_t WS_FLAT = WS_KVU + al256((size_t)T * 1024 * 2);
constexpr size_t WS_HID = WS_FLAT + al256((size_t)2 * CROWS * 2048 * 2);
constexpr size_t WS_KC = WS_HID + al256((size_t)2 * CROWS * 256 * 4);
constexpr size_t WS_SEL = WS_KC + al256((size_t)2 * CROWS * 64 * 2);
constexpr size_t WS_TAB = WS_SEL + al256((size_t)T * 2 * 8);
constexpr size_t WS_END = WS_TAB + al256((size_t)T * 48 * 4);
constexpr size_t WS_YMIX = WS_UA;
constexpr size_t WS_YMIXB = WS_YMIX + (size_t)T * 1024 * 4;
constexpr size_t WS_Y2 = WS_YMIXB + (size_t)T * 1024 * 2;
constexpr size_t WS_E = WS_YMIX;
static_assert(WS_Y2 + (size_t)T * 1024 * 4 <= WS_UB, "alias region fits in UA");
constexpr size_t WS_QN = WS_H;
constexpr size_t WS_KVN = WS_H + (size_t)T * 384 * 2;

DI float bf2f(bf16_t v) { return __uint_as_float(((unsigned)v) << 16); }
DI bf16_t f2bf(float f) { unsigned u = __float_as_uint(f); u += 0x7fffu + ((u >> 16) & 1u); return (bf16_t)(u >> 16); }
DI float sigm(float x) { return 1.f / (1.f + __expf(-x)); }
DI float wave_sum(float v) { for (int o = 32; o > 0; o >>= 1) v += __shfl_xor(v, o); return v; }
DI float wave_max(float v) { for (int o = 32; o > 0; o >>= 1) v = fmaxf(v, __shfl_xor(v, o)); return v; }
DI float ldf(const float* p) { return *p; }
DI float ldf(const bf16_t* p) { return bf2f(*p); }

__global__ void k_tables(const int* pos, float* tab) {
    int i = blockIdx.x * blockDim.x + threadIdx.x;
    if (i >= T * 24) return;
    int t = i / 24, j = i % 24;
    float p = (float)pos[t];
    if (j < 8) {
        float inv = powf(500000.0f, -(float)(2 * j) / 16.0f);
        float a = p * inv;
        tab[(size_t)t * 48 + j] = cosf(a); tab[(size_t)t * 48 + 8 + j] = sinf(a);
    } else {
        int jj = j - 8;
        float inv = powf(500000.0f, -(float)(2 * jj) / 32.0f);
        float a = p * inv;
        tab[(size_t)t * 48 + 16 + jj] = cosf(a); tab[(size_t)t * 48 + 32 + jj] = sinf(a);
    }
}

template <typename TIN>
__global__ void k_rmsnorm(const TIN* in, int ld_in, int ncols, const float* g, bf16_t* out, int ld_out, int nrows) {
    int row = blockIdx.x * (blockDim.x >> 6) + (threadIdx.x >> 6), lane = threadIdx.x & 63;
    if (row >= nrows) return;
    const TIN* r = in + (size_t)row * ld_in;
    float ss = 0.f;
    for (int c = lane; c < ncols; c += 64) { float v = ldf(r + c); ss += v * v; }
    ss = wave_sum(ss);
    float rs = rsqrtf(ss / (float)ncols + 1e-6f);
    for (int c = lane; c < ncols; c += 64) out[(size_t)row * ld_out + c] = f2bf(ldf(r + c) * rs * g[c]);
}

__global__ void k_post(float* x, const float* y2, const float* g, bf16_t* xb) {
    int row = blockIdx.x * (blockDim.x >> 6) + (threadIdx.x >> 6), lane = threadIdx.x & 63;
    if (row >= T) return;
    const float* r = y2 + (size_t)row * D;
    float ss = 0.f;
    for (int c = lane; c < D; c += 64) { float v = r[c]; ss += v * v; }
    ss = wave_sum(ss);
    float rs = rsqrtf(ss / (float)D + 1e-6f);
    for (int c = lane; c < D; c += 64) { float v = x[(size_t)row * D + c] + r[c] * rs * g[c]; x[(size_t)row * D + c] = v; xb[(size_t)row * D + c] = f2bf(v); }
}

struct EpiU { bf16_t* ua; bf16_t* ub;
    DI void operator()(int r, int c, float v) const {
        int buf, col;
        if (c < 512) { buf = 0; col = A_AQ + c; }
        else if (c < 1280) { buf = 0; col = A_AKV + c - 512; }
        else if (c < 1304) { buf = 1; col = B_GATE + c - 1280; }
        else if (c < 1816) { buf = 1; col = B_ZA + c - 1304; }
        else if (c < 2200) { buf = 0; col = A_BCQ + c - 1816; }
        else if (c < 2328) { buf = 0; col = A_BCKV + c - 2200; }
        else if (c < 2360) { buf = 0; col = A_BKR + c - 2328; }
        else if (c < 2872) { buf = 1; col = B_ZB + c - 2360; }
        else if (c < 7480) { buf = 0; col = A_CQKV + c - 2872; }
        else if (c < 7992) { buf = 1; col = B_ZC + c - 7480; }
        else { buf = 1; col = B_MG + c - 7992; }
        if (buf == 0) ua[(size_t)r * LDA + col] = f2bf(v); else ub[(size_t)r * LDB + col] = f2bf(v);
    } };
struct EpiBf { bf16_t* c; int ldc; int pad; DI void operator()(int r, int col, float v) const { c[(size_t)r * ldc + col] = f2bf(v); } };
struct EpiF { float* c; int ldc; int pad; DI void operator()(int r, int col, float v) const { c[(size_t)r * ldc + col] = v; } };
struct EpiSilu { float* c; int ldc; int pad; DI void operator()(int r, int col, float v) const { c[(size_t)r * ldc + col] = v * sigm(v); } };
struct EpiYmix { float* ymix; bf16_t* ymixb; const bf16_t* ub; int x; int pad;
    DI void operator()(int r, int col, float v) const {
        float gsc = sigm(bf2f(ub[(size_t)r * LDB + B_MG + x * 1024 + col]));
        float acc = gsc * v;
        if (x > 0) acc += ymix[(size_t)r * D + col];
        ymix[(size_t)r * D + col] = acc;
        if (x == 2) ymixb[(size_t)r * D + col] = f2bf(acc);
    } };
struct EpiPlg { float* x; const float* e; DI void operator()(int r, int col, float v) const { x[(size_t)r * D + col] += sigm(v) * e[(size_t)r * D + col]; } };

template <typename TA, class Epi>
__global__ __launch_bounds__(256) void k_gemm(const TA* A, int lda, const float* Bm, int ldb, int M, int N, int K, Epi epi) {
    __shared__ float As[16][68];
    __shared__ float Bs[16][68];
    const int tid = threadIdx.x, tx = tid & 15, ty = tid >> 4;
    const int m0 = blockIdx.y * 64, n0 = blockIdx.x * 64;
    float acc[4][4] = {};
    for (int k0 = 0; k0 < K; k0 += 16) {
        for (int e = tid; e < 1024; e += 256) { int r = e >> 4, c = e & 15; As[c][r] = ldf(A + (size_t)(m0 + r) * lda + k0 + c); }
        for (int e = tid; e < 1024; e += 256) { int r = e >> 6, c = e & 63; int n = n0 + c; Bs[r][c] = (n < N) ? Bm[(size_t)(k0 + r) * ldb + n] : 0.f; }
        __syncthreads();
#pragma unroll
        for (int k = 0; k < 16; ++k) {
            float a[4], b[4];
#pragma unroll
            for (int i = 0; i < 4; ++i) { a[i] = As[k][ty * 4 + i]; b[i] = Bs[k][tx * 4 + i]; }
#pragma unroll
            for (int i = 0; i < 4; ++i)
#pragma unroll
                for (int j = 0; j < 4; ++j) acc[i][j] += a[i] * b[j];
        }
        __syncthreads();
    }
#pragma unroll
    for (int i = 0; i < 4; ++i)
#pragma unroll
        for (int j = 0; j < 4; ++j) { int r = m0 + ty * 4 + i, c = n0 + tx * 4 + j; if (r < M && c < N) epi(r, c, acc[i][j]); }
}

__global__ void k_rope_ua(bf16_t* ua, const float* tab) {
    size_t i = (size_t)blockIdx.x * blockDim.x + threadIdx.x;
    if (i >= (size_t)T * 512) return;
    int t = (int)(i / 512), w = (int)(i % 512);
    bf16_t* row = ua + (size_t)t * LDA;
    const float* tb = tab + (size_t)t * 48;
    if (w < 496) {
        int item = w / 8, j = w % 8, base;
        if (item < 8) base = A_AQ + item * 64;
        else if (item < 14) { int q = item - 8; int jj = (q / 2) * 2, hk = q % 2; base = A_AKV + jj * 128 + hk * 64; }
        else { int q = item - 14; int gi = q / 16, wh = (q / 8) % 2, h = q % 8; base = A_CQKV + gi * 1536 + wh * 512 + h * 64; }
        float c = tb[j], s = tb[8 + j];
        float x1 = bf2f(row[base + j]), x2 = bf2f(row[base + 8 + j]);
        row[base + j] = f2bf(x1 * c - x2 * s); row[base + 8 + j] = f2bf(x2 * c + x1 * s);
    } else {
        int j = w - 496;
        float c = tb[16 + j], s = tb[32 + j];
        float x1 = bf2f(row[A_BKR + j]), x2 = bf2f(row[A_BKR + 16 + j]);
        row[A_BKR + j] = f2bf(x1 * c - x2 * s); row[A_BKR + 16 + j] = f2bf(x2 * c + x1 * s);
    }
}
__global__ void k_rope_qm(bf16_t* qm, const float* tab) {
    size_t i = (size_t)blockIdx.x * blockDim.x + threadIdx.x;
    if (i >= (size_t)T * 128) return;
    int t = (int)(i / 128), w = (int)(i % 128), h = w / 16, j = w % 16;
    bf16_t* p = qm + (size_t)t * 768 + h * 96 + 64;
    const float* tb = tab + (size_t)t * 48;
    float c = tb[16 + j], s = tb[32 + j];
    float x1 = bf2f(p[j]), x2 = bf2f(p[16 + j]);
    p[j] = f2bf(x1 * c - x2 * s); p[16 + j] = f2bf(x2 * c + x1 * s);
}

__global__ void k_flat(const bf16_t* ua, const float* pe  , bf16_t* flat) {
    size_t i = (size_t)blockIdx.x * blockDim.x + threadIdx.x;
    if (i >= (size_t)2 * CROWS * 2048) return;
    int kv = (int)(i / ((size_t)CROWS * 2048));
    size_t rem = i % ((size_t)CROWS * 2048);
    int row = (int)(rem / 2048), col = (int)(rem % 2048);
    float v = 0.f;
    if (row < NB * NC * 2) {
        int hk = row & 1, bc = row >> 1, b = bc / NC, c = bc % NC, l = col >> 6, d = col & 63;
        int tok = b * S + 16 * c + l;
        v = bf2f(ua[(size_t)tok * LDA + A_AKV + kv * 128 + hk * 64 + d]) + pe[(kv * 32 + l) * 64 + d];
    }
    flat[i] = f2bf(v);
}

DI float dot8(const float* q, uint4 w) {
    float r = q[0] * __uint_as_float(w.x << 16) + q[1] * __uint_as_float(w.x & 0xffff0000u);
    r += q[2] * __uint_as_float(w.y << 16) + q[3] * __uint_as_float(w.y & 0xffff0000u);
    r += q[4] * __uint_as_float(w.z << 16) + q[5] * __uint_as_float(w.z & 0xffff0000u);
    r += q[6] * __uint_as_float(w.w << 16) + q[7] * __uint_as_float(w.w & 0xffff0000u);
    return r;
}
__global__ __launch_bounds__(256) void k_topk(const bf16_t* ua, const bf16_t* kc  , unsigned long long* sel) {
    __shared__ float qs[4][64];
    const int wv = threadIdx.x >> 6, lane = threadIdx.x & 63;
    const int item = blockIdx.x * 4 + wv;
    const int t = item >> 1, hk = item & 1, b = t / S, s = t % S;
    float mine = 0.f;
    for (int g = 0; g < 4; ++g) {
        __syncthreads();
        qs[wv][lane] = bf2f(ua[(size_t)t * LDA + A_AQ + (hk * 4 + g) * 64 + lane]);
        __syncthreads();
        float sc[4]; bool ok[4]; float mx = -INFINITY;
#pragma unroll
        for (int e = 0; e < 4; ++e) {
            int c = lane * 4 + e;
            ok[e] = (c < NC) && (16 * c + 31 <= s);
            float dsum = 0.f;
            if (ok[e]) { const bf16_t* kr = kc + ((size_t)(b * NC + c) * 2 + hk) * 64;
#pragma unroll
                for (int d8 = 0; d8 < 8; ++d8) dsum += dot8(&qs[wv][d8 * 8], *(const uint4*)(kr + d8 * 8)); }
            sc[e] = ok[e] ? dsum * 0.125f : -INFINITY;
            mx = fmaxf(mx, sc[e]);
        }
        mx = wave_max(mx);
        float p[4], sum = 0.f;
#pragma unroll
        for (int e = 0; e < 4; ++e) { p[e] = ok[e] ? __expf(sc[e] - mx) : 0.f; sum += p[e]; }
        sum = wave_sum(sum);
        float inv = sum > 0.f ? 1.f / sum : 0.f;
#pragma unroll
        for (int e = 0; e < 4; ++e) p[e] *= inv;
        float carry = 0.5f * p[3];
        float up = __shfl_up(carry, 1); if (lane == 0) up = 0.f;
        mine += p[0] + p[1] + p[2] + 0.5f * p[3] + up;
    }
    const int cur = s >> 6;
    const bool valid = lane <= cur;
    const bool forced = (lane == 0) || (lane == cur) || (lane == cur - 1);
    const float score = forced ? 1e30f : (valid ? mine : -1e30f);
    int rank = 0;
    for (int jj = 0; jj < 64; ++jj) { float v = __shfl(score, jj); rank += (v > score || (v == score && jj < lane)) ? 1 : 0; }
    unsigned long long m = __ballot((rank < 16) && valid);
    if (lane == 0) sel[(size_t)t * 2 + hk] = m;
}

struct AttnArgs { const bf16_t* ua; const bf16_t* kc; const bf16_t* qm; const bf16_t* kvu; const unsigned long long* sel; bf16_t* out; float* lse; };
template <int MODE>
__global__ __launch_bounds__(128) void k_attn(AttnArgs a) {
    __shared__ float sc_s[2][4096];
    __shared__ float q_s[2][96];
    const int wv = threadIdx.x >> 6, lane = threadIdx.x & 63;
    const int item = blockIdx.x * 2 + wv;
    const int t = item >> 3, hq = item & 7, b = t / S, s = t % S;
    constexpr int DQK = (MODE == 3) ? 96 : 64;
    const float scale = (MODE == 3) ? 0.10206207261596577f : 0.125f;
    float* sc = sc_s[wv]; float* q = q_s[wv];
    if (MODE == 3) { q[lane] = bf2f(a.qm[(size_t)t * 768 + hq * 96 + lane]); if (lane < 32) q[64 + lane] = bf2f(a.qm[(size_t)t * 768 + hq * 96 + 64 + lane]); }
    else if (MODE <= 2) q[lane] = bf2f(a.ua[(size_t)t * LDA + A_AQ + hq * 64 + lane]);
    else q[lane] = bf2f(a.ua[(size_t)t * LDA + A_CQKV + (MODE - 4) * 1536 + hq * 64 + lane]);
    __syncthreads();
    const int hk = hq >> 2;
    const int dil = (MODE == 5) ? 4 : (MODE == 6) ? 16 : 1;
    int nk;
    if (MODE == 0) nk = NC; else if (MODE == 1) nk = ((s >> 6) + 1) * 64; else if (MODE == 2) nk = 512; else if (MODE == 3) nk = s + 1; else nk = 129;
    unsigned long long selm = 0ull;
    if (MODE == 1) selm = a.sel[(size_t)t * 2 + hk];
    auto keyinfo = [&](int i, bool& ok, const bf16_t*& kp, const bf16_t*& kp2, const bf16_t*& vp) {
        kp2 = nullptr;
        if (MODE == 0) { ok = (16 * i + 31 <= s); size_t r = ((size_t)(b * NC + i) * 2 + hk) * 64; kp = a.kc + r; vp = a.kc + (size_t)CROWS * 64 + r; }
        else if (MODE == 1) { ok = (i <= s) && ((selm >> (i >> 6)) & 1ull); size_t r = (size_t)(b * S + i) * LDA + A_AKV + hk * 64; kp = a.ua + r + 2 * 128; vp = a.ua + r + 3 * 128; }
        else if (MODE == 2) { int kt = s - 511 + i; ok = kt >= 0; if (!ok) kt = 0; size_t r = (size_t)(b * S + kt) * LDA + A_AKV + hk * 64; kp = a.ua + r + 4 * 128; vp = a.ua + r + 5 * 128; }
        else if (MODE == 3) { ok = true; size_t r = (size_t)(b * S + i); kp = a.kvu + r * 1024 + hq * 128; vp = kp + 64; kp2 = a.ua + r * LDA + A_BKR; }
        else { int kt = s - dil * i; ok = kt >= 0; if (!ok) kt = 0; size_t r = (size_t)(b * S + kt) * LDA + A_CQKV + (MODE - 4) * 1536 + hq * 64; kp = a.ua + r + 512; vp = a.ua + r + 1024; }
    };
    float mx = -INFINITY;
    for (int i = lane; i < nk; i += 64) {
        bool ok; const bf16_t *kp, *kp2, *vp; keyinfo(i, ok, kp, kp2, vp);
        float v = -INFINITY;
        if (ok) {
            float dsum = 0.f;
#pragma unroll
            for (int d8 = 0; d8 < 8; ++d8) dsum += dot8(q + d8 * 8, *(const uint4*)(kp + d8 * 8));
            if (MODE == 3) {
#pragma unroll
                for (int d8 = 0; d8 < 4; ++d8) dsum += dot8(q + 64 + d8 * 8, *(const uint4*)(kp2 + d8 * 8)); }
            v = dsum * scale;
        }
        sc[i] = v; mx = fmaxf(mx, v);
    }
    mx = wave_max(mx);
    float sum = 0.f;
    for (int i = lane; i < nk; i += 64) { float v = sc[i]; float e = (v == -INFINITY) ? 0.f : __expf(v - mx); sc[i] = e; sum += e; }
    sum = wave_sum(sum);
    __syncthreads();
    const int kg = lane >> 3, dc = lane & 7;
    float acc8[8];
#pragma unroll
    for (int j = 0; j < 8; ++j) acc8[j] = 0.f;
    for (int i0 = 0; i0 < nk; i0 += 8) {
        const int i = i0 + kg;
        const float p = (i < nk) ? sc[i] : 0.f;
        if (p != 0.f) {
            bool ok; const bf16_t *kp, *kp2, *vp; keyinfo(i, ok, kp, kp2, vp);
            const uint4 w = *(const uint4*)(vp + dc * 8);
            acc8[0] += p * __uint_as_float(w.x << 16); acc8[1] += p * __uint_as_float(w.x & 0xffff0000u);
            acc8[2] += p * __uint_as_float(w.y << 16); acc8[3] += p * __uint_as_float(w.y & 0xffff0000u);
            acc8[4] += p * __uint_as_float(w.z << 16); acc8[5] += p * __uint_as_float(w.z & 0xffff0000u);
            acc8[6] += p * __uint_as_float(w.w << 16); acc8[7] += p * __uint_as_float(w.w & 0xffff0000u);
        }
    }
    const float inv = (sum > 0.f) ? 1.f / sum : 0.f;
#pragma unroll
    for (int j = 0; j < 8; ++j) { float v = acc8[j]; v += __shfl_xor(v, 8); v += __shfl_xor(v, 16); v += __shfl_xor(v, 32); acc8[j] = v * inv; }
    if (kg == 0) {
        uint4 w;
        w.x = (unsigned)f2bf(acc8[0]) | ((unsigned)f2bf(acc8[1]) << 16); w.y = (unsigned)f2bf(acc8[2]) | ((unsigned)f2bf(acc8[3]) << 16);
        w.z = (unsigned)f2bf(acc8[4]) | ((unsigned)f2bf(acc8[5]) << 16); w.w = (unsigned)f2bf(acc8[6]) | ((unsigned)f2bf(acc8[7]) << 16);
        *(uint4*)(a.out + (size_t)t * 512 + hq * 64 + dc * 8) = w;
    }
    if (MODE >= 4 && lane == 0) a.lse[((size_t)(MODE - 4) * T + t) * 8 + hq] = mx + __logf(sum);
}

__global__ void k_combine(bf16_t* o7, const float* lse, const bf16_t* ub) {
    size_t i = (size_t)blockIdx.x * blockDim.x + threadIdx.x;
    if (i >= (size_t)T * 512) return;
    int t = (int)(i / 512), col = (int)(i % 512), hq = col >> 6;
    const bf16_t* u = ub + (size_t)t * LDB;
    bf16_t* ocmp = o7; bf16_t* ob = o7 + O7_STRIDE; bf16_t* od0 = o7 + 2 * O7_STRIDE; bf16_t* oslc = o7 + 3 * O7_STRIDE; bf16_t* owin = o7 + 4 * O7_STRIDE; bf16_t* od1 = o7 + 5 * O7_STRIDE; bf16_t* od2 = o7 + 6 * O7_STRIDE;
    float g0 = sigm(bf2f(u[B_GATE + hq * 3 + 0])), g1 = sigm(bf2f(u[B_GATE + hq * 3 + 1])), g2 = sigm(bf2f(u[B_GATE + hq * 3 + 2]));
    float za = bf2f(u[B_ZA + col]), zb = bf2f(u[B_ZB + col]), zc = bf2f(u[B_ZC + col]);
    float oa = (g0 * bf2f(ocmp[i]) + g1 * bf2f(oslc[i]) + g2 * bf2f(owin[i])) * (za * sigm(za));
    float obv = bf2f(ob[i]) * (zb * sigm(zb));
    float l0 = lse[((size_t)0 * T + t) * 8 + hq], l1 = lse[((size_t)1 * T + t) * 8 + hq], l2 = lse[((size_t)2 * T + t) * 8 + hq];
    float m = fmaxf(l0, fmaxf(l1, l2));
    float w0 = __expf(l0 - m), w1 = __expf(l1 - m), w2 = __expf(l2 - m);
    float oc = (w0 * bf2f(od0[i]) + w1 * bf2f(od1[i]) + w2 * bf2f(od2[i])) / (w0 + w1 + w2) * (zc * sigm(zc));
    ocmp[i] = f2bf(oa); ob[i] = f2bf(obv); od0[i] = f2bf(oc);
}


namespace pg8 {
#define PG8_LAS __attribute__((address_space(3)))
typedef unsigned short bf16_t;
typedef short bf16x8 __attribute__((ext_vector_type(8)));
typedef float f32x4 __attribute__((ext_vector_type(4)));
typedef unsigned u32x4 __attribute__((ext_vector_type(4)));
constexpr int BM = 256, BK = 64, HALF = 128, HTB = HALF * BK * 2  , STAGE_BYTES = 8 * HTB, NXCD = 8, WGM = 8;

__host__ __device__ __forceinline__ int lds_byte(int r, int c) { const int st = (r >> 4) * 2 + (c >> 5), rr = r & 15, cc = c & 31, ob = rr * 64 + cc * 2; return st * 1024 + (ob ^ (((ob >> 9) & 1) << 5)); }
__host__ __device__ __forceinline__ void stage_rc(int b, int& R, int& C) { const int st = b / 1024, sb = b % 1024, swz = sb ^ (((sb >> 9) & 1) << 5); R = (st >> 1) * 16 + swz / 64; C = (st & 1) * 32 + (swz % 64) / 2; }
__host__ __device__ __forceinline__ int perm32(int rho) { const int n = rho >> 4, i = rho & 15; return 8 * (i >> 2) + 4 * n + (i & 3); }

constexpr int HWTID_OFF = 131072 + 1024;
__device__ __forceinline__ unsigned hw_slot() { const unsigned h = (unsigned)__builtin_amdgcn_s_getreg((6 << 11) | (0 << 6) | 4); return h & 63u; }
__device__ __forceinline__ void hw_tid_init(PG8_LAS unsigned char* lds) { if ((threadIdx.x & 63) == 0) *(PG8_LAS unsigned*)(lds + HWTID_OFF + 4 * hw_slot()) = threadIdx.x >> 6; }
__device__ __forceinline__ int hw_tid(PG8_LAS unsigned char* lds) {
    const unsigned w = *(PG8_LAS unsigned*)(lds + HWTID_OFF + 4 * hw_slot());
    int lane; asm volatile("v_mbcnt_lo_u32_b32 %0, -1, 0\n\tv_mbcnt_hi_u32_b32 %0, -1, %0" : "=v"(lane));
    return (int)__builtin_amdgcn_readfirstlane(w) * 64 + lane;
}
struct Unit { int pm, pn; };
struct Gemm { const bf16_t* A; const bf16_t* Bt; int M, N, K; };

struct StaticOrder {
    int nM, nN, nwg, G, c;
    __host__ __device__ void init(int M, int N, int G_, int c_) { nM = M / BM; nN = N / BM; nwg = nM * nN; G = G_; c = c_; }
    __host__ __device__ bool next(int i, Unit& u) const {
        const long L = (long)i * G + c; if (L >= nwg) return false;
        int wgid = (int)L; { const int q = nwg / NXCD, r = nwg % NXCD, xcd = wgid % NXCD, off = wgid / NXCD; wgid = (xcd < r ? xcd * (q + 1) : r * (q + 1) + (xcd - r) * q) + off; }
        const int nig = WGM * nN, gid = wgid / nig, fm = gid * WGM, gsz = (nM - fm) < WGM ? (nM - fm) : WGM;
        u.pm = fm + ((wgid % nig) % gsz); u.pn = (wgid % nig) / gsz; return true;
    }
    __device__ __forceinline__ void a_ready(const Unit&) const {}
    __device__ __forceinline__ void done(const Unit&) const {}
};

__device__ __forceinline__ unsigned cvt_pk_bf16(float lo, float hi) { unsigned r; asm volatile("v_cvt_pk_bf16_f32 %0, %1, %2" : "=v"(r) : "v"(lo), "v"(hi)); return r; }

template <class Epi, class Sched, bool ALIGN_EPI = false, bool SP2 = false>
__device__ __forceinline__ void gemm_phase(PG8_LAS unsigned char* lds, const Gemm g, const Sched& S, const Epi& E) {
    int tid_ = hw_tid(lds); asm volatile("" : "+v"(tid_));
    const int tid = tid_, wid = __builtin_amdgcn_readfirstlane(tid >> 6), lane = tid & 63, wr = wid >> 2, wc = wid & 3, fr = lane & 15, fq = lane >> 4;
    int K_ = g.K; asm volatile("" : "+s"(K_));
    __builtin_assume(K_ >= 128 && K_ % 128 == 0);
    const int K = K_, nt = K / BK;
    unsigned voffA[2], voffB[2];
#pragma unroll
    for (int i = 0; i < 2; ++i) { int R, C; stage_rc(tid * 16 + i * 8192, R, C); const int Rb = Epi::PERM ? ((R & ~31) + perm32(R & 31)) : R;
        voffA[i] = (unsigned)(R * K + C) * 2u; voffB[i] = (unsigned)(Rb * K + C) * 2u; }
    const size_t kstep = (size_t)(BK * 2);
    const size_t hstep = (size_t)HALF * K * 2;
    const size_t tstep = 2 * hstep;
    const unsigned ldsw = (unsigned)wid * 1024u;
    const int aoff = lds_byte(wr * 64 + fr, fq * 8), boff = lds_byte(wc * 32 + fr, fq * 8);
#define PG8_SA(b, h) (((b) * 2 + (h)) * HTB)
#define PG8_SB(b, h) ((4 + (b) * 2 + (h)) * HTB)
#define PG8_STAGE(bufoff, gbase, voff) do { _Pragma("unroll") for (int _i = 0; _i < 2; ++_i) \
        __builtin_amdgcn_global_load_lds((const unsigned*)((const char*)(gbase) + (voff)[_i]), (PG8_LAS unsigned*)(lds + (bufoff) + ldsw + _i * 8192), 16, 0, 0); } while (0)
#define PG8_LDA(dst, b, h) do { _Pragma("unroll") for (int m = 0; m < 4; ++m) _Pragma("unroll") for (int k = 0; k < 2; ++k) dst[m][k] = *(const PG8_LAS bf16x8*)(lds + PG8_SA(b, h) + aoff + m * 2048 + k * 1024); } while (0)
#define PG8_LDB(dst, b, h) do { _Pragma("unroll") for (int n = 0; n < 2; ++n) _Pragma("unroll") for (int k = 0; k < 2; ++k) dst[n][k] = *(const PG8_LAS bf16x8*)(lds + PG8_SB(b, h) + boff + n * 2048 + k * 1024); } while (0)
#define PG8_MMA(ai, bj, At, Bt) do { __builtin_amdgcn_s_setprio(1); _Pragma("unroll") for (int m = 0; m < 4; ++m) _Pragma("unroll") for (int n = 0; n < 2; ++n) _Pragma("unroll") for (int k = 0; k < 2; ++k) \
        acc[ai][bj][m][n] = __builtin_amdgcn_mfma_f32_16x16x32_bf16(Bt[n][k], At[m][k], acc[ai][bj][m][n], 0, 0, 0); __builtin_amdgcn_s_setprio(0); } while (0)
#define PG8_WAIT_V(n) asm volatile("s_waitcnt vmcnt(" #n ")" ::: "memory")
#define PG8_WAIT_L(n) asm volatile("s_waitcnt lgkmcnt(" #n ")" ::: "memory")
#define PG8_BAR __builtin_amdgcn_s_barrier()
#define PG8_SCHED __builtin_amdgcn_sched_barrier(0)
    Unit cur, nxt; int ui = 0;
    if (!S.next(0, cur)) return;
    float zf_ = 0.f; asm volatile("" : "+v"(zf_));
    f32x4 acc[2][2][4][2];
#pragma unroll
    for (int a = 0; a < 2; ++a)
#pragma unroll
        for (int b = 0; b < 2; ++b)
#pragma unroll
            for (int m = 0; m < 4; ++m)
#pragma unroll
                for (int n = 0; n < 2; ++n) acc[a][b][m][n] = (f32x4){zf_, zf_, zf_, zf_};
    bf16x8 At[4][2], B0[2][2], B1[2][2];
    const char* cA = (const char*)g.A + (size_t)cur.pm * tstep; const char* cB = (const char*)g.Bt + (size_t)cur.pn * tstep;
    S.a_ready(cur);
    if constexpr (SP2) {
        PG8_STAGE(PG8_SB(0, 0), cB, voffB); PG8_STAGE(PG8_SB(0, 1), cB + hstep, voffB); PG8_STAGE(PG8_SA(0, 0), cA, voffA); PG8_STAGE(PG8_SA(0, 1), cA + hstep, voffA);
        if (wr == 1) PG8_BAR;
        PG8_WAIT_V(2); PG8_BAR;
        PG8_STAGE(PG8_SB(1, 0), cB + kstep, voffB); PG8_STAGE(PG8_SA(1, 0), cA + kstep, voffA); PG8_STAGE(PG8_SB(1, 1), cB + hstep + kstep, voffB);
        PG8_WAIT_V(6); PG8_BAR;
    } else {
        PG8_STAGE(PG8_SB(0, 0), cB, voffB); PG8_STAGE(PG8_SA(0, 0), cA, voffA); PG8_STAGE(PG8_SB(0, 1), cB + hstep, voffB); PG8_STAGE(PG8_SA(0, 1), cA + hstep, voffA);
        if (wr == 1) PG8_BAR;
        PG8_WAIT_V(4); PG8_BAR;
        PG8_STAGE(PG8_SB(1, 0), cB + kstep, voffB); PG8_STAGE(PG8_SA(1, 0), cA + kstep, voffA); PG8_STAGE(PG8_SB(1, 1), cB + hstep + kstep, voffB);
        PG8_WAIT_V(6); PG8_BAR;
    }
    for (;;) {
        const bool has_next = S.next(ui + 1, nxt);
        const char* nA = has_next ? (const char*)g.A + (size_t)nxt.pm * tstep : cA; const char* nB = has_next ? (const char*)g.Bt + (size_t)nxt.pn * tstep : cB;
        for (int t = 0; t < nt; t += 2) {
            const bool last = (t == nt - 2);
            const char* a1 = cA + (size_t)(t + 1) * kstep;
            const char* a2 = last ? nA : cA + (size_t)(t + 2) * kstep; const char* b2 = last ? nB : cB + (size_t)(t + 2) * kstep;
            const char* a3 = a2 + kstep; const char* b3 = b2 + kstep;
            if (last && has_next) S.a_ready(nxt);
            if constexpr (SP2) {
            PG8_LDB(B0, 0, 0); PG8_LDB(B1, 0, 1); PG8_SCHED; PG8_LDA(At, 0, 0); PG8_STAGE(PG8_SA(1, 1), a1 + hstep, voffA);
            PG8_WAIT_V(8); PG8_WAIT_L(0); PG8_BAR; PG8_MMA(0, 0, At, B0); PG8_MMA(0, 1, At, B1); PG8_BAR; PG8_SCHED;
            PG8_LDA(At, 0, 1); PG8_STAGE(PG8_SB(0, 0), b2, voffB); PG8_STAGE(PG8_SB(0, 1), b2 + hstep, voffB); PG8_STAGE(PG8_SA(0, 0), a2, voffA);
            PG8_WAIT_V(8); PG8_WAIT_L(0); PG8_BAR; PG8_MMA(1, 0, At, B0); PG8_MMA(1, 1, At, B1); PG8_BAR; PG8_SCHED;
            PG8_LDB(B0, 1, 0); PG8_LDB(B1, 1, 1); PG8_SCHED; PG8_LDA(At, 1, 0); PG8_STAGE(PG8_SA(0, 1), a2 + hstep, voffA);
            PG8_WAIT_V(8); PG8_WAIT_L(0); PG8_BAR; PG8_MMA(0, 0, At, B0); PG8_MMA(0, 1, At, B1); PG8_BAR; PG8_SCHED;
            PG8_LDA(At, 1, 1); PG8_STAGE(PG8_SB(1, 0), b3, voffB); PG8_STAGE(PG8_SB(1, 1), b3 + hstep, voffB); PG8_STAGE(PG8_SA(1, 0), a3, voffA);
            PG8_WAIT_V(8); PG8_WAIT_L(0); PG8_BAR; PG8_MMA(1, 0, At, B0); PG8_MMA(1, 1, At, B1); PG8_BAR; PG8_SCHED;
            } else {
            PG8_LDB(B0, 0, 0); PG8_SCHED; PG8_LDA(At, 0, 0); PG8_STAGE(PG8_SA(1, 1), a1 + hstep, voffA);
            PG8_WAIT_L(8); PG8_BAR; PG8_WAIT_L(0); PG8_MMA(0, 0, At, B0); PG8_BAR; PG8_SCHED;
            PG8_LDB(B1, 0, 1); PG8_STAGE(PG8_SB(0, 0), b2, voffB);
            PG8_BAR; PG8_WAIT_L(0); PG8_MMA(0, 1, At, B1); PG8_BAR;
            PG8_LDA(At, 0, 1); PG8_STAGE(PG8_SA(0, 0), a2, voffA);
            PG8_BAR; PG8_WAIT_L(0); PG8_MMA(1, 0, At, B0); PG8_BAR; PG8_SCHED;
            PG8_STAGE(PG8_SB(0, 1), b2 + hstep, voffB);
            PG8_WAIT_V(6); PG8_BAR; PG8_MMA(1, 1, At, B1); PG8_BAR;
            PG8_LDB(B0, 1, 0); PG8_SCHED; PG8_LDA(At, 1, 0); PG8_STAGE(PG8_SA(0, 1), a2 + hstep, voffA);
            PG8_WAIT_L(8); PG8_BAR; PG8_WAIT_L(0); PG8_MMA(0, 0, At, B0); PG8_BAR; PG8_SCHED;
            PG8_LDB(B1, 1, 1); PG8_STAGE(PG8_SB(1, 0), b3, voffB);
            PG8_BAR; PG8_WAIT_L(0); PG8_MMA(0, 1, At, B1); PG8_BAR;
            PG8_LDA(At, 1, 1); PG8_STAGE(PG8_SA(1, 0), a3, voffA);
            PG8_BAR; PG8_WAIT_L(0); PG8_MMA(1, 0, At, B0); PG8_BAR; PG8_SCHED;
            PG8_STAGE(PG8_SB(1, 1), b3 + hstep, voffB);
            PG8_WAIT_V(6); PG8_BAR; PG8_MMA(1, 1, At, B1); PG8_BAR;
            }
        }
        if constexpr (ALIGN_EPI) { if (wr == 0) PG8_BAR; }
        if constexpr (!Epi::AFTER_DRAIN) { E(acc, cur, wr, wc, fr, fq); S.done(cur); }
        if (!has_next) break;
#pragma unroll
        for (int a = 0; a < 2; ++a)
#pragma unroll
            for (int b = 0; b < 2; ++b)
#pragma unroll
                for (int m = 0; m < 4; ++m)
#pragma unroll
                    for (int n = 0; n < 2; ++n) acc[a][b][m][n] = (f32x4){zf_, zf_, zf_, zf_};
        asm volatile("" : "+v"(zf_));
        cur = nxt; cA = nA; cB = nB; ++ui;
        if constexpr (ALIGN_EPI) { if (wr == 1) PG8_BAR; }
    }
    PG8_WAIT_V(0);
    if constexpr (!ALIGN_EPI) { if (wr == 0) PG8_BAR; }
    PG8_BAR;
    if constexpr (Epi::AFTER_DRAIN) { E.fused(acc, cur, wr, wc, fr, fq, lds, wid, lane); S.done(cur); }
#undef PG8_SA
#undef PG8_SB
#undef PG8_STAGE
#undef PG8_LDA
#undef PG8_LDB
#undef PG8_MMA
#undef PG8_WAIT_V
#undef PG8_WAIT_L
#undef PG8_BAR
#undef PG8_SCHED
}
}

#define GAS __attribute__((address_space(1)))
#define LAS __attribute__((address_space(3)))
typedef float f32x4 __attribute__((ext_vector_type(4)));
typedef unsigned u32x4 __attribute__((ext_vector_type(4)));
constexpr int NWAVES = 8, NTHREADS = 512;
constexpr int RING_BYTES = 131072, LDSCTL_OFF = RING_BYTES, LDS_BYTES = 147456;
constexpr int NPAD = 11264;
constexpr size_t WS_WIN = WS_END;
constexpr size_t WS_WUQ = WS_WIN + (size_t)NPAD * 1024 * 2;
constexpr size_t WS_WUKV = WS_WUQ + (size_t)768 * 384 * 2;
constexpr size_t WS_W1 = WS_WUKV + (size_t)1024 * 128 * 2;
constexpr size_t WS_WABC = WS_W1 + (size_t)2 * 256 * 2048 * 2;
constexpr size_t WS_WOUT = WS_WABC + (size_t)3 * 1024 * 512 * 2;
constexpr size_t WS_WPLG = WS_WOUT + (size_t)1024 * 1024 * 2;
constexpr size_t WS_WPLE = WS_WPLG + (size_t)1024 * 1024 * 2;
constexpr size_t WS_PBF = WS_WPLE + (size_t)1024 * 256 * 2;
constexpr size_t WS_END2 = WS_PBF + (size_t)T * 256 * 2;
constexpr int CW_BAR = 4096;
constexpr int CW_QUEUE = 16384;

DI unsigned pk2(float lo, float hi) { return (unsigned)f2bf(lo) | ((unsigned)f2bf(hi) << 16); }
DI u32x4 pack8(f32x4 a, f32x4 b) { u32x4 w; w.x = pg8::cvt_pk_bf16(a[0], a[1]); w.y = pg8::cvt_pk_bf16(a[2], a[3]); w.z = pg8::cvt_pk_bf16(b[0], b[1]); w.w = pg8::cvt_pk_bf16(b[2], b[3]); return w; }
DI float shx(float v, int lane, int m) { return __int_as_float(__builtin_amdgcn_ds_bpermute((lane ^ m) << 2, __float_as_int(v))); }
DI float sigf(float x) { return __builtin_amdgcn_rcpf(1.f + __expf(-x)); }
DI int epi_lane() { int lane; asm volatile("v_mbcnt_lo_u32_b32 %0, -1, 0\n\tv_mbcnt_hi_u32_b32 %0, -1, %0" : "=v"(lane)); return lane; }
DI float bflo(unsigned w) { return __uint_as_float(w << 16); }
DI float bfhi(unsigned w) { return __uint_as_float(w & 0xffff0000u); }

DI int win_rowmap(int c) {
    if (c < 512) return A_AQ + c;
    if (c < 1280) return A_AKV + c - 512;
    if (c < 1304) return LDA + B_GATE + c - 1280;
    if (c < 1816) return LDA + B_ZA + c - 1304;
    if (c < 2200) return A_BCQ + c - 1816;
    if (c < 2328) return A_BCKV + c - 2200;
    if (c < 2360) return A_BKR + c - 2328;
    if (c < 2872) return LDA + B_ZB + c - 2360;
    if (c < 7480) return A_CQKV + c - 2872;
    if (c < 7992) return LDA + B_ZC + c - 7480;
    return LDA + B_MG + c - 7992;
}
constexpr int WIN_VALID = LDA + B_GATE + 24;

using pg8::Unit;
struct EpiWin { static constexpr bool PERM = true, AFTER_DRAIN = false;
    bf16_t* ua; bf16_t* ub; const float* tab;
    DI void operator()(const f32x4 (&acc)[2][2][4][2], const Unit& u, int wr, int wc, int, int) const {
        const int tl_ = epi_lane(); const int fr = tl_ & 15, fq = tl_ >> 4;
        const int lane = fr + 16 * fq;
#pragma unroll
        for (int bj = 0; bj < 2; ++bj) {
            const int c32 = u.pn * 256 + bj * 128 + wc * 32;
            const int n0 = c32 + 8 * fq;
            int kind = 0;
            if (c32 < 512) kind = ((c32 & 63) == 0) ? 1 : 0;
            else if (c32 < 1280) kind = (((((c32 - 512) >> 7) & 1) == 0) && ((c32 & 63) == 0)) ? 1 : 0;
            else if (c32 >= A_BKR && c32 < A_CQKV) kind = 2;
            else if (c32 >= A_CQKV && c32 < LDA) { const int cc = c32 - A_CQKV; kind = (((cc % 1536) < 1024) && ((cc & 63) == 0)) ? 1 : 0; }
            bf16_t* dst; int ld;
            if (n0 < LDA) { dst = ua + n0; ld = LDA; } else { dst = ub + (n0 - LDA); ld = LDB; }
            const bool wr_ok = n0 < WIN_VALID;
#pragma unroll
            for (int ai = 0; ai < 2; ++ai)
#pragma unroll
                for (int m = 0; m < 4; ++m) { __builtin_amdgcn_sched_barrier(0);
                    const int row = u.pm * 256 + ai * 128 + wr * 64 + m * 16 + fr;
                    f32x4 v0 = acc[ai][bj][m][0], v1 = acc[ai][bj][m][1];
                    if (kind == 1) {
                        f32x4 p0, p1;
#pragma unroll
                        for (int e = 0; e < 4; ++e) { p0[e] = shx(v0[e], lane, 16); p1[e] = shx(v1[e], lane, 16); }
                        if (fq < 2) {
                            const float* tb = tab + (size_t)row * 48;
                            const f32x4 c0 = *(const f32x4*)(tb), c1 = *(const f32x4*)(tb + 4), s0 = *(const f32x4*)(tb + 8), s1 = *(const f32x4*)(tb + 12);
                            const float sg = (fq == 0) ? -1.f : 1.f;
                            v0 = v0 * c0 + sg * (p0 * s0); v1 = v1 * c1 + sg * (p1 * s1);
                        }
                    } else if (kind == 2) {
                        f32x4 p0, p1;
#pragma unroll
                        for (int e = 0; e < 4; ++e) { p0[e] = shx(v0[e], lane, 32); p1[e] = shx(v1[e], lane, 32); }
                        const float* tb = tab + (size_t)row * 48 + 16 + (fq & 1) * 8;
                        const f32x4 c0 = *(const f32x4*)(tb), c1 = *(const f32x4*)(tb + 4), s0 = *(const f32x4*)(tb + 16), s1 = *(const f32x4*)(tb + 20);
                        const float sg = (fq < 2) ? -1.f : 1.f;
                        v0 = v0 * c0 + sg * (p0 * s0); v1 = v1 * c1 + sg * (p1 * s1);
                    }
                    if (wr_ok) *(u32x4*)(dst + (size_t)row * ld) = pack8(v0, v1);
                }
        }
    }
};
struct EpiQm { static constexpr bool PERM = true, AFTER_DRAIN = false;
    bf16_t* qm; const float* tab;
    DI void operator()(const f32x4 (&acc)[2][2][4][2], const Unit& u, int wr, int wc, int, int) const {
        const int tl_ = epi_lane(); const int fr = tl_ & 15, fq = tl_ >> 4;
        const int lane = fr + 16 * fq;
#pragma unroll
        for (int bj = 0; bj < 2; ++bj) {
            const int c32 = u.pn * 256 + bj * 128 + wc * 32;
            const int n0 = c32 + 8 * fq;
            const bool rope = ((c32 >> 5) % 3) == 2;
#pragma unroll
            for (int ai = 0; ai < 2; ++ai)
#pragma unroll
                for (int m = 0; m < 4; ++m) { __builtin_amdgcn_sched_barrier(0);
                    const int row = u.pm * 256 + ai * 128 + wr * 64 + m * 16 + fr;
                    f32x4 v0 = acc[ai][bj][m][0], v1 = acc[ai][bj][m][1];
                    if (rope) {
                        f32x4 p0, p1;
#pragma unroll
                        for (int e = 0; e < 4; ++e) { p0[e] = shx(v0[e], lane, 32); p1[e] = shx(v1[e], lane, 32); }
                        const float* tb = tab + (size_t)row * 48 + 16 + (fq & 1) * 8;
                        const f32x4 c0 = *(const f32x4*)(tb), c1 = *(const f32x4*)(tb + 4), s0 = *(const f32x4*)(tb + 16), s1 = *(const f32x4*)(tb + 20);
                        const float sg = (fq < 2) ? -1.f : 1.f;
                        v0 = v0 * c0 + sg * (p0 * s0); v1 = v1 * c1 + sg * (p1 * s1);
                    }
                    *(u32x4*)(qm + (size_t)row * 768 + n0) = pack8(v0, v1);
                }
        }
    }
};
struct EpiBfPlain { static constexpr bool PERM = true, AFTER_DRAIN = false;
    bf16_t* c; int ldc; int pad;
    DI void operator()(const f32x4 (&acc)[2][2][4][2], const Unit& u, int wr, int wc, int, int) const {
        const int tl_ = epi_lane(); const int fr = tl_ & 15, fq = tl_ >> 4;
#pragma unroll
        for (int bj = 0; bj < 2; ++bj) { const int n0 = u.pn * 256 + bj * 128 + wc * 32 + 8 * fq;
#pragma unroll
            for (int ai = 0; ai < 2; ++ai)
#pragma unroll
                for (int m = 0; m < 4; ++m) { __builtin_amdgcn_sched_barrier(0); const int row = u.pm * 256 + ai * 128 + wr * 64 + m * 16 + fr;
                    *(u32x4*)(c + (size_t)row * ldc + n0) = pack8(acc[ai][bj][m][0], acc[ai][bj][m][1]); } }
    }
};
template <int ACT  > struct EpiF32 { static constexpr bool PERM = true, AFTER_DRAIN = false;
    float* c; int ldc; int pnmask;
    DI void operator()(const f32x4 (&acc)[2][2][4][2], const Unit& u, int wr, int wc, int, int) const {
        const int tl_ = epi_lane(); const int fr = tl_ & 15, fq = tl_ >> 4;
#pragma unroll
        for (int bj = 0; bj < 2; ++bj) { const int n0 = (u.pn & pnmask) * 256 + bj * 128 + wc * 32 + 8 * fq;
#pragma unroll
            for (int ai = 0; ai < 2; ++ai)
#pragma unroll
                for (int m = 0; m < 4; ++m) { __builtin_amdgcn_sched_barrier(0); const int row = u.pm * 256 + ai * 128 + wr * 64 + m * 16 + fr;
                    f32x4 v0 = acc[ai][bj][m][0], v1 = acc[ai][bj][m][1];
                    if (ACT == 1) {
#pragma unroll
                        for (int e = 0; e < 4; ++e) { v0[e] = v0[e] * sigf(v0[e]); v1[e] = v1[e] * sigf(v1[e]); } }
                    float* p = c + (size_t)row * ldc + n0; *(f32x4*)p = v0; *(f32x4*)(p + 4) = v1; } }
    }
};
struct EpiYabc { static constexpr bool PERM = true, AFTER_DRAIN = false;
    float* ymix; bf16_t* ymixb; const bf16_t* ub;
    DI void operator()(const f32x4 (&acc)[2][2][4][2], const Unit& u, int wr, int wc, int, int) const {
        const int tl_ = epi_lane(); const int fr = tl_ & 15, fq = tl_ >> 4;
        const int x = u.pm >> 6, pm = u.pm & 63, pn = u.pn & 3;
#pragma unroll
        for (int bj = 0; bj < 2; ++bj) { const int n0 = pn * 256 + bj * 128 + wc * 32 + 8 * fq;
#pragma unroll
            for (int ai = 0; ai < 2; ++ai)
#pragma unroll
                for (int m = 0; m < 4; ++m) { __builtin_amdgcn_sched_barrier(0); const int row = pm * 256 + ai * 128 + wr * 64 + m * 16 + fr;
                    const u32x4 gw = *(const u32x4*)(ub + (size_t)row * LDB + B_MG + x * 1024 + n0);
                    f32x4 g0, g1; g0[0] = sigf(bflo(gw.x)); g0[1] = sigf(bfhi(gw.x)); g0[2] = sigf(bflo(gw.y)); g0[3] = sigf(bfhi(gw.y));
                    g1[0] = sigf(bflo(gw.z)); g1[1] = sigf(bfhi(gw.z)); g1[2] = sigf(bflo(gw.w)); g1[3] = sigf(bfhi(gw.w));
                    f32x4 v0 = acc[ai][bj][m][0] * g0, v1 = acc[ai][bj][m][1] * g1;
                    float* p = ymix + (size_t)row * D + n0;
                    if (x > 0) { v0 = v0 + *(const f32x4*)p; v1 = v1 + *(const f32x4*)(p + 4); }
                    if (x < 2) { *(f32x4*)p = v0; *(f32x4*)(p + 4) = v1; }
                    else *(u32x4*)(ymixb + (size_t)row * D + n0) = pack8(v0, v1); } }
    }
};
struct EpiPlgF { static constexpr bool PERM = true, AFTER_DRAIN = false;
    float* x; const float* e;
    DI void operator()(const f32x4 (&acc)[2][2][4][2], const Unit& u, int wr, int wc, int, int) const {
        const int tl_ = epi_lane(); const int fr = tl_ & 15, fq = tl_ >> 4;
#pragma unroll
        for (int bj = 0; bj < 2; ++bj) { const int n0 = u.pn * 256 + bj * 128 + wc * 32 + 8 * fq;
#pragma unroll
            for (int ai = 0; ai < 2; ++ai)
#pragma unroll
                for (int m = 0; m < 4; ++m) { __builtin_amdgcn_sched_barrier(0); const int row = u.pm * 256 + ai * 128 + wr * 64 + m * 16 + fr;
                    const size_t o = (size_t)row * D + n0;
                    f32x4 v0 = acc[ai][bj][m][0], v1 = acc[ai][bj][m][1];
                    const f32x4 e0 = *(const f32x4*)(e + o), e1 = *(const f32x4*)(e + o + 4);
                    f32x4 x0 = *(const f32x4*)(x + o), x1 = *(const f32x4*)(x + o + 4);
#pragma unroll
                    for (int k = 0; k < 4; ++k) { x0[k] += sigf(v0[k]) * e0[k]; x1[k] += sigf(v1[k]) * e1[k]; }
                    *(f32x4*)(x + o) = x0; *(f32x4*)(x + o + 4) = x1; } }
    }
};
struct YabcOrder {
    int G, vcu;
    DI bool next(int i, Unit& u) const { const int tile = (i / 3) * G + vcu, x = i % 3; if (tile >= 256) return false; u.pm = x * 64 + (tile >> 2); u.pn = x * 4 + (tile & 3); return true; }
    DI void a_ready(const Unit&) const {}
    DI void done(const Unit&) const {}
};
struct HidOrder {
    int G, c;
    DI bool next(int i, Unit& u) const { const int id = c - (G - 16); if (i > 0 || id < 0) return false; u.pm = id; u.pn = id >> 3; return true; }
    DI void a_ready(const Unit&) const {}
    DI void done(const Unit&) const {}
};
DI void tr_item(const float* W, int K, int N, bf16_t* WT, LAS float* scr, int item, int lane, bool perm) {
    const int nblk = (N + 31) / 32, kb = item / nblk, nb = item % nblk, k0 = 64 * kb, n0 = 32 * nb;
    const int nn = n0 + (lane & 31);
#pragma unroll 8
    for (int i = 0; i < 32; ++i) { const int kk = 2 * i + (lane >> 5); scr[kk * 33 + (lane & 31)] = (nn < N) ? W[(size_t)(k0 + kk) * N + nn] : 0.f; }
    asm volatile("s_waitcnt lgkmcnt(0)" ::: "memory");
    const int c = lane & 7;
#pragma unroll
    for (int j = 0; j < 4; ++j) { const int n = (lane >> 3) + 8 * j; const LAS float* s = scr + (8 * c) * 33 + n;
        u32x4 o; o.x = pk2(s[0 * 33], s[1 * 33]); o.y = pk2(s[2 * 33], s[3 * 33]); o.z = pk2(s[4 * 33], s[5 * 33]); o.w = pk2(s[6 * 33], s[7 * 33]);
        if (n0 + n < N) { const int rr = perm ? win_rowmap(n0 + n) : (n0 + n); *(u32x4*)(WT + (size_t)rr * K + k0 + 8 * c) = o; } }
    asm volatile("s_waitcnt lgkmcnt(0)" ::: "memory");
}
struct RmIdent { int off; DI int operator()(int n) const { return off + n; } };
struct RmWin { DI int operator()(int n) const { return win_rowmap(n); } };

DI float wsum(float v, int lane) {
#pragma unroll
    for (int o = 1; o < 64; o <<= 1) v += shx(v, lane, o);
    return v;
}
DI void rms_row_f32(const float* xrow, const float* g, bf16_t* orow, int lane) {
    const f32x4* xr = (const f32x4*)xrow + lane; const f32x4* gr = (const f32x4*)g + lane;
    f32x4 v[4]; float s = 0.f;
#pragma unroll
    for (int j = 0; j < 4; ++j) { v[j] = xr[64 * j]; s += (v[j][0] * v[j][0] + v[j][1] * v[j][1]) + (v[j][2] * v[j][2] + v[j][3] * v[j][3]); }
    const float rs = rsqrtf(wsum(s, lane) * (1.f / 1024.f) + 1e-6f);
    unsigned long long* o8 = (unsigned long long*)orow + lane;
#pragma unroll
    for (int j = 0; j < 4; ++j) { const f32x4 gg = gr[64 * j];
        o8[64 * j] = (unsigned long long)pk2(v[j][0] * rs * gg[0], v[j][1] * rs * gg[1]) | ((unsigned long long)pk2(v[j][2] * rs * gg[2], v[j][3] * rs * gg[3]) << 32); }
}

namespace fa {
typedef short bf16x8 __attribute__((ext_vector_type(8)));
typedef float f32x16 __attribute__((ext_vector_type(16)));
typedef short v4i16 __attribute__((ext_vector_type(4)));
constexpr int KBUF = 0, KBUF_SZ = 12288, VBUF = 24576, VBUF_SZ = 8192, OVBUF = 40960, IMP_OFF = 49152, IMP_LD = 65, SELM_OFF = IMP_OFF + 4 * 64 * IMP_LD * 4, WQ_OFF = SELM_OFF + 512;
static_assert(WQ_OFF + 64 <= 131072, "attention LDS map");
constexpr float LOG2E = 1.4426950408889634f;

DI int crow(int r, int hi) { return (r & 3) + 8 * (r >> 2) + 4 * hi; }
DI float xhalf_max(float v) { auto rr = __builtin_amdgcn_permlane32_swap(__float_as_uint(v), __float_as_uint(v), false, false); return fmaxf(__uint_as_float(rr[0]), __uint_as_float(rr[1])); }
DI float xhalf_sum(float v) { auto rr = __builtin_amdgcn_permlane32_swap(__float_as_uint(v), __float_as_uint(v), false, false); return __uint_as_float(rr[0]) + __uint_as_float(rr[1]); }
DI unsigned cvtpk(float lo, float hi) { return pg8::cvt_pk_bf16(lo, hi); }

struct St { f32x16 o[2]; float m, l; };
DI void st_init(St& s) {
#pragma unroll
    for (int i = 0; i < 16; ++i) { s.o[0][i] = 0.f; s.o[1][i] = 0.f; }
    s.m = -1e30f; s.l = 0.f;
}

template <int NQ> DI void qk_tile(f32x16& p0, f32x16& p1, LAS const unsigned char* kt, const bf16x8 (&qf)[NQ], int r32, int hi) {
    LAS const unsigned char* kb = kt + hi * 1024 + r32 * 16;
#pragma unroll
    for (int i = 0; i < 16; ++i) { p0[i] = 0.f; p1[i] = 0.f; }
#pragma unroll
    for (int d0 = 0; d0 < NQ; ++d0) {
        const bf16x8 b0 = *(LAS const bf16x8*)(kb + d0 * 2048);
        const bf16x8 b1 = *(LAS const bf16x8*)(kb + d0 * 2048 + 512);
        p0 = __builtin_amdgcn_mfma_f32_32x32x16_bf16(b0, qf[d0], p0, 0, 0, 0);
        p1 = __builtin_amdgcn_mfma_f32_32x32x16_bf16(b1, qf[d0], p1, 0, 0, 0);
    }
}
DI float softmax_tile(St& s, f32x16& p0, f32x16& p1, float c, bf16x8 (&pa)[4]) {
    float mx = fmaxf(p0[0], p1[0]);
#pragma unroll
    for (int i = 1; i < 16; ++i) mx = fmaxf(mx, fmaxf(p0[i], p1[i]));
    mx = xhalf_max(mx);
    const float mn = fmaxf(s.m, mx);
    const float alpha = __builtin_amdgcn_exp2f((s.m - mn) * c);
    s.m = mn;
    const float nmc = -mn * c;
    float sum = 0.f;
#pragma unroll
    for (int i = 0; i < 16; ++i) { p0[i] = __builtin_amdgcn_exp2f(fmaf(p0[i], c, nmc)); p1[i] = __builtin_amdgcn_exp2f(fmaf(p1[i], c, nmc)); sum += p0[i] + p1[i]; }
    s.l = s.l * alpha + sum;
#pragma unroll
    for (int i = 0; i < 16; ++i) { s.o[0][i] *= alpha; s.o[1][i] *= alpha; }
    u32x4 w;
    w.x = cvtpk(p0[0], p0[1]); w.y = cvtpk(p0[2], p0[3]); w.z = cvtpk(p0[4], p0[5]); w.w = cvtpk(p0[6], p0[7]); pa[0] = __builtin_bit_cast(bf16x8, w);
    w.x = cvtpk(p0[8], p0[9]); w.y = cvtpk(p0[10], p0[11]); w.z = cvtpk(p0[12], p0[13]); w.w = cvtpk(p0[14], p0[15]); pa[1] = __builtin_bit_cast(bf16x8, w);
    w.x = cvtpk(p1[0], p1[1]); w.y = cvtpk(p1[2], p1[3]); w.z = cvtpk(p1[4], p1[5]); w.w = cvtpk(p1[6], p1[7]); pa[2] = __builtin_bit_cast(bf16x8, w);
    w.x = cvtpk(p1[8], p1[9]); w.y = cvtpk(p1[10], p1[11]); w.z = cvtpk(p1[12], p1[13]); w.w = cvtpk(p1[14], p1[15]); pa[3] = __builtin_bit_cast(bf16x8, w);
    return alpha;
}
DI void pv_tile(f32x16 (&o)[2], LAS const unsigned char* vt, const bf16x8 (&pa)[4], int lane) {
    const int hi = lane >> 5;
    LAS const unsigned char* vb = vt + ((lane >> 4) & 1) * 32 + (lane & 3) * 8 + (4 * hi + ((lane & 15) >> 2)) * 64;
#pragma unroll
    for (int d0 = 0; d0 < 2; ++d0)
#pragma unroll
        for (int ks = 0; ks < 4; ++ks) {
            const v4i16 lo = __builtin_amdgcn_ds_read_tr16_b64_v4i16((LAS v4i16*)(vb + d0 * 4096 + ks * 1024));
            const v4i16 hv = __builtin_amdgcn_ds_read_tr16_b64_v4i16((LAS v4i16*)(vb + d0 * 4096 + ks * 1024 + 512));
            const bf16x8 vf = (bf16x8){lo[0], lo[1], lo[2], lo[3], hv[0], hv[1], hv[2], hv[3]};
            o[d0] = __builtin_amdgcn_mfma_f32_32x32x16_bf16(vf, pa[ks], o[d0], 0, 0, 0);
        }
}
DI int k_lds_off(int key, int chunk) { return chunk * 1024 + key * 16; }
DI int v_lds_off(int key, int c8) { return ((c8 >> 2) * 4 + (key >> 4)) * 1024 + (key & 15) * 64 + (c8 & 3) * 16; }

template <int NQ, class Src, class Mask>
DI void run_stage(LAS unsigned char* lds, const Src& src, const Mask& mask, int jt0, int jt1, int jw0, int jw1, const bf16x8 (&qf)[NQ], St& st, float c, int tid, int qpos) {
    const int lane = tid & 63, r32 = lane & 31, hi = lane >> 5;
    const int key = tid >> 3, ch = tid & 7;
    u32x4 rk, rk2, rv;
    rk2 = (u32x4){0u, 0u, 0u, 0u};
    auto gload = [&](int j) {
        const int kpos = 64 * j + key;
        rk = *(const u32x4*)(src.krow(kpos) + ch * 8);
        rv = *(const u32x4*)(src.vrow(kpos) + ch * 8);
        if (NQ == 6 && ch < 4) rk2 = *(const u32x4*)(src.krow2(kpos) + ch * 8);
    };
    auto lstore = [&](int buf) {
        *(LAS u32x4*)(lds + KBUF + buf * KBUF_SZ + k_lds_off(key, ch)) = rk;
        *(LAS u32x4*)(lds + VBUF + buf * VBUF_SZ + v_lds_off(key, ch)) = rv;
        if (NQ == 6 && ch < 4) *(LAS u32x4*)(lds + KBUF + buf * KBUF_SZ + k_lds_off(key, 8 + ch)) = rk2;
    };
    if (jt0 >= jt1) return;
    gload(jt0); lstore(0);
    __syncthreads();
    for (int j = jt0; j < jt1; ++j) {
        const int buf = (j - jt0) & 1;
        if (j + 1 < jt1) gload(j + 1);
        if (j >= jw0 && j < jw1 && !mask.skip(j)) {
            f32x16 p0, p1; bf16x8 pa[4];
            qk_tile<NQ>(p0, p1, lds + KBUF + buf * KBUF_SZ, qf, r32, hi);
            mask.apply(p0, p1, j, qpos, hi);
            softmax_tile(st, p0, p1, c, pa);
            pv_tile(st.o, lds + VBUF + buf * VBUF_SZ, pa, lane);
        }
        if (j + 1 < jt1) lstore(buf ^ 1);
        __syncthreads();
    }
}
struct MaskBand { int maxd;
    DI bool skip(int) const { return false; }
    DI void apply(f32x16& p0, f32x16& p1, int j, int qpos, int hi) const {
        const int kb = 64 * j + 4 * hi, q0 = qpos & ~31;
        if (64 * j + 63 <= q0 && q0 + 31 - (64 * j) <= maxd) return;
#pragma unroll
        for (int r = 0; r < 16; ++r) { const int d0 = qpos - (kb + (r & 3) + 8 * (r >> 2)), d1 = d0 - 32;
            if (d0 < 0 || d0 > maxd) p0[r] = -INFINITY; if (d1 < 0 || d1 > maxd) p1[r] = -INFINITY; }
    } };
struct SrcMla { const bf16_t* kvu; const bf16_t* ua; int b, h;
    DI const bf16_t* krow(int kpos) const { return kvu + (size_t)(b * S + kpos) * 1024 + h * 128; }
    DI const bf16_t* vrow(int kpos) const { return kvu + (size_t)(b * S + kpos) * 1024 + h * 128 + 64; }
    DI const bf16_t* krow2(int kpos) const { return ua + (size_t)(b * S + kpos) * LDA + A_BKR; } };

DI void store_o(const f32x16 (&o)[2], float inv, bf16_t* orow, int hi) {
#pragma unroll
    for (int d0 = 0; d0 < 2; ++d0)
#pragma unroll
        for (int i = 0; i < 4; ++i) {
            const unsigned lo = cvtpk(o[d0][4 * i] * inv, o[d0][4 * i + 1] * inv), hv = cvtpk(o[d0][4 * i + 2] * inv, o[d0][4 * i + 3] * inv);
            *(unsigned long long*)(orow + 32 * d0 + 8 * i + 4 * hi) = (unsigned long long)lo | ((unsigned long long)hv << 32);
        }
}
DI void unit_mla(LAS unsigned char* lds, int tid, int b, int h, int qblk, const bf16_t* qm, const bf16_t* kvu, const bf16_t* ua, const bf16_t* ub, bf16_t* ob) {
    const int lane = tid & 63, r32 = lane & 31, hi = lane >> 5, wave = __builtin_amdgcn_readfirstlane(tid >> 6);
    const int q0 = 256 * qblk + 32 * wave, qpos = q0 + r32;
    const bf16_t* qrow = qm + (size_t)(b * S + qpos) * 768 + h * 96;
    bf16x8 qf[6];
#pragma unroll
    for (int d0 = 0; d0 < 6; ++d0) qf[d0] = *(const bf16x8*)(qrow + d0 * 16 + hi * 8);
    St st; st_init(st);
    SrcMla src{kvu, ua, b, h};
    MaskBand mk{1 << 30};
    run_stage<6>(lds, src, mk, 0, 4 * qblk + 4, 0, (q0 + 31) / 64 + 1, qf, st, 0.10206207261596577f * LOG2E, tid, qpos);
    const float lt = xhalf_sum(st.l), inv = 1.f / lt;
    const bf16_t* zrow = ub + (size_t)(b * S + qpos) * LDB + B_ZB + h * 64; bf16_t* orow = ob + (size_t)(b * S + qpos) * 512 + h * 64;
#pragma unroll
    for (int d0 = 0; d0 < 2; ++d0)
#pragma unroll
        for (int i = 0; i < 4; ++i) {
            const int d = 32 * d0 + 8 * i + 4 * hi;
            const unsigned long long zw = *(const unsigned long long*)(zrow + d);
            const float z0 = bflo((unsigned)zw) , z1 = bfhi((unsigned)zw), z2 = bflo((unsigned)(zw >> 32)), z3 = bfhi((unsigned)(zw >> 32));
            const unsigned lo = cvtpk(st.o[d0][4 * i] * inv * z0 * sigf(z0), st.o[d0][4 * i + 1] * inv * z1 * sigf(z1)), hv = cvtpk(st.o[d0][4 * i + 2] * inv * z2 * sigf(z2), st.o[d0][4 * i + 3] * inv * z3 * sigf(z3));
            *(unsigned long long*)(orow + d) = (unsigned long long)lo | ((unsigned long long)hv << 32);
        }
}
struct SrcDil { const bf16_t* base; int dil;
    DI const bf16_t* krow(int kpos) const { return base + (size_t)kpos * dil * LDA + 512; }
    DI const bf16_t* vrow(int kpos) const { return base + (size_t)kpos * dil * LDA + 1024; }
    DI const bf16_t* krow2(int) const { return base; } };
DI void unit_dil(LAS unsigned char* lds, int tid, int gi, int b, int h, int r, int qblk, const bf16_t* ua, bf16_t* od, float* lse) {
    const int lane = tid & 63, r32 = lane & 31, hi = lane >> 5, wave = __builtin_amdgcn_readfirstlane(tid >> 6);
    const int dil = (gi == 0) ? 1 : (gi == 1) ? 4 : 16;
    const int q0 = 256 * qblk + 32 * wave, qpos = q0 + r32;
    const bf16_t* base = ua + (size_t)(b * S + r) * LDA + A_CQKV + gi * 1536 + h * 64;
    const size_t tok = (size_t)b * S + (size_t)qpos * dil + r;
    const bf16_t* qrow = base + (size_t)qpos * dil * LDA;
    bf16x8 qf[4];
#pragma unroll
    for (int d0 = 0; d0 < 4; ++d0) qf[d0] = *(const bf16x8*)(qrow + d0 * 16 + hi * 8);
    St st; st_init(st);
    SrcDil src{base, dil};
    MaskBand mk{128};
    const int jt0 = (4 * qblk - 2) > 0 ? (4 * qblk - 2) : 0, jw0 = ((q0 - 128) >> 6) > 0 ? ((q0 - 128) >> 6) : 0;
    run_stage<4>(lds, src, mk, jt0, 4 * qblk + 4, jw0, (q0 + 31) / 64 + 1, qf, st, 0.125f * LOG2E, tid, qpos);
    const float lt = xhalf_sum(st.l);
    store_o(st.o, 1.f / lt, od + tok * 512 + h * 64, hi);
    if (hi == 0) lse[tok * 8 + h] = st.m * 0.125f + __logf(lt);
}
struct MaskSel { unsigned lo, hi32;
    DI bool bit(int j) const { return ((j < 32 ? lo >> j : hi32 >> (j - 32)) & 1u) != 0u; }
    DI bool skip(int j) const { return !__any(bit(j)); }
    DI void apply(f32x16& p0, f32x16& p1, int j, int qpos, int hi) const {
        const bool on = bit(j);
        const int kb = 64 * j + 4 * hi;
#pragma unroll
        for (int r = 0; r < 16; ++r) { const int k0 = kb + (r & 3) + 8 * (r >> 2);
            if (!on || k0 > qpos) p0[r] = -INFINITY; if (!on || k0 + 32 > qpos) p1[r] = -INFINITY; }
    } };
struct SrcAkv { const bf16_t* base;
    DI const bf16_t* krow(int kpos) const { return base + (size_t)kpos * LDA; }
    DI const bf16_t* vrow(int kpos) const { return base + (size_t)kpos * LDA + 128; }
    DI const bf16_t* krow2(int) const { return base; } };

DI void unit_nsa(LAS unsigned char* lds, int tid, int b, int hk, int qb, const bf16_t* ua, const bf16_t* ub, const bf16_t* kc, bf16_t* oa) {
    const int lane = tid & 63, r32 = lane & 31, hi = lane >> 5, wave = __builtin_amdgcn_readfirstlane(tid >> 6);
    const int g = wave >> 1, half = wave & 1, hq = hk * 4 + g;
    const int q0 = 64 * qb + 32 * half, qpos = q0 + r32;
    const size_t tok = (size_t)b * S + qpos;
    bf16x8 qf[4];
    { const bf16_t* qrow = ua + tok * LDA + A_AQ + hq * 64;
#pragma unroll
      for (int d0 = 0; d0 < 4; ++d0) qf[d0] = *(const bf16x8*)(qrow + d0 * 16 + hi * 8); }
    const float c = 0.125f * LOG2E;
    f32x16 oacc[2];
    {
        St st; st_init(st);
        f32x16 o2[2];
#pragma unroll
        for (int i = 0; i < 16; ++i) { o2[0][i] = 0.f; o2[1][i] = 0.f; }
        const int ntile = ((4 * qb + 2) >> 6) + 1;
        const int key = tid >> 3, ch = tid & 7;
        for (int t = 0; t < ntile; ++t) {
            const int cidx = 64 * t + key, cc = cidx < NC ? cidx : NC - 1;
            const bf16_t* kr = kc + ((size_t)(b * NC + cc) * 2 + hk) * 64;
            const u32x4 rk = *(const u32x4*)(kr + ch * 8), rv = *(const u32x4*)(kr + (size_t)CROWS * 64 + ch * 8);
            *(LAS u32x4*)(lds + KBUF + k_lds_off(key, ch)) = rk;
            *(LAS u32x4*)(lds + VBUF + v_lds_off(key, ch)) = rv;
            {
              const int jb = cidx >> 2, e3 = cidx & 3; unsigned short w[8];
#pragma unroll
              for (int e = 0; e < 8; ++e) { const int j = 8 * ch + e; w[e] = (cidx >= NC) ? 0 : (j == jb) ? (e3 < 3 ? 0x3F80 : 0x3F00) : (j == jb + 1 && e3 == 3) ? 0x3F00 : 0; }
              u32x4 ov; ov.x = w[0] | ((unsigned)w[1] << 16); ov.y = w[2] | ((unsigned)w[3] << 16); ov.z = w[4] | ((unsigned)w[5] << 16); ov.w = w[6] | ((unsigned)w[7] << 16);
              *(LAS u32x4*)(lds + OVBUF + v_lds_off(key, ch)) = ov; }
            __syncthreads();
            {
                f32x16 p0, p1; bf16x8 pa[4];
                qk_tile<4>(p0, p1, lds + KBUF, qf, r32, hi);
                const int kb = 64 * t + 4 * hi;
#pragma unroll
                for (int r = 0; r < 16; ++r) { const int c0 = kb + (r & 3) + 8 * (r >> 2);
                    if (c0 >= NC || 16 * c0 + 31 > qpos) p0[r] = -INFINITY; if (c0 + 32 >= NC || 16 * (c0 + 32) + 31 > qpos) p1[r] = -INFINITY; }
                const float alpha = softmax_tile(st, p0, p1, c, pa);
#pragma unroll
                for (int i = 0; i < 16; ++i) { o2[0][i] *= alpha; o2[1][i] *= alpha; }
                pv_tile(st.o, lds + VBUF, pa, lane);
                pv_tile(o2, lds + OVBUF, pa, lane);
            }
            __syncthreads();
        }
        const float lt = xhalf_sum(st.l), inv = lt > 0.f ? 1.f / lt : 0.f;
        const float g0 = sigf(bf2f(ub[tok * LDB + B_GATE + hq * 3 + 0])) * inv;
#pragma unroll
        for (int i = 0; i < 16; ++i) { oacc[0][i] = st.o[0][i] * g0; oacc[1][i] = st.o[1][i] * g0; }
        LAS float* imp = (LAS float*)(lds + IMP_OFF) + (g * 64 + 32 * half + r32) * IMP_LD;
#pragma unroll
        for (int d0 = 0; d0 < 2; ++d0)
#pragma unroll
            for (int r = 0; r < 16; ++r) imp[32 * d0 + crow(r, hi)] = o2[d0][r] * inv;
    }
    __syncthreads();
    {
        LAS const float* impb = (LAS const float*)(lds + IMP_OFF);
        for (int i = 0; i < 8; ++i) {
            const int tk = wave * 8 + i;
            float v = impb[(0 * 64 + tk) * IMP_LD + lane]; v += impb[(1 * 64 + tk) * IMP_LD + lane]; v += impb[(2 * 64 + tk) * IMP_LD + lane]; v += impb[(3 * 64 + tk) * IMP_LD + lane];
            const bool valid = lane <= qb, forced = (lane == 0) || (lane == qb) || (lane == qb - 1);
            const float score = forced ? 1e30f : (valid ? v : -1e30f);
            int rank = 0;
#pragma unroll
            for (int jj = 0; jj < 64; ++jj) { const float o = __uint_as_float(__builtin_amdgcn_readlane(__float_as_uint(score), jj)); rank += (o > score || (o == score && jj < lane)) ? 1 : 0; }
            const unsigned long long m = __ballot((rank < 16) && valid);
            if (lane == 0) *(LAS unsigned long long*)(lds + SELM_OFF + 8 * tk) = m;
        }
    }
    __syncthreads();
    {
        St st; st_init(st);
        const unsigned long long m = *(LAS const unsigned long long*)(lds + SELM_OFF + 8 * (32 * half + r32));
        MaskSel mk{(unsigned)m, (unsigned)(m >> 32)};
        SrcAkv src{ua + (size_t)b * S * LDA + A_AKV + 2 * 128 + hk * 64};
        run_stage<4>(lds, src, mk, 0, qb + 1, 0, qb + 1, qf, st, c, tid, qpos);
        const float lt = xhalf_sum(st.l);
        const float g1 = sigf(bf2f(ub[tok * LDB + B_GATE + hq * 3 + 1])) / lt;
#pragma unroll
        for (int i = 0; i < 16; ++i) { oacc[0][i] += st.o[0][i] * g1; oacc[1][i] += st.o[1][i] * g1; }
    }
    {
        St st; st_init(st);
        MaskBand mk{511};
        SrcAkv src{ua + (size_t)b * S * LDA + A_AKV + 4 * 128 + hk * 64};
        const int jt0 = qb > 8 ? qb - 8 : 0;
        int jw0 = (q0 - 511) >> 6; jw0 = jw0 > jt0 ? jw0 : jt0;
        run_stage<4>(lds, src, mk, jt0, qb + 1, jw0, qb + 1, qf, st, c, tid, qpos);
        const float lt = xhalf_sum(st.l);
        const float g2 = sigf(bf2f(ub[tok * LDB + B_GATE + hq * 3 + 2])) / lt;
#pragma unroll
        for (int i = 0; i < 16; ++i) { oacc[0][i] += st.o[0][i] * g2; oacc[1][i] += st.o[1][i] * g2; }
    }
    {
        const bf16_t* zrow = ub + tok * LDB + B_ZA + hq * 64; bf16_t* orow = oa + tok * 512 + hq * 64;
#pragma unroll
        for (int d0 = 0; d0 < 2; ++d0)
#pragma unroll
            for (int i = 0; i < 4; ++i) {
                const int d = 32 * d0 + 8 * i + 4 * hi;
                const unsigned long long zw = *(const unsigned long long*)(zrow + d);
                const float z0 = bflo((unsigned)zw), z1 = bfhi((unsigned)zw), z2 = bflo((unsigned)(zw >> 32)), z3 = bfhi((unsigned)(zw >> 32));
                const unsigned lo = cvtpk(oacc[d0][4 * i] * z0 * sigf(z0), oacc[d0][4 * i + 1] * z1 * sigf(z1)), hv = cvtpk(oacc[d0][4 * i + 2] * z2 * sigf(z2), oacc[d0][4 * i + 3] * z3 * sigf(z3));
                *(unsigned long long*)(orow + d) = (unsigned long long)lo | ((unsigned long long)hv << 32);
            }
    }
}
}
__global__ void k_combine_bc(bf16_t* o7, const float* lse, const bf16_t* ub) {
    size_t i = (size_t)blockIdx.x * blockDim.x + threadIdx.x;
    if (i >= (size_t)T * 512) return;
    int t = (int)(i / 512), col = (int)(i % 512), hq = col >> 6;
    const bf16_t* u = ub + (size_t)t * LDB;
    bf16_t* ob = o7 + O7_STRIDE; bf16_t* od0 = o7 + 2 * O7_STRIDE; bf16_t* od1 = o7 + 5 * O7_STRIDE; bf16_t* od2 = o7 + 6 * O7_STRIDE;
    float zb = bf2f(u[B_ZB + col]), zc = bf2f(u[B_ZC + col]);
    float obv = bf2f(ob[i]) * (zb * sigm(zb));
    float l0 = lse[((size_t)0 * T + t) * 8 + hq], l1 = lse[((size_t)1 * T + t) * 8 + hq], l2 = lse[((size_t)2 * T + t) * 8 + hq];
    float m = fmaxf(l0, fmaxf(l1, l2));
    float w0 = __expf(l0 - m), w1 = __expf(l1 - m), w2 = __expf(l2 - m);
    float oc = (w0 * bf2f(od0[i]) + w1 * bf2f(od1[i]) + w2 * bf2f(od2[i])) / (w0 + w1 + w2) * (zc * sigm(zc));
    ob[i] = f2bf(obv); od0[i] = f2bf(oc);
}
#define XB_TMO      128
#define XB_XCNT(j)  (256  + 64 * (j))
#define XB_XSUB(j)  (1280 + 64 * (j))
#define XB_XGEN(j)  (2304 + 64 * (j))
#define XB_TOP      3328
#define XB_TOPGEN   3392
#define XCD_BAR_WORDS 3456
#define XB_SPIN_CAP (1u << 18)

__device__ __forceinline__ unsigned xb_ld(unsigned* p)              { return __hip_atomic_load(p, __ATOMIC_RELAXED, __HIP_MEMORY_SCOPE_AGENT); }
__device__ __forceinline__ unsigned xb_add(unsigned* p, unsigned v) { return __hip_atomic_fetch_add(p, v, __ATOMIC_RELAXED, __HIP_MEMORY_SCOPE_AGENT); }
__device__ __forceinline__ unsigned xb_xcc_id() { return (unsigned)__builtin_amdgcn_s_getreg((3 << 11) | 20) & 0xFu; }
#define XB_SPIN(cond, bar) do { unsigned _sp = 0; while (cond) { __builtin_amdgcn_s_sleep(1); \
    if ((++_sp & 255u) == 0u) { if (xb_ld(&(bar)[XB_TMO])) break; if (_sp > XB_SPIN_CAP) { atomicAdd(&(bar)[XB_TMO], 1u); break; } } } } while (0)

struct XcdBarrier {
    unsigned* bar; unsigned x;
    volatile LAS unsigned* st;
};

__device__ __forceinline__ XcdBarrier xcd_barrier_post(unsigned* bar, volatile LAS unsigned* st) {
    XcdBarrier b; b.bar = bar; b.x = xb_xcc_id(); b.st = st;
    if (threadIdx.x == 0) (void)xb_add(&bar[XB_XCNT(b.x)], 1u);
    return b;
}
__device__ __forceinline__ void xcd_barrier_complete(unsigned* bar, unsigned x, unsigned& nloc, unsigned& nx) {
    const unsigned G = gridDim.x * gridDim.y * gridDim.z;
    unsigned sum, cnt, mine, sp = 0u;
    for (;;) {
        sum = 0u; cnt = 0u; mine = 0u;
#pragma unroll
        for (unsigned j = 0; j < 16; ++j) { const unsigned c = xb_ld(&bar[XB_XCNT(j)]); sum += c; cnt += (c > 0u) ? 1u : 0u; mine = (j == x) ? c : mine; }
        if (sum == G) break;
        __builtin_amdgcn_s_sleep(1);
        if ((++sp & 255u) == 0u) { if (xb_ld(&bar[XB_TMO])) break; if (sp > XB_SPIN_CAP) { atomicAdd(&bar[XB_TMO], 1u); break; } }
    }
    nloc = mine > 0u ? mine : 1u; nx = cnt > 0u ? cnt : 1u;
}

__device__ __forceinline__ void xcd_barrier(const XcdBarrier& b) {
    asm volatile("s_waitcnt vmcnt(0)" ::: "memory");
    __syncthreads();
    if (threadIdx.x == 0) {
        unsigned* bar = b.bar;
        __builtin_amdgcn_s_waitcnt(0);
        unsigned nloc = b.st[0], nx = b.st[1];
        if (nloc == 0u) { xcd_barrier_complete(bar, b.x, nloc, nx); b.st[0] = nloc; b.st[1] = nx; }
        const unsigned old = xb_add(&bar[XB_XSUB(b.x)], 1u);
        const unsigned gen = old / nloc;
        if (old + 1u == (gen + 1u) * nloc) {
            __builtin_amdgcn_fence(__ATOMIC_RELEASE, "agent");
            asm volatile("s_waitcnt vmcnt(0)" ::: "memory");
            const unsigned og = xb_add(&bar[XB_TOP], 1u);
            const unsigned tg = og / nx;
            if (og + 1u == (tg + 1u) * nx) xb_add(&bar[XB_TOPGEN], 1u);
            else XB_SPIN(xb_ld(&bar[XB_TOPGEN]) == tg, bar);
            __builtin_amdgcn_fence(__ATOMIC_ACQUIRE, "agent");
            xb_add(&bar[XB_XGEN(b.x)], 1u);
            asm volatile("s_waitcnt vmcnt(0)" ::: "memory");
        } else {
            XB_SPIN(xb_ld(&bar[XB_XGEN(b.x)]) == gen, bar);
            __builtin_amdgcn_fence(__ATOMIC_ACQUIRE, "agent");
            asm volatile("s_waitcnt vmcnt(0)" ::: "memory");
        }
    }
    __syncthreads();
}

enum { PH_CONV = 0, PH_WIN, PH_PREP, PH_G2, PH_KC, PH_ATT1, PH_COMB, PH_YABC, PH_WOUT, PH_POST, PH_PLE, PH_COUNT };
struct MArgs { const void* in[19]; float* out; unsigned char* ws; int ph_lo, ph_hi, l_lo, l_hi; };
static_assert(sizeof(MArgs) == 19 * 8 + 8 + 8 + 16, "no padding");

typedef __attribute__((address_space(4))) const char* kptr_t;
DI kptr_t kbase() { kptr_t p = (kptr_t)__builtin_amdgcn_kernarg_segment_ptr(); asm volatile("" : "+s"(p)); return p; }
template <typename Tp> DI Tp* kload_ptr(int off) { typedef Tp* ptr_t; typedef __attribute__((address_space(4))) const ptr_t* slot_t; return *(slot_t)(kbase() + off); }
DI int kload_int(int off) { typedef __attribute__((address_space(4))) const int* slot_t; return *(slot_t)(kbase() + off); }
#define KIN(type, i) kload_ptr<type>(8 * (i))
#define KOUT() kload_ptr<float>(152)
#define KWS() kload_ptr<unsigned char>(160)
#define KINT(off) kload_int(off)
#define WSP(type, off) ((type*)(KWS() + (off)))

DI void grid_barrier(unsigned* barw) {
    extern __shared__ __attribute__((aligned(16))) unsigned char lds_raw[];
    XcdBarrier b; b.bar = barw; b.x = xb_xcc_id(); b.st = (volatile LAS unsigned*)((LAS unsigned char*)lds_raw + LDSCTL_OFF + 64);
    xcd_barrier(b);
}

__global__ void __launch_bounds__(NTHREADS, 2) mega(MArgs) {
    extern __shared__ __attribute__((aligned(16))) unsigned char lds_raw[];
    LAS unsigned char* lds = (LAS unsigned char*)lds_raw;
#define G ((int)gridDim.x)
#define bx ((int)blockIdx.x)
#define vcu ((G % 8 == 0) ? (bx % 8) * (G / 8) + bx / 8 : bx)
#define NGW (G * NWAVES)
    for (int u = threadIdx.x; u < (LDS_BYTES - LDSCTL_OFF) / 4; u += NTHREADS) ((LAS unsigned*)(lds + LDSCTL_OFF))[u] = 0u;
    __syncthreads();
    pg8::hw_tid_init(lds);
    __syncthreads();
    (void)xcd_barrier_post(WSP(unsigned, WS_CTL) + CW_BAR, (volatile LAS unsigned*)(lds + LDSCTL_OFF + 64));
#define GRID_BAR() grid_barrier(WSP(unsigned, WS_CTL) + CW_BAR)

#define IN(k) (KINT(168) <= (k) && (k) < KINT(172))
#define SEAM(k) do { if (IN(k) && (IN((k) + 1) || ((k) == PH_COUNT - 1 && L + 1 < KINT(180) && KINT(168) == 0))) GRID_BAR(); } while (0)

    for (int L = KINT(176); L < KINT(180); ++L) {
        if (IN(PH_CONV)) {
            const float* w_in = KIN(const float, 5); const float* w_uq = KIN(const float, 11); const float* w_ukv = KIN(const float, 13); const float* cmp_w1 = KIN(const float, 7);
            const float* w_a = KIN(const float, 9); const float* w_b = KIN(const float, 14); const float* w_c = KIN(const float, 15); const float* w_out = KIN(const float, 16);
            const float* w_ple = KIN(const float, 17); const float* w_plg = KIN(const float, 18);
            bf16_t* WinT = WSP(bf16_t, WS_WIN); bf16_t* WuqT = WSP(bf16_t, WS_WUQ); bf16_t* WukvT = WSP(bf16_t, WS_WUKV); bf16_t* W1T = WSP(bf16_t, WS_W1);
            bf16_t* WabcT = WSP(bf16_t, WS_WABC); bf16_t* WoutT = WSP(bf16_t, WS_WOUT); bf16_t* WplgT = WSP(bf16_t, WS_WPLG); bf16_t* WpleT = WSP(bf16_t, WS_WPLE);
            int tid_ = pg8::hw_tid(lds); asm volatile("" : "+v"(tid_)); const int tid = tid_, lane = tid & 63, wave = __builtin_amdgcn_readfirstlane(tid >> 6); const int gw = vcu * NWAVES + wave;
            LAS float* scr = (LAS float*)(lds + wave * 16384);
            constexpr int I_IN = 16 * 346, I_UQ = 6 * 24, I_UKV = 2 * 32, I_W1 = 32 * 8, I_ABC = 8 * 32, I_OUT = 16 * 32, I_PLE = 4 * 32;
            constexpr int NITEMS = I_IN + I_UQ + I_UKV + 2 * I_W1 + 3 * I_ABC + 2 * I_OUT + I_PLE;
            for (int it = gw; it < NITEMS; it += NGW) {
                int r = it; const float* src; bf16_t* dst; int K_, N_; bool perm = false;
                if (r < I_IN) { src = w_in + (size_t)L * D * DIN; dst = WinT; K_ = D; N_ = DIN; perm = true; }
                else if ((r -= I_IN) < I_UQ) { src = w_uq + (size_t)L * 384 * 768; dst = WuqT; K_ = 384; N_ = 768; }
                else if ((r -= I_UQ) < I_UKV) { src = w_ukv + (size_t)L * 128 * 1024; dst = WukvT; K_ = 128; N_ = 1024; }
                else if ((r -= I_UKV) < 2 * I_W1) { const int kv = r / I_W1; r %= I_W1; src = cmp_w1 + ((size_t)L * 2 + kv) * 2048 * 256; dst = W1T + (size_t)kv * 256 * 2048; K_ = 2048; N_ = 256; }
                else if ((r -= 2 * I_W1) < 3 * I_ABC) { const int x = r / I_ABC; r %= I_ABC; src = (x == 0 ? w_a : x == 1 ? w_b : w_c) + (size_t)L * 512 * D; dst = WabcT + (size_t)x * 1024 * 512; K_ = 512; N_ = D; }
                else if ((r -= 3 * I_ABC) < I_OUT) { src = w_out + (size_t)L * D * D; dst = WoutT; K_ = D; N_ = D; }
                else if ((r -= I_OUT) < I_OUT) { src = w_plg + (size_t)L * D * D; dst = WplgT; K_ = D; N_ = D; }
                else { r -= I_OUT; src = w_ple + (size_t)L * 256 * D; dst = WpleT; K_ = 256; N_ = D; }
                tr_item(src, K_, N_, dst, scr, r, lane, perm);
            }
            { const int nz = (NPAD - WIN_VALID) * 1024 / 8; unsigned z0 = 0u; asm volatile("" : "+v"(z0)); u32x4 z = {z0, z0, z0, z0};
              for (int i = gw * 64 + lane; i < nz; i += NGW * 64) *(u32x4*)(WinT + (size_t)WIN_VALID * 1024 + (size_t)i * 8) = z; }
            { const float* p_in = KIN(const float, 1); bf16_t* PBF = WSP(bf16_t, WS_PBF); const float* ps = p_in + (size_t)L * T * 256; const int n8 = T * 256 / 8;
              for (int i = gw * 64 + lane; i < n8; i += NGW * 64) { const f32x4 a = *(const f32x4*)(ps + (size_t)i * 8), b = *(const f32x4*)(ps + (size_t)i * 8 + 4);
                  u32x4 w; w.x = pk2(a[0], a[1]); w.y = pk2(a[2], a[3]); w.z = pk2(b[0], b[1]); w.w = pk2(b[2], b[3]); *(u32x4*)(PBF + (size_t)i * 8) = w; } }
            if (L == 0) {
                const int* pos = KIN(const int, 2); float* TAB = WSP(float, WS_TAB);
                for (int i = gw * 64 + lane; i < T * 24; i += NGW * 64) {
                    const int t = i / 24, j = i % 24; const float p = (float)pos[t];
                    if (j < 8) { const float a = p * powf(500000.0f, -(float)(2 * j) / 16.0f); TAB[(size_t)t * 48 + j] = cosf(a); TAB[(size_t)t * 48 + 8 + j] = sinf(a); }
                    else { const int jj = j - 8; const float a = p * powf(500000.0f, -(float)(2 * jj) / 32.0f); TAB[(size_t)t * 48 + 16 + jj] = cosf(a); TAB[(size_t)t * 48 + 32 + jj] = sinf(a); }
                }
            }
            { const float* xout = (L == 0) ? KIN(const float, 0) : (const float*)KOUT(); const float* g_pre = KIN(const float, 3); bf16_t* H = WSP(bf16_t, WS_H);
              for (int m = gw; m < T; m += NGW) rms_row_f32(xout + (size_t)m * D, g_pre + (size_t)L * D, H + (size_t)m * D, lane); }
        }
        SEAM(PH_CONV);
        if (IN(PH_WIN)) {
            pg8::Gemm g{WSP(bf16_t, WS_H), WSP(bf16_t, WS_WIN), T, NPAD, D}; pg8::StaticOrder S; S.init(T, NPAD, G, bx);
            EpiWin Ep{WSP(bf16_t, WS_UA), WSP(bf16_t, WS_UB), WSP(float, WS_TAB)};
            pg8::gemm_phase<EpiWin, pg8::StaticOrder, true, true>(lds, g, S, Ep);
        }
        SEAM(PH_WIN);
        if (IN(PH_PREP)) {
            int tid_ = pg8::hw_tid(lds); asm volatile("" : "+v"(tid_)); const int tid = tid_, lane = tid & 63, wave = __builtin_amdgcn_readfirstlane(tid >> 6); const int gw = vcu * NWAVES + wave;
            { const bf16_t* UA = WSP(bf16_t, WS_UA); bf16_t* QN = WSP(bf16_t, WS_QN); bf16_t* KVN = WSP(bf16_t, WS_KVN);
              const float* gq = KIN(const float, 10) + (size_t)L * 384; const float* gkv = KIN(const float, 12) + (size_t)L * 128;
              for (int m = gw; m < T; m += NGW) {
                  const bool isq = lane < 48; const int e0 = isq ? lane * 8 : (lane - 48) * 8;
                  const u32x4 w = *(const u32x4*)(UA + (size_t)m * LDA + (isq ? A_BCQ : A_BCKV) + e0);
                  float v[8] = {bflo(w.x), bfhi(w.x), bflo(w.y), bfhi(w.y), bflo(w.z), bfhi(w.z), bflo(w.w), bfhi(w.w)};
                  float ss = 0.f;
#pragma unroll
                  for (int e = 0; e < 8; ++e) ss += v[e] * v[e];
                  const float sq = wsum(isq ? ss : 0.f, lane), sk = wsum(isq ? 0.f : ss, lane);
                  const float rs = isq ? rsqrtf(sq * (1.f / 384.f) + 1e-6f) : rsqrtf(sk * (1.f / 128.f) + 1e-6f);
                  const float* gp = (isq ? gq : gkv) + e0;
                  const f32x4 g0 = *(const f32x4*)gp, g1 = *(const f32x4*)(gp + 4);
                  u32x4 o; o.x = pk2(v[0] * rs * g0[0], v[1] * rs * g0[1]); o.y = pk2(v[2] * rs * g0[2], v[3] * rs * g0[3]); o.z = pk2(v[4] * rs * g1[0], v[5] * rs * g1[1]); o.w = pk2(v[6] * rs * g1[2], v[7] * rs * g1[3]);
                  if (isq) *(u32x4*)(QN + (size_t)m * 384 + e0) = o; else *(u32x4*)(KVN + (size_t)m * 128 + e0) = o;
              } }
            { const bf16_t* UA = WSP(bf16_t, WS_UA); bf16_t* FLAT = WSP(bf16_t, WS_FLAT); const float* pe = KIN(const float, 6) + (size_t)L * 2 * 32 * 64;
              for (int i = gw * 64 + lane; i < 2 * CROWS * 256; i += NGW * 64) {
                  const int kv = i / (CROWS * 256), rem = i % (CROWS * 256), row = rem >> 8, gcol = rem & 255, l = gcol >> 3, d = (gcol & 7) * 8;
                  u32x4 o = {0u, 0u, 0u, 0u};
                  if (row < NB * NC * 2) {
                      const int hk = row & 1, bc = row >> 1, b = bc / NC, c = bc % NC;
                      const u32x4 w = *(const u32x4*)(UA + (size_t)(b * S + 16 * c + l) * LDA + A_AKV + kv * 128 + hk * 64 + d);
                      const float* pp = pe + (kv * 32 + l) * 64 + d; const f32x4 p0 = *(const f32x4*)pp, p1 = *(const f32x4*)(pp + 4);
                      o.x = pk2(bflo(w.x) + p0[0], bfhi(w.x) + p0[1]); o.y = pk2(bflo(w.y) + p0[2], bfhi(w.y) + p0[3]); o.z = pk2(bflo(w.z) + p1[0], bfhi(w.z) + p1[1]); o.w = pk2(bflo(w.w) + p1[2], bfhi(w.w) + p1[3]);
                  }
                  *(u32x4*)(FLAT + (size_t)i * 8) = o;
              } }
        }
        SEAM(PH_PREP);
        if (IN(PH_G2)) {
            { pg8::Gemm g{WSP(bf16_t, WS_QN), WSP(bf16_t, WS_WUQ), T, 768, 384}; pg8::StaticOrder S; S.init(T, 768, G, bx); EpiQm Ep{WSP(bf16_t, WS_QM), WSP(float, WS_TAB)};
              pg8::gemm_phase<EpiQm, pg8::StaticOrder, true, true>(lds, g, S, Ep); }
            __syncthreads();
            { pg8::Gemm g{WSP(bf16_t, WS_KVN), WSP(bf16_t, WS_WUKV), T, 1024, 128}; pg8::StaticOrder S; S.init(T, 1024, G, bx); EpiBfPlain Ep{WSP(bf16_t, WS_KVU), 1024, 0};
              pg8::gemm_phase<EpiBfPlain, pg8::StaticOrder, true, true>(lds, g, S, Ep); }
            __syncthreads();
            { pg8::Gemm g{WSP(bf16_t, WS_FLAT), WSP(bf16_t, WS_W1), 2 * CROWS, 512, 2048}; HidOrder S{G, bx};
              EpiF32<1> Ep{WSP(float, WS_HID), 256, 0};
              pg8::gemm_phase<EpiF32<1>, HidOrder, true, true>(lds, g, S, Ep); }
        }
        SEAM(PH_G2);
        if (IN(PH_KC)) {
            int tid_ = pg8::hw_tid(lds); asm volatile("" : "+v"(tid_)); const int tid = tid_, lane = tid & 63, wave = __builtin_amdgcn_readfirstlane(tid >> 6); const int gw = vcu * NWAVES + wave;
            const float* HID = WSP(float, WS_HID); bf16_t* KC = WSP(bf16_t, WS_KC); const float* w2 = KIN(const float, 8) + (size_t)L * 2 * 256 * 64;
            LAS float* hrow = (LAS float*)(lds + wave * 1024);
            for (int r = gw; r < 2 * CROWS; r += NGW) {
                const int kv = r / CROWS;
                *(LAS f32x4*)(hrow + 4 * lane) = *(const f32x4*)(HID + (size_t)r * 256 + 4 * lane);
                asm volatile("s_waitcnt lgkmcnt(0)" ::: "memory");
                const float* wp = w2 + (size_t)kv * 256 * 64 + lane;
                float acc = 0.f;
#pragma unroll 8
                for (int k = 0; k < 256; ++k) acc += hrow[k] * wp[(size_t)k * 64];
                KC[(size_t)r * 64 + lane] = f2bf(acc);
                asm volatile("s_waitcnt lgkmcnt(0)" ::: "memory");
            }
        }
        SEAM(PH_KC);
        if (IN(PH_ATT1)) {
            int tid_ = pg8::hw_tid(lds); asm volatile("" : "+v"(tid_)); const int tid = tid_;
            unsigned* qctr = WSP(unsigned, WS_CTL) + CW_QUEUE + 64 * L;
            LAS unsigned* wq = (LAS unsigned*)(lds + fa::WQ_OFF);
            for (;;) {
                if (tid == 0) *wq = atomicAdd(qctr, 1u);
                __syncthreads();
                const int id = (int)*wq;
                __syncthreads();
                if (id >= 2560) break;
                if (id < 1024) {
                    const int gq = id >> 6, r = id & 63;
                    if (r >= 8 && r < 40) { const int bh = r - 8;
                        fa::unit_mla(lds, tid, bh >> 3, bh & 7, 15 - gq, WSP(bf16_t, WS_QM), WSP(bf16_t, WS_KVU), WSP(bf16_t, WS_UA), WSP(bf16_t, WS_UB), WSP(bf16_t, WS_O7) + O7_STRIDE);
                    } else { const int k = (r < 8) ? 0 : ((r - 40) >> 3) + 1, bk = r & 7;
                        fa::unit_nsa(lds, tid, bk >> 1, bk & 1, 63 - 4 * gq - k, WSP(bf16_t, WS_UA), WSP(bf16_t, WS_UB), WSP(bf16_t, WS_KC), WSP(bf16_t, WS_O7)); }
                } else {
                    const int e = id - 1024, gi = e >> 9, bh = e & 31, rest = (e >> 5) & 15;
                    const int dil = (gi == 0) ? 1 : (gi == 1) ? 4 : 16;
                    fa::unit_dil(lds, tid, gi, bh >> 3, bh & 7, rest % dil, rest / dil, WSP(bf16_t, WS_UA),
                                 WSP(bf16_t, WS_O7) + (size_t)(gi == 0 ? 2 : gi == 1 ? 5 : 6) * O7_STRIDE, WSP(float, WS_LSE) + (size_t)gi * T * 8);
                }
            }
        }
        SEAM(PH_ATT1);
        if (IN(PH_COMB)) {
            int tid_ = pg8::hw_tid(lds); asm volatile("" : "+v"(tid_)); const int tid = tid_, lane = tid & 63, wave = __builtin_amdgcn_readfirstlane(tid >> 6); const int gw = vcu * NWAVES + wave;
            bf16_t* O7 = WSP(bf16_t, WS_O7); const float* LSE = WSP(float, WS_LSE); const bf16_t* UB = WSP(bf16_t, WS_UB);
            bf16_t* od0 = O7 + 2 * O7_STRIDE; const bf16_t* od1 = O7 + 5 * O7_STRIDE; const bf16_t* od2 = O7 + 6 * O7_STRIDE;
            for (int i = gw * 64 + lane; i < T * 64; i += NGW * 64) {
                const int t = i >> 6, col = (i & 63) * 8, h = col >> 6;
                const float l0 = LSE[((size_t)0 * T + t) * 8 + h], l1 = LSE[((size_t)1 * T + t) * 8 + h], l2 = LSE[((size_t)2 * T + t) * 8 + h];
                const float mx = fmaxf(l0, fmaxf(l1, l2));
                float w0 = __expf(l0 - mx), w1 = __expf(l1 - mx), w2 = __expf(l2 - mx); const float iw = __builtin_amdgcn_rcpf(w0 + w1 + w2); w0 *= iw; w1 *= iw; w2 *= iw;
                const size_t o = (size_t)t * 512 + col;
                const u32x4 a = *(const u32x4*)(od0 + o), b = *(const u32x4*)(od1 + o), c = *(const u32x4*)(od2 + o), z = *(const u32x4*)(UB + (size_t)t * LDB + B_ZC + col);
                const unsigned aw[4] = {a.x, a.y, a.z, a.w}, bw[4] = {b.x, b.y, b.z, b.w}, cw[4] = {c.x, c.y, c.z, c.w}, zw[4] = {z.x, z.y, z.z, z.w}; unsigned ow[4];
#pragma unroll
                for (int e = 0; e < 4; ++e) { const float z0 = bflo(zw[e]), z1 = bfhi(zw[e]);
                    ow[e] = pk2((w0 * bflo(aw[e]) + w1 * bflo(bw[e]) + w2 * bflo(cw[e])) * z0 * sigf(z0), (w0 * bfhi(aw[e]) + w1 * bfhi(bw[e]) + w2 * bfhi(cw[e])) * z1 * sigf(z1)); }
                *(u32x4*)(od0 + o) = (u32x4){ow[0], ow[1], ow[2], ow[3]};
            }
        }
        SEAM(PH_COMB);
        if (IN(PH_YABC)) {
            pg8::Gemm g{WSP(bf16_t, WS_O7), WSP(bf16_t, WS_WABC), 3 * T, 3 * 1024, 512}; YabcOrder S{G, vcu};
            EpiYabc Ep{WSP(float, WS_YMIX), WSP(bf16_t, WS_YMIXB), WSP(bf16_t, WS_UB)};
            pg8::gemm_phase<EpiYabc, YabcOrder, true, true>(lds, g, S, Ep);
        }
        SEAM(PH_YABC);
        if (IN(PH_WOUT)) {
            pg8::Gemm g{WSP(bf16_t, WS_YMIXB), WSP(bf16_t, WS_WOUT), T, D, D}; pg8::StaticOrder S; S.init(T, D, G, bx);
            EpiF32<0> Ep{WSP(float, WS_Y2), D, -1};
            pg8::gemm_phase<EpiF32<0>, pg8::StaticOrder, true, true>(lds, g, S, Ep);
        }
        SEAM(PH_WOUT);
        if (IN(PH_POST)) {
            int tid_ = pg8::hw_tid(lds); asm volatile("" : "+v"(tid_)); const int tid = tid_, lane = tid & 63, wave = __builtin_amdgcn_readfirstlane(tid >> 6); const int gw = vcu * NWAVES + wave;
            const float* xsrc = (L == 0) ? KIN(const float, 0) : (const float*)KOUT(); float* xout = KOUT(); const float* Y2 = WSP(float, WS_Y2); bf16_t* H = WSP(bf16_t, WS_H);
            const float* gp = KIN(const float, 4) + (size_t)L * D;
            for (int m = gw; m < T; m += NGW) {
                const f32x4* yr = (const f32x4*)(Y2 + (size_t)m * D) + lane; const f32x4* xr = (const f32x4*)(xsrc + (size_t)m * D) + lane; const f32x4* gr = (const f32x4*)gp + lane;
                f32x4 v[4]; float s = 0.f;
#pragma unroll
                for (int j = 0; j < 4; ++j) { v[j] = yr[64 * j]; s += (v[j][0] * v[j][0] + v[j][1] * v[j][1]) + (v[j][2] * v[j][2] + v[j][3] * v[j][3]); }
                const float rs = rsqrtf(wsum(s, lane) * (1.f / 1024.f) + 1e-6f);
                f32x4* xo = (f32x4*)(xout + (size_t)m * D) + lane; unsigned long long* h8 = (unsigned long long*)(H + (size_t)m * D) + lane;
#pragma unroll
                for (int j = 0; j < 4; ++j) { const f32x4 gg = gr[64 * j]; f32x4 xn = xr[64 * j];
                    xn[0] += v[j][0] * rs * gg[0]; xn[1] += v[j][1] * rs * gg[1]; xn[2] += v[j][2] * rs * gg[2]; xn[3] += v[j][3] * rs * gg[3];
                    xo[64 * j] = xn; h8[64 * j] = (unsigned long long)pk2(xn[0], xn[1]) | ((unsigned long long)pk2(xn[2], xn[3]) << 32); }
            }
        }
        SEAM(PH_POST);
        if (IN(PH_PLE)) {
            { pg8::Gemm g{WSP(bf16_t, WS_PBF), WSP(bf16_t, WS_WPLE), T, D, 256}; pg8::StaticOrder S; S.init(T, D, G, bx); EpiF32<0> Ep{WSP(float, WS_E), D, -1};
              pg8::gemm_phase<EpiF32<0>, pg8::StaticOrder, true, true>(lds, g, S, Ep); }
            __syncthreads();
            { pg8::Gemm g{WSP(bf16_t, WS_H), WSP(bf16_t, WS_WPLG), T, D, D}; pg8::StaticOrder S; S.init(T, D, G, bx); EpiPlgF Ep{KOUT(), WSP(float, WS_E)};
              pg8::gemm_phase<EpiPlgF, pg8::StaticOrder, true, true>(lds, g, S, Ep); }
        }
        SEAM(PH_PLE);
    }
#undef IN
#undef SEAM
#undef G
#undef bx
#undef vcu
#undef NGW
}

static void launch_mega(hipStream_t st, void* const* d_in, void* d_out, void* d_ws, int ph_lo, int ph_hi, int l_lo, int l_hi) {
    MArgs a{};
    for (int i = 0; i < 19; ++i) a.in[i] = d_in[i];
    a.out = (float*)d_out; a.ws = (unsigned char*)d_ws; a.ph_lo = ph_lo; a.ph_hi = ph_hi; a.l_lo = l_lo; a.l_hi = l_hi;
    (void)hipMemsetAsync((char*)d_ws + WS_CTL, 0, 1 << 20, st);
    hipLaunchKernelGGL(mega, dim3(256), dim3(NTHREADS), LDS_BYTES, st, a);
}
template <typename TA, class Epi>
static void gemm(hipStream_t st, const TA* A, int lda, const float* Bm, int ldb, int M, int N, int K, Epi epi) {
    dim3 grid((N + 63) / 64, M / 64);
    hipLaunchKernelGGL((k_gemm<TA, Epi>), grid, dim3(256), 0, st, A, lda, Bm, ldb, M, N, K, epi);
}

extern "C" void kernel_launch(void* const* d_in, const int* in_sizes, int n_in, void* d_out, int out_size, void* d_ws, size_t ws_size, hipStream_t stream) {
    if (ws_size < WS_END2) return;
    (void)hipFuncSetAttribute((const void*)mega, hipFuncAttributeMaxDynamicSharedMemorySize, LDS_BYTES);
    const float* x_in = (const float*)d_in[0];
    const float* g_post = (const float*)d_in[4];
    const float* cmp_pe = (const float*)d_in[6];
    const float* cmp_w2 = (const float*)d_in[8];
    const float* g_q = (const float*)d_in[10];
    const float* g_kv = (const float*)d_in[12];
    unsigned char* ws = (unsigned char*)d_ws;
    float* x = (float*)d_out;
    bf16_t* UA = (bf16_t*)(ws + WS_UA); bf16_t* UB = (bf16_t*)(ws + WS_UB); bf16_t* H = (bf16_t*)(ws + WS_H);
    bf16_t* O7 = (bf16_t*)(ws + WS_O7); float* LSE = (float*)(ws + WS_LSE);
    bf16_t* QM = (bf16_t*)(ws + WS_QM); bf16_t* KVU = (bf16_t*)(ws + WS_KVU); bf16_t* FLAT = (bf16_t*)(ws + WS_FLAT);
    float* HID = (float*)(ws + WS_HID); bf16_t* KC = (bf16_t*)(ws + WS_KC); unsigned long long* SEL = (unsigned long long*)(ws + WS_SEL);
    float* Y2 = (float*)(ws + WS_Y2);
    bf16_t* QN = (bf16_t*)(ws + WS_QN); bf16_t* KVN = (bf16_t*)(ws + WS_KVN);
    launch_mega(stream, d_in, d_out, d_ws, 0, PH_COUNT, 0, DEPTH);
    (void)x; (void)x_in; (void)g_post; (void)cmp_pe; (void)cmp_w2; (void)g_q; (void)g_kv; (void)UA; (void)UB; (void)H; (void)O7; (void)LSE; (void)QM; (void)KVU; (void)FLAT; (void)HID; (void)KC; (void)SEL; (void)Y2; (void)QN; (void)KVN;
}
```

```cpp
#include <hip/hip_runtime.h>
#include <stdint.h>
#include <math.h>

typedef unsigned short bf16_t;
#define DI __device__ __forceinline__

constexpr int NB = 4, S = 4096, T = NB * S, D = 1024, DEPTH = 4;
constexpr int DIN = 11064;
constexpr int A_AQ = 0, A_AKV = 512, A_BCQ = 1280, A_BCKV = 1664, A_BKR = 1792, A_CQKV = 1824, LDA = 6432;
constexpr int B_ZA = 0, B_ZB = 512, B_ZC = 1024, B_MG = 1536, B_GATE = 4608, LDB = 4640;
constexpr int NC = 255;
constexpr int CROWS = 2048;

constexpr size_t al256(size_t x) { return (x + 255) & ~(size_t)255; }
constexpr size_t WS_CTL = 0;
constexpr size_t WS_UA = 1 << 20;
constexpr size_t WS_UB = WS_UA + al256((size_t)T * LDA * 2);
constexpr size_t WS_H = WS_UB + al256((size_t)T * LDB * 2);
constexpr size_t WS_O7 = WS_H + al256((size_t)T * 1024 * 2);
constexpr size_t O7_STRIDE = (size_t)T * 512;
constexpr size_t WS_LSE = WS_O7 + al256(7 * O7_STRIDE * 2);
constexpr size_t WS_QM = WS_LSE + al256((size_t)3 * T * 8 * 4);
constexpr size_t WS_KVU = WS_QM + al256((size_t)T * 768 * 2);
constexpr size_t WS_FLAT = WS_KVU + al256((size_t)T * 1024 * 2);
constexpr size_t WS_HID = WS_FLAT + al256((size_t)2 * CROWS * 2048 * 2);
constexpr size_t WS_KC = WS_HID + al256((size_t)2 * CROWS * 256 * 4);
constexpr size_t WS_SEL = WS_KC + al256((size_t)2 * CROWS * 64 * 2);
constexpr size_t WS_TAB = WS_SEL + al256((size_t)T * 2 * 8);
constexpr size_t WS_END = WS_TAB + al256((size_t)T * 48 * 4);
constexpr size_t WS_YMIX = WS_UA;
constexpr size_t WS_YMIXB = WS_YMIX + (size_t)T * 1024 * 4;
constexpr size_t WS_Y2 = WS_YMIXB + (size_t)T * 1024 * 2;
constexpr size_t WS_E = WS_YMIX;
static_assert(WS_Y2 + (size_t)T * 1024 * 4 <= WS_UB, "alias region fits in UA");
constexpr size_t WS_QN = WS_H;
constexpr size_t WS_KVN = WS_H + (size_t)T * 384 * 2;

DI float bf2f(bf16_t v) { return __uint_as_float(((unsigned)v) << 16); }
DI bf16_t f2bf(float f) { unsigned u = __float_as_uint(f); u += 0x7fffu + ((u >> 16) & 1u); return (bf16_t)(u >> 16); }
DI float sigm(float x) { return 1.f / (1.f + __expf(-x)); }
DI float wave_sum(float v) { for (int o = 32; o > 0; o >>= 1) v += __shfl_xor(v, o); return v; }
DI float wave_max(float v) { for (int o = 32; o > 0; o >>= 1) v = fmaxf(v, __shfl_xor(v, o)); return v; }
DI float ldf(const float* p) { return *p; }
DI float ldf(const bf16_t* p) { return bf2f(*p); }


namespace pg8 {
#define PG8_LAS __attribute__((address_space(3)))
typedef unsigned short bf16_t;
typedef short bf16x8 __attribute__((ext_vector_type(8)));
typedef float f32x4 __attribute__((ext_vector_type(4)));
typedef unsigned u32x4 __attribute__((ext_vector_type(4)));
constexpr int BM = 256, BK = 64, HALF = 128, HTB = HALF * BK * 2  , STAGE_BYTES = 8 * HTB, NXCD = 8, WGM = 8;

__host__ __device__ __forceinline__ int lds_byte(int r, int c) { const int st = (r >> 4) * 2 + (c >> 5), rr = r & 15, cc = c & 31, ob = rr * 64 + cc * 2; return st * 1024 + (ob ^ (((ob >> 9) & 1) << 5)); }
__host__ __device__ __forceinline__ void stage_rc(int b, int& R, int& C) { const int st = b / 1024, sb = b % 1024, swz = sb ^ (((sb >> 9) & 1) << 5); R = (st >> 1) * 16 + swz / 64; C = (st & 1) * 32 + (swz % 64) / 2; }
__host__ __device__ __forceinline__ int perm32(int rho) { const int n = rho >> 4, i = rho & 15; return 8 * (i >> 2) + 4 * n + (i & 3); }

constexpr int HWTID_OFF = 131072 + 1024;
__device__ __forceinline__ unsigned hw_slot() { const unsigned h = (unsigned)__builtin_amdgcn_s_getreg((6 << 11) | (0 << 6) | 4); return h & 63u; }
__device__ __forceinline__ void hw_tid_init(PG8_LAS unsigned char* lds) { if ((threadIdx.x & 63) == 0) *(PG8_LAS unsigned*)(lds + HWTID_OFF + 4 * hw_slot()) = threadIdx.x >> 6; }
__device__ __forceinline__ int hw_tid(PG8_LAS unsigned char* lds) {
    const unsigned w = *(PG8_LAS unsigned*)(lds + HWTID_OFF + 4 * hw_slot());
    int lane; asm volatile("v_mbcnt_lo_u32_b32 %0, -1, 0\n\tv_mbcnt_hi_u32_b32 %0, -1, %0" : "=v"(lane));
    return (int)__builtin_amdgcn_readfirstlane(w) * 64 + lane;
}
struct Unit { int pm, pn; };
struct Gemm { const bf16_t* A; const bf16_t* Bt; int M, N, K; };

struct StaticOrder {
    int nM, nN, nwg, G, c;
    __host__ __device__ void init(int M, int N, int G_, int c_) { nM = M / BM; nN = N / BM; nwg = nM * nN; G = G_; c = c_; }
    __host__ __device__ bool next(int i, Unit& u) const {
        const long L = (long)i * G + c; if (L >= nwg) return false;
        int wgid = (int)L; { const int q = nwg / NXCD, r = nwg % NXCD, xcd = wgid % NXCD, off = wgid / NXCD; wgid = (xcd < r ? xcd * (q + 1) : r * (q + 1) + (xcd - r) * q) + off; }
        const int nig = WGM * nN, gid = wgid / nig, fm = gid * WGM, gsz = (nM - fm) < WGM ? (nM - fm) : WGM;
        u.pm = fm + ((wgid % nig) % gsz); u.pn = (wgid % nig) / gsz; return true;
    }
    __device__ __forceinline__ void a_ready(const Unit&) const {}
    __device__ __forceinline__ void done(const Unit&) const {}
};

__device__ __forceinline__ unsigned cvt_pk_bf16(float lo, float hi) { unsigned r; asm volatile("v_cvt_pk_bf16_f32 %0, %1, %2" : "=v"(r) : "v"(lo), "v"(hi)); return r; }

template <class Epi, class Sched, bool ALIGN_EPI = false, bool SP2 = false>
__device__ __forceinline__ void gemm_phase(PG8_LAS unsigned char* lds, const Gemm g, const Sched& S, const Epi& E) {
    int tid_ = hw_tid(lds); asm volatile("" : "+v"(tid_));
    const int tid = tid_, wid = __builtin_amdgcn_readfirstlane(tid >> 6), lane = tid & 63, wr = wid >> 2, wc = wid & 3, fr = lane & 15, fq = lane >> 4;
    int K_ = g.K; asm volatile("" : "+s"(K_));
    __builtin_assume(K_ >= 128 && K_ % 128 == 0);
    const int K = K_, nt = K / BK;
    unsigned voffA[2], voffB[2];
#pragma unroll
    for (int i = 0; i < 2; ++i) { int R, C; stage_rc(tid * 16 + i * 8192, R, C); const int Rb = Epi::PERM ? ((R & ~31) + perm32(R & 31)) : R;
        voffA[i] = (unsigned)(R * K + C) * 2u; voffB[i] = (unsigned)(Rb * K + C) * 2u; }
    const size_t kstep = (size_t)(BK * 2);
    const size_t hstep = (size_t)HALF * K * 2;
    const size_t tstep = 2 * hstep;
    const unsigned ldsw = (unsigned)wid * 1024u;
    const int aoff = lds_byte(wr * 64 + fr, fq * 8), boff = lds_byte(wc * 32 + fr, fq * 8);
#define PG8_SA(b, h) (((b) * 2 + (h)) * HTB)
#define PG8_SB(b, h) ((4 + (b) * 2 + (h)) * HTB)
#define PG8_STAGE(bufoff, gbase, voff) do { _Pragma("unroll") for (int _i = 0; _i < 2; ++_i) \
        __builtin_amdgcn_global_load_lds((const unsigned*)((const char*)(gbase) + (voff)[_i]), (PG8_LAS unsigned*)(lds + (bufoff) + ldsw + _i * 8192), 16, 0, 0); } while (0)
#define PG8_LDA(dst, b, h) do { _Pragma("unroll") for (int m = 0; m < 4; ++m) _Pragma("unroll") for (int k = 0; k < 2; ++k) dst[m][k] = *(const PG8_LAS bf16x8*)(lds + PG8_SA(b, h) + aoff + m * 2048 + k * 1024); } while (0)
#define PG8_LDB(dst, b, h) do { _Pragma("unroll") for (int n = 0; n < 2; ++n) _Pragma("unroll") for (int k = 0; k < 2; ++k) dst[n][k] = *(const PG8_LAS bf16x8*)(lds + PG8_SB(b, h) + boff + n * 2048 + k * 1024); } while (0)
#define PG8_MMA(ai, bj, At, Bt) do { __builtin_amdgcn_s_setprio(1); _Pragma("unroll") for (int m = 0; m < 4; ++m) _Pragma("unroll") for (int n = 0; n < 2; ++n) _Pragma("unroll") for (int k = 0; k < 2; ++k) \
        acc[ai][bj][m][n] = __builtin_amdgcn_mfma_f32_16x16x32_bf16(Bt[n][k], At[m][k], acc[ai][bj][m][n], 0, 0, 0); __builtin_amdgcn_s_setprio(0); } while (0)
#define PG8_WAIT_V(n) asm volatile("s_waitcnt vmcnt(" #n ")" ::: "memory")
#define PG8_WAIT_L(n) asm volatile("s_waitcnt lgkmcnt(" #n ")" ::: "memory")
#define PG8_BAR __builtin_amdgcn_s_barrier()
#define PG8_SCHED __builtin_amdgcn_sched_barrier(0)
    Unit cur, nxt; int ui = 0;
    if (!S.next(0, cur)) return;
    float zf_ = 0.f; asm volatile("" : "+v"(zf_));
    f32x4 acc[2][2][4][2];
#pragma unroll
    for (int a = 0; a < 2; ++a)
#pragma unroll
        for (int b = 0; b < 2; ++b)
#pragma unroll
            for (int m = 0; m < 4; ++m)
#pragma unroll
                for (int n = 0; n < 2; ++n) acc[a][b][m][n] = (f32x4){zf_, zf_, zf_, zf_};
    bf16x8 At[4][2], B0[2][2], B1[2][2];
    const char* cA = (const char*)g.A + (size_t)cur.pm * tstep; const char* cB = (const char*)g.Bt + (size_t)cur.pn * tstep;
    S.a_ready(cur);
    if constexpr (SP2) {
        PG8_STAGE(PG8_SB(0, 0), cB, voffB); PG8_STAGE(PG8_SB(0, 1), cB + hstep, voffB); PG8_STAGE(PG8_SA(0, 0), cA, voffA); PG8_STAGE(PG8_SA(0, 1), cA + hstep, voffA);
        if (wr == 1) PG8_BAR;
        PG8_WAIT_V(2); PG8_BAR;
        PG8_STAGE(PG8_SB(1, 0), cB + kstep, voffB); PG8_STAGE(PG8_SA(1, 0), cA + kstep, voffA); PG8_STAGE(PG8_SB(1, 1), cB + hstep + kstep, voffB);
        PG8_WAIT_V(6); PG8_BAR;
    } else {
        PG8_STAGE(PG8_SB(0, 0), cB, voffB); PG8_STAGE(PG8_SA(0, 0), cA, voffA); PG8_STAGE(PG8_SB(0, 1), cB + hstep, voffB); PG8_STAGE(PG8_SA(0, 1), cA + hstep, voffA);
        if (wr == 1) PG8_BAR;
        PG8_WAIT_V(4); PG8_BAR;
        PG8_STAGE(PG8_SB(1, 0), cB + kstep, voffB); PG8_STAGE(PG8_SA(1, 0), cA + kstep, voffA); PG8_STAGE(PG8_SB(1, 1), cB + hstep + kstep, voffB);
        PG8_WAIT_V(6); PG8_BAR;
    }
    for (;;) {
        const bool has_next = S.next(ui + 1, nxt);
        const char* nA = has_next ? (const char*)g.A + (size_t)nxt.pm * tstep : cA; const char* nB = has_next ? (const char*)g.Bt + (size_t)nxt.pn * tstep : cB;
        for (int t = 0; t < nt; t += 2) {
            const bool last = (t == nt - 2);
            const char* a1 = cA + (size_t)(t + 1) * kstep;
            const char* a2 = last ? nA : cA + (size_t)(t + 2) * kstep; const char* b2 = last ? nB : cB + (size_t)(t + 2) * kstep;
            const char* a3 = a2 + kstep; const char* b3 = b2 + kstep;
            if (last && has_next) S.a_ready(nxt);
            if constexpr (SP2) {
            PG8_LDB(B0, 0, 0); PG8_LDB(B1, 0, 1); PG8_SCHED; PG8_LDA(At, 0, 0); PG8_STAGE(PG8_SA(1, 1), a1 + hstep, voffA);
            PG8_WAIT_V(8); PG8_WAIT_L(0); PG8_BAR; PG8_MMA(0, 0, At, B0); PG8_MMA(0, 1, At, B1); PG8_BAR; PG8_SCHED;
            PG8_LDA(At, 0, 1); PG8_STAGE(PG8_SB(0, 0), b2, voffB); PG8_STAGE(PG8_SB(0, 1), b2 + hstep, voffB); PG8_STAGE(PG8_SA(0, 0), a2, voffA);
            PG8_WAIT_V(8); PG8_WAIT_L(0); PG8_BAR; PG8_MMA(1, 0, At, B0); PG8_MMA(1, 1, At, B1); PG8_BAR; PG8_SCHED;
            PG8_LDB(B0, 1, 0); PG8_LDB(B1, 1, 1); PG8_SCHED; PG8_LDA(At, 1, 0); PG8_STAGE(PG8_SA(0, 1), a2 + hstep, voffA);
            PG8_WAIT_V(8); PG8_WAIT_L(0); PG8_BAR; PG8_MMA(0, 0, At, B0); PG8_MMA(0, 1, At, B1); PG8_BAR; PG8_SCHED;
            PG8_LDA(At, 1, 1); PG8_STAGE(PG8_SB(1, 0), b3, voffB); PG8_STAGE(PG8_SB(1, 1), b3 + hstep, voffB); PG8_STAGE(PG8_SA(1, 0), a3, voffA);
            PG8_WAIT_V(8); PG8_WAIT_L(0); PG8_BAR; PG8_MMA(1, 0, At, B0); PG8_MMA(1, 1, At, B1); PG8_BAR; PG8_SCHED;
            } else {
            PG8_LDB(B0, 0, 0); PG8_SCHED; PG8_LDA(At, 0, 0); PG8_STAGE(PG8_SA(1, 1), a1 + hstep, voffA);
            PG8_WAIT_L(8); PG8_BAR; PG8_WAIT_L(0); PG8_MMA(0, 0, At, B0); PG8_BAR; PG8_SCHED;
            PG8_LDB(B1, 0, 1); PG8_STAGE(PG8_SB(0, 0), b2, voffB);
            PG8_BAR; PG8_WAIT_L(0); PG8_MMA(0, 1, At, B1); PG8_BAR;
            PG8_LDA(At, 0, 1); PG8_STAGE(PG8_SA(0, 0), a2, voffA);
            PG8_BAR; PG8_WAIT_L(0); PG8_MMA(1, 0, At, B0); PG8_BAR; PG8_SCHED;
            PG8_STAGE(PG8_SB(0, 1), b2 + hstep, voffB);
            PG8_WAIT_V(6); PG8_BAR; PG8_MMA(1, 1, At, B1); PG8_BAR;
            PG8_LDB(B0, 1, 0); PG8_SCHED; PG8_LDA(At, 1, 0); PG8_STAGE(PG8_SA(0, 1), a2 + hstep, voffA);
            PG8_WAIT_L(8); PG8_BAR; PG8_WAIT_L(0); PG8_MMA(0, 0, At, B0); PG8_BAR; PG8_SCHED;
            PG8_LDB(B1, 1, 1); PG8_STAGE(PG8_SB(1, 0), b3, voffB);
            PG8_BAR; PG8_WAIT_L(0); PG8_MMA(0, 1, At, B1); PG8_BAR;
            PG8_LDA(At, 1, 1); PG8_STAGE(PG8_SA(1, 0), a3, voffA);
            PG8_BAR; PG8_WAIT_L(0); PG8_MMA(1, 0, At, B0); PG8_BAR; PG8_SCHED;
            PG8_STAGE(PG8_SB(1, 1), b3 + hstep, voffB);
            PG8_WAIT_V(6); PG8_BAR; PG8_MMA(1, 1, At, B1); PG8_BAR;
            }
        }
        if constexpr (ALIGN_EPI) { if (wr == 0) PG8_BAR; }
        if constexpr (!Epi::AFTER_DRAIN) { E(acc, cur, wr, wc, fr, fq); S.done(cur); }
        if (!has_next) break;
#pragma unroll
        for (int a = 0; a < 2; ++a)
#pragma unroll
            for (int b = 0; b < 2; ++b)
#pragma unroll
                for (int m = 0; m < 4; ++m)
#pragma unroll
                    for (int n = 0; n < 2; ++n) acc[a][b][m][n] = (f32x4){zf_, zf_, zf_, zf_};
        asm volatile("" : "+v"(zf_));
        cur = nxt; cA = nA; cB = nB; ++ui;
        if constexpr (ALIGN_EPI) { if (wr == 1) PG8_BAR; }
    }
    PG8_WAIT_V(0);
    if constexpr (!ALIGN_EPI) { if (wr == 0) PG8_BAR; }
    PG8_BAR;
    if constexpr (Epi::AFTER_DRAIN) { E.fused(acc, cur, wr, wc, fr, fq, lds, wid, lane); S.done(cur); }
#undef PG8_SA
#undef PG8_SB
#undef PG8_STAGE
#undef PG8_LDA
#undef PG8_LDB
#undef PG8_MMA
#undef PG8_WAIT_V
#undef PG8_WAIT_L
#undef PG8_BAR
#undef PG8_SCHED
}
}

#define GAS __attribute__((address_space(1)))
#define LAS __attribute__((address_space(3)))
typedef float f32x4 __attribute__((ext_vector_type(4)));
typedef unsigned u32x4 __attribute__((ext_vector_type(4)));
constexpr int NWAVES = 8, NTHREADS = 512;
constexpr int RING_BYTES = 131072, LDSCTL_OFF = RING_BYTES, LDS_BYTES = 147456;
constexpr int NPAD = 11264;
constexpr size_t WS_WIN = WS_END;
constexpr size_t WS_WUQ = WS_WIN + (size_t)NPAD * 1024 * 2;
constexpr size_t WS_WUKV = WS_WUQ + (size_t)768 * 384 * 2;
constexpr size_t WS_W1 = WS_WUKV + (size_t)1024 * 128 * 2;
constexpr size_t WS_WABC = WS_W1 + (size_t)2 * 256 * 2048 * 2;
constexpr size_t WS_WOUT = WS_WABC + (size_t)3 * 1024 * 512 * 2;
constexpr size_t WS_WPLG = WS_WOUT + (size_t)1024 * 1024 * 2;
constexpr size_t WS_WPLE = WS_WPLG + (size_t)1024 * 1024 * 2;
constexpr size_t WS_PBF = WS_WPLE + (size_t)1024 * 256 * 2;
constexpr size_t WS_EB = WS_PBF + (size_t)T * 256 * 2;
constexpr size_t WS_HIDP = WS_EB + (size_t)T * 1024 * 2;
constexpr size_t WS_END2 = WS_HIDP + (size_t)4 * 2 * CROWS * 256 * 4;
constexpr int CW_BAR = 4096;
constexpr int CW_QUEUE = 16384;

DI unsigned pk2(float lo, float hi) { return (unsigned)f2bf(lo) | ((unsigned)f2bf(hi) << 16); }
DI u32x4 pack8(f32x4 a, f32x4 b) { u32x4 w; w.x = pg8::cvt_pk_bf16(a[0], a[1]); w.y = pg8::cvt_pk_bf16(a[2], a[3]); w.z = pg8::cvt_pk_bf16(b[0], b[1]); w.w = pg8::cvt_pk_bf16(b[2], b[3]); return w; }
DI float shx(float v, int lane, int m) { return __int_as_float(__builtin_amdgcn_ds_bpermute((lane ^ m) << 2, __float_as_int(v))); }
DI float sigf(float x) { return __builtin_amdgcn_rcpf(1.f + __expf(-x)); }
DI int epi_lane() { int lane; asm volatile("v_mbcnt_lo_u32_b32 %0, -1, 0\n\tv_mbcnt_hi_u32_b32 %0, -1, %0" : "=v"(lane)); return lane; }
DI float bflo(unsigned w) { return __uint_as_float(w << 16); }
DI float bfhi(unsigned w) { return __uint_as_float(w & 0xffff0000u); }

DI int win_rowmap(int c) {
    if (c < 512) return A_AQ + c;
    if (c < 1280) return A_AKV + c - 512;
    if (c < 1304) return LDA + B_GATE + c - 1280;
    if (c < 1816) return LDA + B_ZA + c - 1304;
    if (c < 2200) return A_BCQ + c - 1816;
    if (c < 2328) return A_BCKV + c - 2200;
    if (c < 2360) return A_BKR + c - 2328;
    if (c < 2872) return LDA + B_ZB + c - 2360;
    if (c < 7480) return A_CQKV + c - 2872;
    if (c < 7992) return LDA + B_ZC + c - 7480;
    return LDA + B_MG + c - 7992;
}
constexpr int WIN_VALID = LDA + B_GATE + 24;

using pg8::Unit;
struct EpiWin { static constexpr bool PERM = true, AFTER_DRAIN = false;
    bf16_t* ua; bf16_t* ub; const float* tab;
    DI void operator()(const f32x4 (&acc)[2][2][4][2], const Unit& u, int wr, int wc, int, int) const {
        const int tl_ = epi_lane(); const int fr = tl_ & 15, fq = tl_ >> 4;
        const int lane = fr + 16 * fq;
#pragma unroll
        for (int bj = 0; bj < 2; ++bj) {
            const int c32 = u.pn * 256 + bj * 128 + wc * 32;
            const int n0 = c32 + 8 * fq;
            int kind = 0;
            if (c32 < 512) kind = ((c32 & 63) == 0) ? 1 : 0;
            else if (c32 < 1280) kind = (((((c32 - 512) >> 7) & 1) == 0) && ((c32 & 63) == 0)) ? 1 : 0;
            else if (c32 >= A_BKR && c32 < A_CQKV) kind = 2;
            else if (c32 >= A_CQKV && c32 < LDA) { const int cc = c32 - A_CQKV; kind = (((cc % 1536) < 1024) && ((cc & 63) == 0)) ? 1 : 0; }
            bf16_t* dst; int ld;
            if (n0 < LDA) { dst = ua + n0; ld = LDA; } else { dst = ub + (n0 - LDA); ld = LDB; }
            const bool wr_ok = n0 < WIN_VALID;
#pragma unroll
            for (int ai = 0; ai < 2; ++ai)
#pragma unroll
                for (int m = 0; m < 4; ++m) { __builtin_amdgcn_sched_barrier(0);
                    const int row = u.pm * 256 + ai * 128 + wr * 64 + m * 16 + fr;
                    f32x4 v0 = acc[ai][bj][m][0], v1 = acc[ai][bj][m][1];
                    if (kind == 1) {
                        f32x4 p0, p1;
#pragma unroll
                        for (int e = 0; e < 4; ++e) { p0[e] = shx(v0[e], lane, 16); p1[e] = shx(v1[e], lane, 16); }
                        if (fq < 2) {
                            const float* tb = tab + (size_t)row * 48;
                            const f32x4 c0 = *(const f32x4*)(tb), c1 = *(const f32x4*)(tb + 4), s0 = *(const f32x4*)(tb + 8), s1 = *(const f32x4*)(tb + 12);
                            const float sg = (fq == 0) ? -1.f : 1.f;
                            v0 = v0 * c0 + sg * (p0 * s0); v1 = v1 * c1 + sg * (p1 * s1);
                        }
                    } else if (kind == 2) {
                        f32x4 p0, p1;
#pragma unroll
                        for (int e = 0; e < 4; ++e) { p0[e] = shx(v0[e], lane, 32); p1[e] = shx(v1[e], lane, 32); }
                        const float* tb = tab + (size_t)row * 48 + 16 + (fq & 1) * 8;
                        const f32x4 c0 = *(const f32x4*)(tb), c1 = *(const f32x4*)(tb + 4), s0 = *(const f32x4*)(tb + 16), s1 = *(const f32x4*)(tb + 20);
                        const float sg = (fq < 2) ? -1.f : 1.f;
                        v0 = v0 * c0 + sg * (p0 * s0); v1 = v1 * c1 + sg * (p1 * s1);
                    }
                    if (wr_ok) *(u32x4*)(dst + (size_t)row * ld) = pack8(v0, v1);
                }
        }
    }
};
struct EpiQm { static constexpr bool PERM = true, AFTER_DRAIN = false;
    bf16_t* qm; const float* tab;
    DI void operator()(const f32x4 (&acc)[2][2][4][2], const Unit& u, int wr, int wc, int, int) const {
        const int tl_ = epi_lane(); const int fr = tl_ & 15, fq = tl_ >> 4;
        const int lane = fr + 16 * fq;
#pragma unroll
        for (int bj = 0; bj < 2; ++bj) {
            const int c32 = u.pn * 256 + bj * 128 + wc * 32;
            const int n0 = c32 + 8 * fq;
            const bool rope = ((c32 >> 5) % 3) == 2;
#pragma unroll
            for (int ai = 0; ai < 2; ++ai)
#pragma unroll
                for (int m = 0; m < 4; ++m) { __builtin_amdgcn_sched_barrier(0);
                    const int row = u.pm * 256 + ai * 128 + wr * 64 + m * 16 + fr;
                    f32x4 v0 = acc[ai][bj][m][0], v1 = acc[ai][bj][m][1];
                    if (rope) {
                        f32x4 p0, p1;
#pragma unroll
                        for (int e = 0; e < 4; ++e) { p0[e] = shx(v0[e], lane, 32); p1[e] = shx(v1[e], lane, 32); }
                        const float* tb = tab + (size_t)row * 48 + 16 + (fq & 1) * 8;
                        const f32x4 c0 = *(const f32x4*)(tb), c1 = *(const f32x4*)(tb + 4), s0 = *(const f32x4*)(tb + 16), s1 = *(const f32x4*)(tb + 20);
                        const float sg = (fq < 2) ? -1.f : 1.f;
                        v0 = v0 * c0 + sg * (p0 * s0); v1 = v1 * c1 + sg * (p1 * s1);
                    }
                    *(u32x4*)(qm + (size_t)row * 768 + n0) = pack8(v0, v1);
                }
        }
    }
};
struct EpiBfPlain { static constexpr bool PERM = true, AFTER_DRAIN = false;
    bf16_t* c; int ldc; int pad;
    DI void operator()(const f32x4 (&acc)[2][2][4][2], const Unit& u, int wr, int wc, int, int) const {
        const int tl_ = epi_lane(); const int fr = tl_ & 15, fq = tl_ >> 4;
#pragma unroll
        for (int bj = 0; bj < 2; ++bj) { const int n0 = u.pn * 256 + bj * 128 + wc * 32 + 8 * fq;
#pragma unroll
            for (int ai = 0; ai < 2; ++ai)
#pragma unroll
                for (int m = 0; m < 4; ++m) { __builtin_amdgcn_sched_barrier(0); const int row = u.pm * 256 + ai * 128 + wr * 64 + m * 16 + fr;
                    *(u32x4*)(c + (size_t)row * ldc + n0) = pack8(acc[ai][bj][m][0], acc[ai][bj][m][1]); } }
    }
};
template <int ACT  > struct EpiF32 { static constexpr bool PERM = true, AFTER_DRAIN = false;
    float* c; int ldc; int pnmask;
    DI void operator()(const f32x4 (&acc)[2][2][4][2], const Unit& u, int wr, int wc, int, int) const {
        const int tl_ = epi_lane(); const int fr = tl_ & 15, fq = tl_ >> 4;
#pragma unroll
        for (int bj = 0; bj < 2; ++bj) { const int n0 = (u.pn & pnmask) * 256 + bj * 128 + wc * 32 + 8 * fq;
#pragma unroll
            for (int ai = 0; ai < 2; ++ai)
#pragma unroll
                for (int m = 0; m < 4; ++m) { __builtin_amdgcn_sched_barrier(0); const int row = u.pm * 256 + ai * 128 + wr * 64 + m * 16 + fr;
                    f32x4 v0 = acc[ai][bj][m][0], v1 = acc[ai][bj][m][1];
                    if (ACT == 1) {
#pragma unroll
                        for (int e = 0; e < 4; ++e) { v0[e] = v0[e] * sigf(v0[e]); v1[e] = v1[e] * sigf(v1[e]); } }
                    float* p = c + (size_t)row * ldc + n0; *(f32x4*)p = v0; *(f32x4*)(p + 4) = v1; } }
    }
};
struct EpiYabc { static constexpr bool PERM = true, AFTER_DRAIN = false;
    bf16_t* ymixb; const bf16_t* ub;
    DI void operator()(const f32x4 (&acc)[2][2][4][2], const Unit& u, int wr, int wc, int, int) const {
        const int tl_ = epi_lane(); const int fr = tl_ & 15, fq = tl_ >> 4;
        const int x = u.pm >> 6, pm = u.pm & 63, pn = u.pn & 3;
#pragma unroll
        for (int bj = 0; bj < 2; ++bj) { const int n0 = pn * 256 + bj * 128 + wc * 32 + 8 * fq;
#pragma unroll
            for (int ai = 0; ai < 2; ++ai)
#pragma unroll
                for (int m = 0; m < 4; ++m) { __builtin_amdgcn_sched_barrier(0); const int row = pm * 256 + ai * 128 + wr * 64 + m * 16 + fr;
                    const u32x4 gw = *(const u32x4*)(ub + (size_t)row * LDB + B_MG + x * 1024 + n0);
                    f32x4 g0, g1; g0[0] = sigf(bflo(gw.x)); g0[1] = sigf(bfhi(gw.x)); g0[2] = sigf(bflo(gw.y)); g0[3] = sigf(bfhi(gw.y));
                    g1[0] = sigf(bflo(gw.z)); g1[1] = sigf(bfhi(gw.z)); g1[2] = sigf(bflo(gw.w)); g1[3] = sigf(bfhi(gw.w));
                    f32x4 v0 = acc[ai][bj][m][0] * g0, v1 = acc[ai][bj][m][1] * g1;
                    bf16_t* p = ymixb + (size_t)row * D + n0;
                    if (x > 0) { const u32x4 q = *(const u32x4*)p;
                        v0[0] += bflo(q.x); v0[1] += bfhi(q.x); v0[2] += bflo(q.y); v0[3] += bfhi(q.y); v1[0] += bflo(q.z); v1[1] += bfhi(q.z); v1[2] += bflo(q.w); v1[3] += bfhi(q.w); }
                    *(u32x4*)p = pack8(v0, v1); } }
    }
};
struct EpiPlgF { static constexpr bool PERM = true, AFTER_DRAIN = false;
    float* x; const bf16_t* e;
    DI void operator()(const f32x4 (&acc)[2][2][4][2], const Unit& u, int wr, int wc, int, int) const {
        const int tl_ = epi_lane(); const int fr = tl_ & 15, fq = tl_ >> 4;
#pragma unroll
        for (int bj = 0; bj < 2; ++bj) { const int n0 = u.pn * 256 + bj * 128 + wc * 32 + 8 * fq;
#pragma unroll
            for (int ai = 0; ai < 2; ++ai)
#pragma unroll
                for (int m = 0; m < 4; ++m) { __builtin_amdgcn_sched_barrier(0); const int row = u.pm * 256 + ai * 128 + wr * 64 + m * 16 + fr;
                    const size_t o = (size_t)row * D + n0;
                    f32x4 v0 = acc[ai][bj][m][0], v1 = acc[ai][bj][m][1];
                    const u32x4 ew = *(const u32x4*)(e + o); const f32x4 e0 = {bflo(ew.x), bfhi(ew.x), bflo(ew.y), bfhi(ew.y)}, e1 = {bflo(ew.z), bfhi(ew.z), bflo(ew.w), bfhi(ew.w)};
                    f32x4 x0 = *(const f32x4*)(x + o), x1 = *(const f32x4*)(x + o + 4);
#pragma unroll
                    for (int k = 0; k < 4; ++k) { x0[k] += sigf(v0[k]) * e0[k]; x1[k] += sigf(v1[k]) * e1[k]; }
                    *(f32x4*)(x + o) = x0; *(f32x4*)(x + o + 4) = x1; } }
    }
};
struct YabcOrder {
    int G, vcu;
    DI bool next(int i, Unit& u) const { const int tile = (i / 3) * G + vcu, x = i % 3; if (tile >= 256) return false; u.pm = x * 64 + (tile >> 2); u.pn = x * 4 + (tile & 3); return true; }
    DI void a_ready(const Unit&) const {}
    DI void done(const Unit&) const {}
};
struct HidOrder {
    int G, c;
    DI bool next(int i, Unit& u) const { const int id = c - (G - 64); if (i > 0 || id < 0) return false; u.pm = (id >> 3) * 8 + (id & 7); u.pn = id >> 3; return true; }
    DI void a_ready(const Unit&) const {}
    DI void done(const Unit&) const {}
};
DI void tr_item(const float* W, int K, int N, bf16_t* WT, LAS float* scr, int item, int lane, bool perm) {
    const int nblk = (N + 31) / 32, kb = item / nblk, nb = item % nblk, k0 = 64 * kb, n0 = 32 * nb;
    const int nn = n0 + (lane & 31);
#pragma unroll 8
    for (int i = 0; i < 32; ++i) { const int kk = 2 * i + (lane >> 5); scr[kk * 33 + (lane & 31)] = (nn < N) ? W[(size_t)(k0 + kk) * N + nn] : 0.f; }
    asm volatile("s_waitcnt lgkmcnt(0)" ::: "memory");
    const int c = lane & 7;
#pragma unroll
    for (int j = 0; j < 4; ++j) { const int n = (lane >> 3) + 8 * j; const LAS float* s = scr + (8 * c) * 33 + n;
        u32x4 o; o.x = pk2(s[0 * 33], s[1 * 33]); o.y = pk2(s[2 * 33], s[3 * 33]); o.z = pk2(s[4 * 33], s[5 * 33]); o.w = pk2(s[6 * 33], s[7 * 33]);
        if (n0 + n < N) { const int rr = perm ? win_rowmap(n0 + n) : (n0 + n); *(u32x4*)(WT + (size_t)rr * K + k0 + 8 * c) = o; } }
    asm volatile("s_waitcnt lgkmcnt(0)" ::: "memory");
}
struct RmIdent { int off; DI int operator()(int n) const { return off + n; } };
struct RmWin { DI int operator()(int n) const { return win_rowmap(n); } };

DI float wsum(float v, int lane) {
#pragma unroll
    for (int o = 1; o < 64; o <<= 1) v += shx(v, lane, o);
    return v;
}
DI void rms_row_f32(const float* xrow, const float* g, bf16_t* orow, int lane) {
    const f32x4* xr = (const f32x4*)xrow + lane; const f32x4* gr = (const f32x4*)g + lane;
    f32x4 v[4]; float s = 0.f;
#pragma unroll
    for (int j = 0; j < 4; ++j) { v[j] = xr[64 * j]; s += (v[j][0] * v[j][0] + v[j][1] * v[j][1]) + (v[j][2] * v[j][2] + v[j][3] * v[j][3]); }
    const float rs = rsqrtf(wsum(s, lane) * (1.f / 1024.f) + 1e-6f);
    unsigned long long* o8 = (unsigned long long*)orow + lane;
#pragma unroll
    for (int j = 0; j < 4; ++j) { const f32x4 gg = gr[64 * j];
        o8[64 * j] = (unsigned long long)pk2(v[j][0] * rs * gg[0], v[j][1] * rs * gg[1]) | ((unsigned long long)pk2(v[j][2] * rs * gg[2], v[j][3] * rs * gg[3]) << 32); }
}

namespace fa {
typedef short bf16x8 __attribute__((ext_vector_type(8)));
typedef float f32x16 __attribute__((ext_vector_type(16)));
typedef short v4i16 __attribute__((ext_vector_type(4)));
constexpr int KBUF = 0, KBUF_SZ = 12288, VBUF = 24576, VBUF_SZ = 8192, OVBUF = 40960, IMP_OFF = 49152, IMP_LD = 65, SELM_OFF = IMP_OFF + 4 * 64 * IMP_LD * 4, WQ_OFF = SELM_OFF + 512;
static_assert(WQ_OFF + 64 <= 131072, "attention LDS map");
constexpr float LOG2E = 1.4426950408889634f;

DI int crow(int r, int hi) { return (r & 3) + 8 * (r >> 2) + 4 * hi; }
DI float xhalf_max(float v) { auto rr = __builtin_amdgcn_permlane32_swap(__float_as_uint(v), __float_as_uint(v), false, false); return fmaxf(__uint_as_float(rr[0]), __uint_as_float(rr[1])); }
DI float xhalf_sum(float v) { auto rr = __builtin_amdgcn_permlane32_swap(__float_as_uint(v), __float_as_uint(v), false, false); return __uint_as_float(rr[0]) + __uint_as_float(rr[1]); }
DI unsigned cvtpk(float lo, float hi) { return pg8::cvt_pk_bf16(lo, hi); }

struct St { f32x16 o[2]; float m, l; };
DI void st_init(St& s) {
#pragma unroll
    for (int i = 0; i < 16; ++i) { s.o[0][i] = 0.f; s.o[1][i] = 0.f; }
    s.m = -1e30f; s.l = 0.f;
}

template <int NQ> DI void qk_tile(f32x16& p0, f32x16& p1, LAS const unsigned char* kt, const bf16x8 (&qf)[NQ], int r32, int hi) {
    LAS const unsigned char* kb = kt + hi * 1024 + r32 * 16;
#pragma unroll
    for (int i = 0; i < 16; ++i) { p0[i] = 0.f; p1[i] = 0.f; }
#pragma unroll
    for (int d0 = 0; d0 < NQ; ++d0) {
        const bf16x8 b0 = *(LAS const bf16x8*)(kb + d0 * 2048);
        const bf16x8 b1 = *(LAS const bf16x8*)(kb + d0 * 2048 + 512);
        p0 = __builtin_amdgcn_mfma_f32_32x32x16_bf16(b0, qf[d0], p0, 0, 0, 0);
        p1 = __builtin_amdgcn_mfma_f32_32x32x16_bf16(b1, qf[d0], p1, 0, 0, 0);
    }
}
DI float softmax_tile(St& s, f32x16& p0, f32x16& p1, float c, bf16x8 (&pa)[4]) {
    float mx = fmaxf(p0[0], p1[0]);
#pragma unroll
    for (int i = 1; i < 16; ++i) mx = fmaxf(mx, fmaxf(p0[i], p1[i]));
    mx = xhalf_max(mx);
    const float mn = fmaxf(s.m, mx);
    const float alpha = __builtin_amdgcn_exp2f((s.m - mn) * c);
    s.m = mn;
    const float nmc = -mn * c;
    float sum = 0.f;
#pragma unroll
    for (int i = 0; i < 16; ++i) { p0[i] = __builtin_amdgcn_exp2f(fmaf(p0[i], c, nmc)); p1[i] = __builtin_amdgcn_exp2f(fmaf(p1[i], c, nmc)); sum += p0[i] + p1[i]; }
    s.l = s.l * alpha + sum;
#pragma unroll
    for (int i = 0; i < 16; ++i) { s.o[0][i] *= alpha; s.o[1][i] *= alpha; }
    u32x4 w;
    w.x = cvtpk(p0[0], p0[1]); w.y = cvtpk(p0[2], p0[3]); w.z = cvtpk(p0[4], p0[5]); w.w = cvtpk(p0[6], p0[7]); pa[0] = __builtin_bit_cast(bf16x8, w);
    w.x = cvtpk(p0[8], p0[9]); w.y = cvtpk(p0[10], p0[11]); w.z = cvtpk(p0[12], p0[13]); w.w = cvtpk(p0[14], p0[15]); pa[1] = __builtin_bit_cast(bf16x8, w);
    w.x = cvtpk(p1[0], p1[1]); w.y = cvtpk(p1[2], p1[3]); w.z = cvtpk(p1[4], p1[5]); w.w = cvtpk(p1[6], p1[7]); pa[2] = __builtin_bit_cast(bf16x8, w);
    w.x = cvtpk(p1[8], p1[9]); w.y = cvtpk(p1[10], p1[11]); w.z = cvtpk(p1[12], p1[13]); w.w = cvtpk(p1[14], p1[15]); pa[3] = __builtin_bit_cast(bf16x8, w);
    return alpha;
}
DI void pv_tile(f32x16 (&o)[2], LAS const unsigned char* vt, const bf16x8 (&pa)[4], int lane) {
    const int hi = lane >> 5;
    LAS const unsigned char* vb = vt + ((lane >> 4) & 1) * 32 + (lane & 3) * 8 + (4 * hi + ((lane & 15) >> 2)) * 64;
#pragma unroll
    for (int d0 = 0; d0 < 2; ++d0)
#pragma unroll
        for (int ks = 0; ks < 4; ++ks) {
            const v4i16 lo = __builtin_amdgcn_ds_read_tr16_b64_v4i16((LAS v4i16*)(vb + d0 * 4096 + ks * 1024));
            const v4i16 hv = __builtin_amdgcn_ds_read_tr16_b64_v4i16((LAS v4i16*)(vb + d0 * 4096 + ks * 1024 + 512));
            const bf16x8 vf = (bf16x8){lo[0], lo[1], lo[2], lo[3], hv[0], hv[1], hv[2], hv[3]};
            o[d0] = __builtin_amdgcn_mfma_f32_32x32x16_bf16(vf, pa[ks], o[d0], 0, 0, 0);
        }
}
DI int k_lds_off(int key, int chunk) { return chunk * 1024 + key * 16; }
DI int v_lds_off(int key, int c8) { return ((c8 >> 2) * 4 + (key >> 4)) * 1024 + (key & 15) * 64 + (c8 & 3) * 16; }

template <int NQ, class Src, class Mask>
DI void run_stage(LAS unsigned char* lds, const Src& src, const Mask& mask, int jt0, int jt1, int jw0, int jw1, const bf16x8 (&qf)[NQ], St& st, float c, int tid, int qpos) {
    const int lane = tid & 63, r32 = lane & 31, hi = lane >> 5;
    const int key = tid >> 3, ch = tid & 7;
    u32x4 rk, rk2, rv;
    rk2 = (u32x4){0u, 0u, 0u, 0u};
    auto gload = [&](int j) {
        const int kpos = 64 * j + key;
        rk = *(const u32x4*)(src.krow(kpos) + ch * 8);
        rv = *(const u32x4*)(src.vrow(kpos) + ch * 8);
        if (NQ == 6 && ch < 4) rk2 = *(const u32x4*)(src.krow2(kpos) + ch * 8);
    };
    auto lstore = [&](int buf) {
        *(LAS u32x4*)(lds + KBUF + buf * KBUF_SZ + k_lds_off(key, ch)) = rk;
        *(LAS u32x4*)(lds + VBUF + buf * VBUF_SZ + v_lds_off(key, ch)) = rv;
        if (NQ == 6 && ch < 4) *(LAS u32x4*)(lds + KBUF + buf * KBUF_SZ + k_lds_off(key, 8 + ch)) = rk2;
    };
    if (jt0 >= jt1) return;
    gload(jt0); lstore(0);
    __syncthreads();
    for (int j = jt0; j < jt1; ++j) {
        const int buf = (j - jt0) & 1;
        if (j + 1 < jt1) gload(j + 1);
        if (j >= jw0 && j < jw1 && !mask.skip(j)) {
            f32x16 p0, p1; bf16x8 pa[4];
            qk_tile<NQ>(p0, p1, lds + KBUF + buf * KBUF_SZ, qf, r32, hi);
            mask.apply(p0, p1, j, qpos, hi);
            softmax_tile(st, p0, p1, c, pa);
            pv_tile(st.o, lds + VBUF + buf * VBUF_SZ, pa, lane);
        }
        if (j + 1 < jt1) lstore(buf ^ 1);
        __syncthreads();
    }
}
struct MaskBand { int maxd;
    DI bool skip(int) const { return false; }
    DI void apply(f32x16& p0, f32x16& p1, int j, int qpos, int hi) const {
        const int kb = 64 * j + 4 * hi, q0 = qpos & ~31;
        if (64 * j + 63 <= q0 && q0 + 31 - (64 * j) <= maxd) return;
#pragma unroll
        for (int r = 0; r < 16; ++r) { const int d0 = qpos - (kb + (r & 3) + 8 * (r >> 2)), d1 = d0 - 32;
            if (d0 < 0 || d0 > maxd) p0[r] = -INFINITY; if (d1 < 0 || d1 > maxd) p1[r] = -INFINITY; }
    } };
struct SrcMla { const bf16_t* kvu; const bf16_t* ua; int b, h;
    DI const bf16_t* krow(int kpos) const { return kvu + (size_t)(b * S + kpos) * 1024 + h * 128; }
    DI const bf16_t* vrow(int kpos) const { return kvu + (size_t)(b * S + kpos) * 1024 + h * 128 + 64; }
    DI const bf16_t* krow2(int kpos) const { return ua + (size_t)(b * S + kpos) * LDA + A_BKR; } };

DI void store_o(const f32x16 (&o)[2], float inv, bf16_t* orow, int hi) {
#pragma unroll
    for (int d0 = 0; d0 < 2; ++d0)
#pragma unroll
        for (int i = 0; i < 4; ++i) {
            const unsigned lo = cvtpk(o[d0][4 * i] * inv, o[d0][4 * i + 1] * inv), hv = cvtpk(o[d0][4 * i + 2] * inv, o[d0][4 * i + 3] * inv);
            *(unsigned long long*)(orow + 32 * d0 + 8 * i + 4 * hi) = (unsigned long long)lo | ((unsigned long long)hv << 32);
        }
}
DI void unit_mla(LAS unsigned char* lds, int tid, int b, int h, int qblk, const bf16_t* qm, const bf16_t* kvu, const bf16_t* ua, const bf16_t* ub, bf16_t* ob) {
    const int lane = tid & 63, r32 = lane & 31, hi = lane >> 5, wave = __builtin_amdgcn_readfirstlane(tid >> 6);
    const int q0 = 256 * qblk + 32 * wave, qpos = q0 + r32;
    const bf16_t* qrow = qm + (size_t)(b * S + qpos) * 768 + h * 96;
    bf16x8 qf[6];
#pragma unroll
    for (int d0 = 0; d0 < 6; ++d0) qf[d0] = *(const bf16x8*)(qrow + d0 * 16 + hi * 8);
    St st; st_init(st);
    SrcMla src{kvu, ua, b, h};
    MaskBand mk{1 << 30};
    run_stage<6>(lds, src, mk, 0, 4 * qblk + 4, 0, (q0 + 31) / 64 + 1, qf, st, 0.10206207261596577f * LOG2E, tid, qpos);
    const float lt = xhalf_sum(st.l), inv = 1.f / lt;
    const bf16_t* zrow = ub + (size_t)(b * S + qpos) * LDB + B_ZB + h * 64; bf16_t* orow = ob + (size_t)(b * S + qpos) * 512 + h * 64;
#pragma unroll
    for (int d0 = 0; d0 < 2; ++d0)
#pragma unroll
        for (int i = 0; i < 4; ++i) {
            const int d = 32 * d0 + 8 * i + 4 * hi;
            const unsigned long long zw = *(const unsigned long long*)(zrow + d);
            const float z0 = bflo((unsigned)zw) , z1 = bfhi((unsigned)zw), z2 = bflo((unsigned)(zw >> 32)), z3 = bfhi((unsigned)(zw >> 32));
            const unsigned lo = cvtpk(st.o[d0][4 * i] * inv * z0 * sigf(z0), st.o[d0][4 * i + 1] * inv * z1 * sigf(z1)), hv = cvtpk(st.o[d0][4 * i + 2] * inv * z2 * sigf(z2), st.o[d0][4 * i + 3] * inv * z3 * sigf(z3));
            *(unsigned long long*)(orow + d) = (unsigned long long)lo | ((unsigned long long)hv << 32);
        }
}
struct SrcDil { const bf16_t* base; int dil;
    DI const bf16_t* krow(int kpos) const { return base + (size_t)kpos * dil * LDA + 512; }
    DI const bf16_t* vrow(int kpos) const { return base + (size_t)kpos * dil * LDA + 1024; }
    DI const bf16_t* krow2(int) const { return base; } };
DI void unit_dil(LAS unsigned char* lds, int tid, int gi, int b, int h, int r, int qblk, const bf16_t* ua, bf16_t* od, float* lse) {
    const int lane = tid & 63, r32 = lane & 31, hi = lane >> 5, wave = __builtin_amdgcn_readfirstlane(tid >> 6);
    const int dil = (gi == 0) ? 1 : (gi == 1) ? 4 : 16;
    const int q0 = 256 * qblk + 32 * wave, qpos = q0 + r32;
    const bf16_t* base = ua + (size_t)(b * S + r) * LDA + A_CQKV + gi * 1536 + h * 64;
    const size_t tok = (size_t)b * S + (size_t)qpos * dil + r;
    const bf16_t* qrow = base + (size_t)qpos * dil * LDA;
    bf16x8 qf[4];
#pragma unroll
    for (int d0 = 0; d0 < 4; ++d0) qf[d0] = *(const bf16x8*)(qrow + d0 * 16 + hi * 8);
    St st; st_init(st);
    SrcDil src{base, dil};
    MaskBand mk{128};
    const int jt0 = (4 * qblk - 2) > 0 ? (4 * qblk - 2) : 0, jw0 = ((q0 - 128) >> 6) > 0 ? ((q0 - 128) >> 6) : 0;
    run_stage<4>(lds, src, mk, jt0, 4 * qblk + 4, jw0, (q0 + 31) / 64 + 1, qf, st, 0.125f * LOG2E, tid, qpos);
    const float lt = xhalf_sum(st.l);
    store_o(st.o, 1.f / lt, od + tok * 512 + h * 64, hi);
    if (hi == 0) lse[tok * 8 + h] = st.m * 0.125f + __logf(lt);
}
struct MaskSel { unsigned lo, hi32;
    DI bool bit(int j) const { return ((j < 32 ? lo >> j : hi32 >> (j - 32)) & 1u) != 0u; }
    DI bool skip(int j) const { return !__any(bit(j)); }
    DI void apply(f32x16& p0, f32x16& p1, int j, int qpos, int hi) const {
        const bool on = bit(j);
        const int kb = 64 * j + 4 * hi;
#pragma unroll
        for (int r = 0; r < 16; ++r) { const int k0 = kb + (r & 3) + 8 * (r >> 2);
            if (!on || k0 > qpos) p0[r] = -INFINITY; if (!on || k0 + 32 > qpos) p1[r] = -INFINITY; }
    } };
struct SrcAkv { const bf16_t* base;
    DI const bf16_t* krow(int kpos) const { return base + (size_t)kpos * LDA; }
    DI const bf16_t* vrow(int kpos) const { return base + (size_t)kpos * LDA + 128; }
    DI const bf16_t* krow2(int) const { return base; } };

DI void unit_nsa(LAS unsigned char* lds, int tid, int b, int hk, int qb, const bf16_t* ua, const bf16_t* ub, const bf16_t* kc, bf16_t* oa) {
    const int lane = tid & 63, r32 = lane & 31, hi = lane >> 5, wave = __builtin_amdgcn_readfirstlane(tid >> 6);
    const int g = wave >> 1, half = wave & 1, hq = hk * 4 + g;
    const int q0 = 64 * qb + 32 * half, qpos = q0 + r32;
    const size_t tok = (size_t)b * S + qpos;
    bf16x8 qf[4];
    { const bf16_t* qrow = ua + tok * LDA + A_AQ + hq * 64;
#pragma unroll
      for (int d0 = 0; d0 < 4; ++d0) qf[d0] = *(const bf16x8*)(qrow + d0 * 16 + hi * 8); }
    const float c = 0.125f * LOG2E;
    f32x16 oacc[2];
    {
        St st; st_init(st);
        f32x16 o2[2];
#pragma unroll
        for (int i = 0; i < 16; ++i) { o2[0][i] = 0.f; o2[1][i] = 0.f; }
        const int ntile = ((4 * qb + 2) >> 6) + 1;
        const int key = tid >> 3, ch = tid & 7;
        for (int t = 0; t < ntile; ++t) {
            const int cidx = 64 * t + key, cc = cidx < NC ? cidx : NC - 1;
            const bf16_t* kr = kc + ((size_t)(b * NC + cc) * 2 + hk) * 64;
            const u32x4 rk = *(const u32x4*)(kr + ch * 8), rv = *(const u32x4*)(kr + (size_t)CROWS * 64 + ch * 8);
            *(LAS u32x4*)(lds + KBUF + k_lds_off(key, ch)) = rk;
            *(LAS u32x4*)(lds + VBUF + v_lds_off(key, ch)) = rv;
            {
              const int jb = cidx >> 2, e3 = cidx & 3; unsigned short w[8];
#pragma unroll
              for (int e = 0; e < 8; ++e) { const int j = 8 * ch + e; w[e] = (cidx >= NC) ? 0 : (j == jb) ? (e3 < 3 ? 0x3F80 : 0x3F00) : (j == jb + 1 && e3 == 3) ? 0x3F00 : 0; }
              u32x4 ov; ov.x = w[0] | ((unsigned)w[1] << 16); ov.y = w[2] | ((unsigned)w[3] << 16); ov.z = w[4] | ((unsigned)w[5] << 16); ov.w = w[6] | ((unsigned)w[7] << 16);
              *(LAS u32x4*)(lds + OVBUF + v_lds_off(key, ch)) = ov; }
            __syncthreads();
            {
                f32x16 p0, p1; bf16x8 pa[4];
                qk_tile<4>(p0, p1, lds + KBUF, qf, r32, hi);
                const int kb = 64 * t + 4 * hi;
#pragma unroll
                for (int r = 0; r < 16; ++r) { const int c0 = kb + (r & 3) + 8 * (r >> 2);
                    if (c0 >= NC || 16 * c0 + 31 > qpos) p0[r] = -INFINITY; if (c0 + 32 >= NC || 16 * (c0 + 32) + 31 > qpos) p1[r] = -INFINITY; }
                const float alpha = softmax_tile(st, p0, p1, c, pa);
#pragma unroll
                for (int i = 0; i < 16; ++i) { o2[0][i] *= alpha; o2[1][i] *= alpha; }
                pv_tile(st.o, lds + VBUF, pa, lane);
                pv_tile(o2, lds + OVBUF, pa, lane);
            }
            __syncthreads();
        }
        const float lt = xhalf_sum(st.l), inv = lt > 0.f ? 1.f / lt : 0.f;
        const float g0 = sigf(bf2f(ub[tok * LDB + B_GATE + hq * 3 + 0])) * inv;
#pragma unroll
        for (int i = 0; i < 16; ++i) { oacc[0][i] = st.o[0][i] * g0; oacc[1][i] = st.o[1][i] * g0; }
        LAS float* imp = (LAS float*)(lds + IMP_OFF) + (g * 64 + 32 * half + r32) * IMP_LD;
#pragma unroll
        for (int d0 = 0; d0 < 2; ++d0)
#pragma unroll
            for (int r = 0; r < 16; ++r) imp[32 * d0 + crow(r, hi)] = o2[d0][r] * inv;
    }
    __syncthreads();
    {
        LAS const float* impb = (LAS const float*)(lds + IMP_OFF);
        for (int i = 0; i < 8; ++i) {
            const int tk = wave * 8 + i;
            float v = impb[(0 * 64 + tk) * IMP_LD + lane]; v += impb[(1 * 64 + tk) * IMP_LD + lane]; v += impb[(2 * 64 + tk) * IMP_LD + lane]; v += impb[(3 * 64 + tk) * IMP_LD + lane];
            const bool valid = lane <= qb, forced = (lane == 0) || (lane == qb) || (lane == qb - 1);
            const float score = forced ? 1e30f : (valid ? v : -1e30f);
            int rank = 0;
#pragma unroll
            for (int jj = 0; jj < 64; ++jj) { const float o = __uint_as_float(__builtin_amdgcn_readlane(__float_as_uint(score), jj)); rank += (o > score || (o == score && jj < lane)) ? 1 : 0; }
            const unsigned long long m = __ballot((rank < 16) && valid);
            if (lane == 0) *(LAS unsigned long long*)(lds + SELM_OFF + 8 * tk) = m;
        }
    }
    __syncthreads();
    {
        St st; st_init(st);
        const unsigned long long m = *(LAS const unsigned long long*)(lds + SELM_OFF + 8 * (32 * half + r32));
        MaskSel mk{(unsigned)m, (unsigned)(m >> 32)};
        SrcAkv src{ua + (size_t)b * S * LDA + A_AKV + 2 * 128 + hk * 64};
        run_stage<4>(lds, src, mk, 0, qb + 1, 0, qb + 1, qf, st, c, tid, qpos);
        const float lt = xhalf_sum(st.l);
        const float g1 = sigf(bf2f(ub[tok * LDB + B_GATE + hq * 3 + 1])) / lt;
#pragma unroll
        for (int i = 0; i < 16; ++i) { oacc[0][i] += st.o[0][i] * g1; oacc[1][i] += st.o[1][i] * g1; }
    }
    {
        St st; st_init(st);
        MaskBand mk{511};
        SrcAkv src{ua + (size_t)b * S * LDA + A_AKV + 4 * 128 + hk * 64};
        const int jt0 = qb > 8 ? qb - 8 : 0;
        int jw0 = (q0 - 511) >> 6; jw0 = jw0 > jt0 ? jw0 : jt0;
        run_stage<4>(lds, src, mk, jt0, qb + 1, jw0, qb + 1, qf, st, c, tid, qpos);
        const float lt = xhalf_sum(st.l);
        const float g2 = sigf(bf2f(ub[tok * LDB + B_GATE + hq * 3 + 2])) / lt;
#pragma unroll
        for (int i = 0; i < 16; ++i) { oacc[0][i] += st.o[0][i] * g2; oacc[1][i] += st.o[1][i] * g2; }
    }
    {
        const bf16_t* zrow = ub + tok * LDB + B_ZA + hq * 64; bf16_t* orow = oa + tok * 512 + hq * 64;
#pragma unroll
        for (int d0 = 0; d0 < 2; ++d0)
#pragma unroll
            for (int i = 0; i < 4; ++i) {
                const int d = 32 * d0 + 8 * i + 4 * hi;
                const unsigned long long zw = *(const unsigned long long*)(zrow + d);
                const float z0 = bflo((unsigned)zw), z1 = bfhi((unsigned)zw), z2 = bflo((unsigned)(zw >> 32)), z3 = bfhi((unsigned)(zw >> 32));
                const unsigned lo = cvtpk(oacc[d0][4 * i] * z0 * sigf(z0), oacc[d0][4 * i + 1] * z1 * sigf(z1)), hv = cvtpk(oacc[d0][4 * i + 2] * z2 * sigf(z2), oacc[d0][4 * i + 3] * z3 * sigf(z3));
                *(unsigned long long*)(orow + d) = (unsigned long long)lo | ((unsigned long long)hv << 32);
            }
    }
}
}
#define XB_TMO      128
#define XB_XCNT(j)  (256  + 64 * (j))
#define XB_XSUB(j)  (1280 + 64 * (j))
#define XB_XGEN(j)  (2304 + 64 * (j))
#define XB_TOP      3328
#define XB_TOPGEN   3392
#define XCD_BAR_WORDS 3456
#define XB_SPIN_CAP (1u << 18)

__device__ __forceinline__ unsigned xb_ld(unsigned* p)              { return __hip_atomic_load(p, __ATOMIC_RELAXED, __HIP_MEMORY_SCOPE_AGENT); }
__device__ __forceinline__ unsigned xb_add(unsigned* p, unsigned v) { return __hip_atomic_fetch_add(p, v, __ATOMIC_RELAXED, __HIP_MEMORY_SCOPE_AGENT); }
__device__ __forceinline__ unsigned xb_xcc_id() { return (unsigned)__builtin_amdgcn_s_getreg((3 << 11) | 20) & 0xFu; }
#define XB_SPIN(cond, bar) do { unsigned _sp = 0; while (cond) { __builtin_amdgcn_s_sleep(1); \
    if ((++_sp & 255u) == 0u) { if (xb_ld(&(bar)[XB_TMO])) break; if (_sp > XB_SPIN_CAP) { atomicAdd(&(bar)[XB_TMO], 1u); break; } } } } while (0)

struct XcdBarrier {
    unsigned* bar; unsigned x;
    volatile LAS unsigned* st;
};

__device__ __forceinline__ XcdBarrier xcd_barrier_post(unsigned* bar, volatile LAS unsigned* st) {
    XcdBarrier b; b.bar = bar; b.x = xb_xcc_id(); b.st = st;
    if (threadIdx.x == 0) (void)xb_add(&bar[XB_XCNT(b.x)], 1u);
    return b;
}
__device__ __forceinline__ void xcd_barrier_complete(unsigned* bar, unsigned x, unsigned& nloc, unsigned& nx) {
    const unsigned G = gridDim.x * gridDim.y * gridDim.z;
    unsigned sum, cnt, mine, sp = 0u;
    for (;;) {
        sum = 0u; cnt = 0u; mine = 0u;
#pragma unroll
        for (unsigned j = 0; j < 16; ++j) { const unsigned c = xb_ld(&bar[XB_XCNT(j)]); sum += c; cnt += (c > 0u) ? 1u : 0u; mine = (j == x) ? c : mine; }
        if (sum == G) break;
        __builtin_amdgcn_s_sleep(1);
        if ((++sp & 255u) == 0u) { if (xb_ld(&bar[XB_TMO])) break; if (sp > XB_SPIN_CAP) { atomicAdd(&bar[XB_TMO], 1u); break; } }
    }
    nloc = mine > 0u ? mine : 1u; nx = cnt > 0u ? cnt : 1u;
}

__device__ __forceinline__ void xcd_barrier(const XcdBarrier& b) {
    asm volatile("s_waitcnt vmcnt(0)" ::: "memory");
    __syncthreads();
    if (threadIdx.x == 0) {
        unsigned* bar = b.bar;
        __builtin_amdgcn_s_waitcnt(0);
        unsigned nloc = b.st[0], nx = b.st[1];
        if (nloc == 0u) { xcd_barrier_complete(bar, b.x, nloc, nx); b.st[0] = nloc; b.st[1] = nx; }
        const unsigned old = xb_add(&bar[XB_XSUB(b.x)], 1u);
        const unsigned gen = old / nloc;
        if (old + 1u == (gen + 1u) * nloc) {
            __builtin_amdgcn_fence(__ATOMIC_RELEASE, "agent");
            asm volatile("s_waitcnt vmcnt(0)" ::: "memory");
            const unsigned og = xb_add(&bar[XB_TOP], 1u);
            const unsigned tg = og / nx;
            if (og + 1u == (tg + 1u) * nx) xb_add(&bar[XB_TOPGEN], 1u);
            else XB_SPIN(xb_ld(&bar[XB_TOPGEN]) == tg, bar);
            __builtin_amdgcn_fence(__ATOMIC_ACQUIRE, "agent");
            xb_add(&bar[XB_XGEN(b.x)], 1u);
            asm volatile("s_waitcnt vmcnt(0)" ::: "memory");
        } else {
            XB_SPIN(xb_ld(&bar[XB_XGEN(b.x)]) == gen, bar);
            __builtin_amdgcn_fence(__ATOMIC_ACQUIRE, "agent");
            asm volatile("s_waitcnt vmcnt(0)" ::: "memory");
        }
    }
    __syncthreads();
}

enum { PH_CONV = 0, PH_WIN, PH_PREP, PH_G2, PH_KC, PH_ATT1, PH_COMB, PH_YABC, PH_WOUT, PH_POST, PH_PLE, PH_COUNT };
struct MArgs { const void* in[19]; float* out; unsigned char* ws; int ph_lo, ph_hi, l_lo, l_hi; };
static_assert(sizeof(MArgs) == 19 * 8 + 8 + 8 + 16, "no padding");

typedef __attribute__((address_space(4))) const char* kptr_t;
DI kptr_t kbase() { kptr_t p = (kptr_t)__builtin_amdgcn_kernarg_segment_ptr(); asm volatile("" : "+s"(p)); return p; }
template <typename Tp> DI Tp* kload_ptr(int off) { typedef Tp* ptr_t; typedef __attribute__((address_space(4))) const ptr_t* slot_t; return *(slot_t)(kbase() + off); }
DI int kload_int(int off) { typedef __attribute__((address_space(4))) const int* slot_t; return *(slot_t)(kbase() + off); }
#define KIN(type, i) kload_ptr<type>(8 * (i))
#define KOUT() kload_ptr<float>(152)
#define KWS() kload_ptr<unsigned char>(160)
#define KINT(off) kload_int(off)
#define WSP(type, off) ((type*)(KWS() + (off)))

DI void grid_barrier(unsigned* barw) {
    extern __shared__ __attribute__((aligned(16))) unsigned char lds_raw[];
    XcdBarrier b; b.bar = barw; b.x = xb_xcc_id(); b.st = (volatile LAS unsigned*)((LAS unsigned char*)lds_raw + LDSCTL_OFF + 64);
    xcd_barrier(b);
}

__global__ void __launch_bounds__(NTHREADS, 2) mega(MArgs) {
    extern __shared__ __attribute__((aligned(16))) unsigned char lds_raw[];
    LAS unsigned char* lds = (LAS unsigned char*)lds_raw;
#define G ((int)gridDim.x)
#define bx ((int)blockIdx.x)
#define vcu ((G % 8 == 0) ? (bx % 8) * (G / 8) + bx / 8 : bx)
#define NGW (G * NWAVES)
    for (int u = threadIdx.x; u < (LDS_BYTES - LDSCTL_OFF) / 4; u += NTHREADS) ((LAS unsigned*)(lds + LDSCTL_OFF))[u] = 0u;
    __syncthreads();
    pg8::hw_tid_init(lds);
    __syncthreads();
    (void)xcd_barrier_post(WSP(unsigned, WS_CTL) + CW_BAR, (volatile LAS unsigned*)(lds + LDSCTL_OFF + 64));
#define GRID_BAR() grid_barrier(WSP(unsigned, WS_CTL) + CW_BAR)

#define IN(k) (KINT(168) <= (k) && (k) < KINT(172))
#define SEAM(k) do { if (IN(k) && (IN((k) + 1) || ((k) == PH_COUNT - 1 && L + 1 < KINT(180) && KINT(168) == 0))) GRID_BAR(); } while (0)

    for (int L = KINT(176); L < KINT(180); ++L) {
        if (IN(PH_CONV)) {
            const float* w_in = KIN(const float, 5); const float* w_uq = KIN(const float, 11); const float* w_ukv = KIN(const float, 13); const float* cmp_w1 = KIN(const float, 7);
            const float* w_a = KIN(const float, 9); const float* w_b = KIN(const float, 14); const float* w_c = KIN(const float, 15); const float* w_out = KIN(const float, 16);
            const float* w_ple = KIN(const float, 17); const float* w_plg = KIN(const float, 18);
            bf16_t* WinT = WSP(bf16_t, WS_WIN); bf16_t* WuqT = WSP(bf16_t, WS_WUQ); bf16_t* WukvT = WSP(bf16_t, WS_WUKV); bf16_t* W1T = WSP(bf16_t, WS_W1);
            bf16_t* WabcT = WSP(bf16_t, WS_WABC); bf16_t* WoutT = WSP(bf16_t, WS_WOUT); bf16_t* WplgT = WSP(bf16_t, WS_WPLG); bf16_t* WpleT = WSP(bf16_t, WS_WPLE);
            int tid_ = pg8::hw_tid(lds); asm volatile("" : "+v"(tid_)); const int tid = tid_, lane = tid & 63, wave = __builtin_amdgcn_readfirstlane(tid >> 6); const int gw = vcu * NWAVES + wave;
            LAS float* scr = (LAS float*)(lds + wave * 16384);
            constexpr int I_IN = 16 * 346, I_UQ = 6 * 24, I_UKV = 2 * 32, I_W1 = 32 * 8, I_ABC = 8 * 32, I_OUT = 16 * 32, I_PLE = 4 * 32;
            constexpr int NITEMS = I_IN + I_UQ + I_UKV + 2 * I_W1 + 3 * I_ABC + 2 * I_OUT + I_PLE;
            for (int it = gw; it < NITEMS; it += NGW) {
                int r = it; const float* src; bf16_t* dst; int K_, N_; bool perm = false;
                if (r < I_IN) { src = w_in + (size_t)L * D * DIN; dst = WinT; K_ = D; N_ = DIN; perm = true; }
                else if ((r -= I_IN) < I_UQ) { src = w_uq + (size_t)L * 384 * 768; dst = WuqT; K_ = 384; N_ = 768; }
                else if ((r -= I_UQ) < I_UKV) { src = w_ukv + (size_t)L * 128 * 1024; dst = WukvT; K_ = 128; N_ = 1024; }
                else if ((r -= I_UKV) < 2 * I_W1) { const int kv = r / I_W1; r %= I_W1; const int ks = r / 64;
                    src = cmp_w1 + ((size_t)L * 2 + kv) * 2048 * 256 + (size_t)ks * 512 * 256; dst = W1T + (size_t)(ks * 2 + kv) * 256 * 512; K_ = 512; N_ = 256; r %= 64; }
                else if ((r -= 2 * I_W1) < 3 * I_ABC) { const int x = r / I_ABC; r %= I_ABC; src = (x == 0 ? w_a : x == 1 ? w_b : w_c) + (size_t)L * 512 * D; dst = WabcT + (size_t)x * 1024 * 512; K_ = 512; N_ = D; }
                else if ((r -= 3 * I_ABC) < I_OUT) { src = w_out + (size_t)L * D * D; dst = WoutT; K_ = D; N_ = D; }
                else if ((r -= I_OUT) < I_OUT) { src = w_plg + (size_t)L * D * D; dst = WplgT; K_ = D; N_ = D; }
                else { r -= I_OUT; src = w_ple + (size_t)L * 256 * D; dst = WpleT; K_ = 256; N_ = D; }
                tr_item(src, K_, N_, dst, scr, r, lane, perm);
            }
            { const int nz = (NPAD - WIN_VALID) * 1024 / 8; unsigned z0 = 0u; asm volatile("" : "+v"(z0)); u32x4 z = {z0, z0, z0, z0};
              for (int i = gw * 64 + lane; i < nz; i += NGW * 64) *(u32x4*)(WinT + (size_t)WIN_VALID * 1024 + (size_t)i * 8) = z; }
            { const float* p_in = KIN(const float, 1); bf16_t* PBF = WSP(bf16_t, WS_PBF); const float* ps = p_in + (size_t)L * T * 256; const int n8 = T * 256 / 8;
              for (int i = gw * 64 + lane; i < n8; i += NGW * 64) { const f32x4 a = *(const f32x4*)(ps + (size_t)i * 8), b = *(const f32x4*)(ps + (size_t)i * 8 + 4);
                  u32x4 w; w.x = pk2(a[0], a[1]); w.y = pk2(a[2], a[3]); w.z = pk2(b[0], b[1]); w.w = pk2(b[2], b[3]); *(u32x4*)(PBF + (size_t)i * 8) = w; } }
            if (L == 0) {
                const int* pos = KIN(const int, 2); float* TAB = WSP(float, WS_TAB);
                for (int i = gw * 64 + lane; i < T * 24; i += NGW * 64) {
                    const int t = i / 24, j = i % 24; const float p = (float)pos[t];
                    if (j < 8) { const float a = p * powf(500000.0f, -(float)(2 * j) / 16.0f); TAB[(size_t)t * 48 + j] = cosf(a); TAB[(size_t)t * 48 + 8 + j] = sinf(a); }
                    else { const int jj = j - 8; const float a = p * powf(500000.0f, -(float)(2 * jj) / 32.0f); TAB[(size_t)t * 48 + 16 + jj] = cosf(a); TAB[(size_t)t * 48 + 32 + jj] = sinf(a); }
                }
            }
            { const float* xout = (L == 0) ? KIN(const float, 0) : (const float*)KOUT(); const float* g_pre = KIN(const float, 3); bf16_t* H = WSP(bf16_t, WS_H);
              for (int m = gw; m < T; m += NGW) rms_row_f32(xout + (size_t)m * D, g_pre + (size_t)L * D, H + (size_t)m * D, lane); }
        }
        SEAM(PH_CONV);
        if (IN(PH_WIN)) {
            pg8::Gemm g{WSP(bf16_t, WS_H), WSP(bf16_t, WS_WIN), T, NPAD, D}; pg8::StaticOrder S; S.init(T, NPAD, G, bx);
            EpiWin Ep{WSP(bf16_t, WS_UA), WSP(bf16_t, WS_UB), WSP(float, WS_TAB)};
            pg8::gemm_phase<EpiWin, pg8::StaticOrder, true, true>(lds, g, S, Ep);
        }
        SEAM(PH_WIN);
        if (IN(PH_PREP)) {
            int tid_ = pg8::hw_tid(lds); asm volatile("" : "+v"(tid_)); const int tid = tid_, lane = tid & 63, wave = __builtin_amdgcn_readfirstlane(tid >> 6); const int gw = vcu * NWAVES + wave;
            { const bf16_t* UA = WSP(bf16_t, WS_UA); bf16_t* QN = WSP(bf16_t, WS_QN); bf16_t* KVN = WSP(bf16_t, WS_KVN);
              const float* gq = KIN(const float, 10) + (size_t)L * 384; const float* gkv = KIN(const float, 12) + (size_t)L * 128;
              for (int m = gw; m < T; m += NGW) {
                  const bool isq = lane < 48; const int e0 = isq ? lane * 8 : (lane - 48) * 8;
                  const u32x4 w = *(const u32x4*)(UA + (size_t)m * LDA + (isq ? A_BCQ : A_BCKV) + e0);
                  float v[8] = {bflo(w.x), bfhi(w.x), bflo(w.y), bfhi(w.y), bflo(w.z), bfhi(w.z), bflo(w.w), bfhi(w.w)};
                  float ss = 0.f;
#pragma unroll
                  for (int e = 0; e < 8; ++e) ss += v[e] * v[e];
                  const float sq = wsum(isq ? ss : 0.f, lane), sk = wsum(isq ? 0.f : ss, lane);
                  const float rs = isq ? rsqrtf(sq * (1.f / 384.f) + 1e-6f) : rsqrtf(sk * (1.f / 128.f) + 1e-6f);
                  const float* gp = (isq ? gq : gkv) + e0;
                  const f32x4 g0 = *(const f32x4*)gp, g1 = *(const f32x4*)(gp + 4);
                  u32x4 o; o.x = pk2(v[0] * rs * g0[0], v[1] * rs * g0[1]); o.y = pk2(v[2] * rs * g0[2], v[3] * rs * g0[3]); o.z = pk2(v[4] * rs * g1[0], v[5] * rs * g1[1]); o.w = pk2(v[6] * rs * g1[2], v[7] * rs * g1[3]);
                  if (isq) *(u32x4*)(QN + (size_t)m * 384 + e0) = o; else *(u32x4*)(KVN + (size_t)m * 128 + e0) = o;
              } }
            { const bf16_t* UA = WSP(bf16_t, WS_UA); bf16_t* FLAT = WSP(bf16_t, WS_FLAT); const float* pe = KIN(const float, 6) + (size_t)L * 2 * 32 * 64;
              for (int i = gw * 64 + lane; i < 2 * CROWS * 256; i += NGW * 64) {
                  const int kv = i / (CROWS * 256), rem = i % (CROWS * 256), row = rem >> 8, gcol = rem & 255, l = gcol >> 3, d = (gcol & 7) * 8;
                  u32x4 o = {0u, 0u, 0u, 0u};
                  if (row < NB * NC * 2) {
                      const int hk = row & 1, bc = row >> 1, b = bc / NC, c = bc % NC;
                      const u32x4 w = *(const u32x4*)(UA + (size_t)(b * S + 16 * c + l) * LDA + A_AKV + kv * 128 + hk * 64 + d);
                      const float* pp = pe + (kv * 32 + l) * 64 + d; const f32x4 p0 = *(const f32x4*)pp, p1 = *(const f32x4*)(pp + 4);
                      o.x = pk2(bflo(w.x) + p0[0], bfhi(w.x) + p0[1]); o.y = pk2(bflo(w.y) + p0[2], bfhi(w.y) + p0[3]); o.z = pk2(bflo(w.z) + p1[0], bfhi(w.z) + p1[1]); o.w = pk2(bflo(w.w) + p1[2], bfhi(w.w) + p1[3]);
                  }
                  *(u32x4*)(FLAT + ((size_t)(((gcol >> 6) * 2 + kv) * CROWS + row) * 512 + (gcol & 63) * 8)) = o;
              } }
        }
        SEAM(PH_PREP);
        if (IN(PH_G2)) {
            { pg8::Gemm g{WSP(bf16_t, WS_FLAT), WSP(bf16_t, WS_W1), 8 * CROWS, 8 * 256, 512}; HidOrder S{G, bx};
              EpiF32<0> Ep{WSP(float, WS_HIDP), 256, 0};
              pg8::gemm_phase<EpiF32<0>, HidOrder, true, true>(lds, g, S, Ep); }
            __syncthreads();
            { pg8::Gemm g{WSP(bf16_t, WS_QN), WSP(bf16_t, WS_WUQ), T, 768, 384}; pg8::StaticOrder S; S.init(T, 768, G, bx); EpiQm Ep{WSP(bf16_t, WS_QM), WSP(float, WS_TAB)};
              pg8::gemm_phase<EpiQm, pg8::StaticOrder, true, true>(lds, g, S, Ep); }
            __syncthreads();
            { pg8::Gemm g{WSP(bf16_t, WS_KVN), WSP(bf16_t, WS_WUKV), T, 1024, 128}; pg8::StaticOrder S; S.init(T, 1024, G, bx); EpiBfPlain Ep{WSP(bf16_t, WS_KVU), 1024, 0};
              pg8::gemm_phase<EpiBfPlain, pg8::StaticOrder, true, true>(lds, g, S, Ep); }
            __syncthreads();
            { pg8::Gemm g{WSP(bf16_t, WS_PBF), WSP(bf16_t, WS_WPLE), T, D, 256}; pg8::StaticOrder S; S.init(T, D, G, bx); EpiBfPlain Ep{WSP(bf16_t, WS_EB), D, 0};
              pg8::gemm_phase<EpiBfPlain, pg8::StaticOrder, true, true>(lds, g, S, Ep); }
        }
        SEAM(PH_G2);
        if (IN(PH_KC)) {
            int tid_ = pg8::hw_tid(lds); asm volatile("" : "+v"(tid_)); const int tid = tid_, lane = tid & 63, wave = __builtin_amdgcn_readfirstlane(tid >> 6);
            const float* HIDP = WSP(float, WS_HIDP); bf16_t* KC = WSP(bf16_t, WS_KC);
            for (int blk = vcu; blk < 2 * CROWS / 16; blk += G) {
                const int kv = blk / (CROWS / 16);
                const float* w2 = KIN(const float, 8) + ((size_t)L * 2 + kv) * 256 * 64;
                for (int i = tid; i < 256 * 64 / 4; i += NTHREADS) *(LAS f32x4*)(lds + 16 * i) = *(const f32x4*)(w2 + 4 * i);
                LAS float* hrow = (LAS float*)(lds + 65536 + wave * 2048);
#pragma unroll
                for (int rr = 0; rr < 2; ++rr) {
                    const size_t r = (size_t)blk * 16 + wave * 2 + rr;
                    f32x4 h = *(const f32x4*)(HIDP + r * 256 + 4 * lane);
#pragma unroll
                    for (int ks = 1; ks < 4; ++ks) { const f32x4 q = *(const f32x4*)(HIDP + ((size_t)ks * 2 * CROWS + r) * 256 + 4 * lane); h = h + q; }
#pragma unroll
                    for (int e = 0; e < 4; ++e) h[e] = h[e] * sigf(h[e]);
                    *(LAS f32x4*)(hrow + rr * 256 + 4 * lane) = h;
                }
                __syncthreads();
                const LAS float* w2s = (const LAS float*)lds;
                float a0 = 0.f, a1 = 0.f;
#pragma unroll 8
                for (int k = 0; k < 256; ++k) { const float w = w2s[k * 64 + lane]; a0 += hrow[k] * w; a1 += hrow[256 + k] * w; }
                const size_t r0 = (size_t)blk * 16 + wave * 2;
                KC[r0 * 64 + lane] = f2bf(a0); KC[(r0 + 1) * 64 + lane] = f2bf(a1);
                __syncthreads();
            }
        }
        SEAM(PH_KC);
        if (IN(PH_ATT1)) {
            int tid_ = pg8::hw_tid(lds); asm volatile("" : "+v"(tid_)); const int tid = tid_;
            unsigned* qctr = WSP(unsigned, WS_CTL) + CW_QUEUE + 64 * L;
            LAS unsigned* wq = (LAS unsigned*)(lds + fa::WQ_OFF);
            for (;;) {
                if (tid == 0) *wq = atomicAdd(qctr, 1u);
                __syncthreads();
                const int id = (int)*wq;
                __syncthreads();
                if (id >= 2560) break;
                if (id < 1024) {
                    const int gq = id >> 6, r = id & 63;
                    if (r >= 8 && r < 40) { const int bh = r - 8;
                        fa::unit_mla(lds, tid, bh >> 3, bh & 7, 15 - gq, WSP(bf16_t, WS_QM), WSP(bf16_t, WS_KVU), WSP(bf16_t, WS_UA), WSP(bf16_t, WS_UB), WSP(bf16_t, WS_O7) + O7_STRIDE);
                    } else { const int k = (r < 8) ? 0 : ((r - 40) >> 3) + 1, bk = r & 7;
                        fa::unit_nsa(lds, tid, bk >> 1, bk & 1, 63 - 4 * gq - k, WSP(bf16_t, WS_UA), WSP(bf16_t, WS_UB), WSP(bf16_t, WS_KC), WSP(bf16_t, WS_O7)); }
                } else {
                    const int e = id - 1024, gi = e >> 9, bh = e & 31, rest = (e >> 5) & 15;
                    const int dil = (gi == 0) ? 1 : (gi == 1) ? 4 : 16;
                    fa::unit_dil(lds, tid, gi, bh >> 3, bh & 7, rest % dil, rest / dil, WSP(bf16_t, WS_UA),
                                 WSP(bf16_t, WS_O7) + (size_t)(gi == 0 ? 2 : gi == 1 ? 5 : 6) * O7_STRIDE, WSP(float, WS_LSE) + (size_t)gi * T * 8);
                }
            }
        }
        SEAM(PH_ATT1);
        if (IN(PH_COMB)) {
            int tid_ = pg8::hw_tid(lds); asm volatile("" : "+v"(tid_)); const int tid = tid_, lane = tid & 63, wave = __builtin_amdgcn_readfirstlane(tid >> 6); const int gw = vcu * NWAVES + wave;
            bf16_t* O7 = WSP(bf16_t, WS_O7); const float* LSE = WSP(float, WS_LSE); const bf16_t* UB = WSP(bf16_t, WS_UB);
            bf16_t* od0 = O7 + 2 * O7_STRIDE; const bf16_t* od1 = O7 + 5 * O7_STRIDE; const bf16_t* od2 = O7 + 6 * O7_STRIDE;
            for (int i = gw * 64 + lane; i < T * 64; i += NGW * 64) {
                const int t = i >> 6, col = (i & 63) * 8, h = col >> 6;
                const float l0 = LSE[((size_t)0 * T + t) * 8 + h], l1 = LSE[((size_t)1 * T + t) * 8 + h], l2 = LSE[((size_t)2 * T + t) * 8 + h];
                const float mx = fmaxf(l0, fmaxf(l1, l2));
                float w0 = __expf(l0 - mx), w1 = __expf(l1 - mx), w2 = __expf(l2 - mx); const float iw = __builtin_amdgcn_rcpf(w0 + w1 + w2); w0 *= iw; w1 *= iw; w2 *= iw;
                const size_t o = (size_t)t * 512 + col;
                const u32x4 a = *(const u32x4*)(od0 + o), b = *(const u32x4*)(od1 + o), c = *(const u32x4*)(od2 + o), z = *(const u32x4*)(UB + (size_t)t * LDB + B_ZC + col);
                const unsigned aw[4] = {a.x, a.y, a.z, a.w}, bw[4] = {b.x, b.y, b.z, b.w}, cw[4] = {c.x, c.y, c.z, c.w}, zw[4] = {z.x, z.y, z.z, z.w}; unsigned ow[4];
#pragma unroll
                for (int e = 0; e < 4; ++e) { const float z0 = bflo(zw[e]), z1 = bfhi(zw[e]);
                    ow[e] = pk2((w0 * bflo(aw[e]) + w1 * bflo(bw[e]) + w2 * bflo(cw[e])) * z0 * sigf(z0), (w0 * bfhi(aw[e]) + w1 * bfhi(bw[e]) + w2 * bfhi(cw[e])) * z1 * sigf(z1)); }
                *(u32x4*)(od0 + o) = (u32x4){ow[0], ow[1], ow[2], ow[3]};
            }
        }
        SEAM(PH_COMB);
        if (IN(PH_YABC)) {
            pg8::Gemm g{WSP(bf16_t, WS_O7), WSP(bf16_t, WS_WABC), 3 * T, 3 * 1024, 512}; YabcOrder S{G, vcu};
            EpiYabc Ep{WSP(bf16_t, WS_YMIXB), WSP(bf16_t, WS_UB)};
            pg8::gemm_phase<EpiYabc, YabcOrder, true, true>(lds, g, S, Ep);
        }
        SEAM(PH_YABC);
        if (IN(PH_WOUT)) {
            pg8::Gemm g{WSP(bf16_t, WS_YMIXB), WSP(bf16_t, WS_WOUT), T, D, D}; pg8::StaticOrder S; S.init(T, D, G, bx);
            EpiF32<0> Ep{WSP(float, WS_Y2), D, -1};
            pg8::gemm_phase<EpiF32<0>, pg8::StaticOrder, true, true>(lds, g, S, Ep);
        }
        SEAM(PH_WOUT);
        if (IN(PH_POST)) {
            int tid_ = pg8::hw_tid(lds); asm volatile("" : "+v"(tid_)); const int tid = tid_, lane = tid & 63, wave = __builtin_amdgcn_readfirstlane(tid >> 6); const int gw = vcu * NWAVES + wave;
            const float* xsrc = (L == 0) ? KIN(const float, 0) : (const float*)KOUT(); float* xout = KOUT(); const float* Y2 = WSP(float, WS_Y2); bf16_t* H = WSP(bf16_t, WS_H);
            const float* gp = KIN(const float, 4) + (size_t)L * D;
            for (int m = gw; m < T; m += NGW) {
                const f32x4* yr = (const f32x4*)(Y2 + (size_t)m * D) + lane; const f32x4* xr = (const f32x4*)(xsrc + (size_t)m * D) + lane; const f32x4* gr = (const f32x4*)gp + lane;
                f32x4 v[4]; float s = 0.f;
#pragma unroll
                for (int j = 0; j < 4; ++j) { v[j] = yr[64 * j]; s += (v[j][0] * v[j][0] + v[j][1] * v[j][1]) + (v[j][2] * v[j][2] + v[j][3] * v[j][3]); }
                const float rs = rsqrtf(wsum(s, lane) * (1.f / 1024.f) + 1e-6f);
                f32x4* xo = (f32x4*)(xout + (size_t)m * D) + lane; unsigned long long* h8 = (unsigned long long*)(H + (size_t)m * D) + lane;
#pragma unroll
                for (int j = 0; j < 4; ++j) { const f32x4 gg = gr[64 * j]; f32x4 xn = xr[64 * j];
                    xn[0] += v[j][0] * rs * gg[0]; xn[1] += v[j][1] * rs * gg[1]; xn[2] += v[j][2] * rs * gg[2]; xn[3] += v[j][3] * rs * gg[3];
                    xo[64 * j] = xn; h8[64 * j] = (unsigned long long)pk2(xn[0], xn[1]) | ((unsigned long long)pk2(xn[2], xn[3]) << 32); }
            }
        }
        SEAM(PH_POST);
        if (IN(PH_PLE)) {
            pg8::Gemm g{WSP(bf16_t, WS_H), WSP(bf16_t, WS_WPLG), T, D, D}; pg8::StaticOrder S; S.init(T, D, G, bx); EpiPlgF Ep{KOUT(), WSP(bf16_t, WS_EB)};
            pg8::gemm_phase<EpiPlgF, pg8::StaticOrder, true, true>(lds, g, S, Ep);
        }
        SEAM(PH_PLE);
    }
#undef IN
#undef SEAM
#undef G
#undef bx
#undef vcu
#undef NGW
}

static void launch_mega(hipStream_t st, void* const* d_in, void* d_out, void* d_ws, int ph_lo, int ph_hi, int l_lo, int l_hi) {
    MArgs a{};
    for (int i = 0; i < 19; ++i) a.in[i] = d_in[i];
    a.out = (float*)d_out; a.ws = (unsigned char*)d_ws; a.ph_lo = ph_lo; a.ph_hi = ph_hi; a.l_lo = l_lo; a.l_hi = l_hi;
    (void)hipMemsetAsync((char*)d_ws + WS_CTL, 0, 1 << 20, st);
    hipLaunchKernelGGL(mega, dim3(256), dim3(NTHREADS), LDS_BYTES, st, a);
}
extern "C" void kernel_launch(void* const* d_in, const int* in_sizes, int n_in, void* d_out, int out_size, void* d_ws, size_t ws_size, hipStream_t stream) {
    if (ws_size < WS_END2 || n_in != 19) return;
    (void)hipFuncSetAttribute((const void*)mega, hipFuncAttributeMaxDynamicSharedMemorySize, LDS_BYTES);
    launch_mega(stream, d_in, d_out, d_ws, 0, PH_COUNT, 0, DEPTH);
}
```

```cpp
#include <hip/hip_runtime.h>
#include <stdint.h>
#include <math.h>

typedef unsigned short bf16_t;
#define DI __device__ __forceinline__

constexpr int NB = 4, S = 4096, T = NB * S, D = 1024, DEPTH = 4;
constexpr int DIN = 11064;
constexpr int A_AQ = 0, A_AKV = 512, A_BCQ = 1280, A_BCKV = 1664, A_BKR = 1792, A_CQKV = 1824, LDA = 6432;
constexpr int B_ZA = 0, B_ZB = 512, B_ZC = 1024, B_GATE = 1536, LDB = 3104;
constexpr int B_MG8 = 3136;
constexpr int VB_MG = 1536, VB_GATE = 4608;
constexpr int NC = 255;
constexpr int CROWS = 2048;

constexpr size_t al256(size_t x) { return (x + 255) & ~(size_t)255; }
constexpr size_t WS_CTL = 0;
constexpr size_t WS_UA = 1 << 20;
constexpr size_t WS_UB = WS_UA + al256((size_t)T * LDA * 2);
constexpr size_t WS_H = WS_UB + al256((size_t)T * LDB * 2);
constexpr size_t WS_O7 = WS_H + al256((size_t)T * 1024 * 2);
constexpr size_t O7_STRIDE = (size_t)T * 512;
constexpr size_t WS_LSE = WS_O7 + al256(7 * O7_STRIDE * 2);
constexpr size_t WS_QM = WS_LSE + al256((size_t)3 * T * 8 * 4);
constexpr size_t WS_KVU = WS_QM + al256((size_t)T * 768 * 2);
constexpr size_t WS_FLAT = WS_KVU + al256((size_t)T * 1024 * 2);
constexpr size_t WS_KC = WS_FLAT + al256((size_t)2 * CROWS * 2048 * 2);
constexpr size_t WS_TAB = WS_KC + al256((size_t)2 * CROWS * 64 * 2);
constexpr size_t WS_SSQ = WS_TAB + al256((size_t)T * 48 * 4);
constexpr size_t WS_XB2 = WS_SSQ + al256((size_t)T * 4 * 4);
constexpr size_t WS_END = WS_XB2 + al256((size_t)T * 1024 * 2);
constexpr size_t WS_YMIXB = WS_UA;
constexpr size_t WS_Y2 = WS_YMIXB + (size_t)T * 1024 * 2;
static_assert(WS_Y2 + (size_t)T * 1024 * 4 <= WS_UB, "alias region fits in UA");
constexpr size_t WS_QN = WS_H;
constexpr size_t WS_KVN = WS_QN + (size_t)T * 384 * 2;
constexpr size_t WS_HIDP = WS_KVN + (size_t)T * 128 * 2;
static_assert(WS_HIDP + (size_t)4 * 2 * CROWS * 256 * 4 <= WS_O7, "H aliases");
constexpr size_t WS_EB = WS_O7 + 3 * O7_STRIDE * 2;

DI float bf2f(bf16_t v) { return __uint_as_float(((unsigned)v) << 16); }
DI bf16_t f2bf(float f) { unsigned u = __float_as_uint(f); u += 0x7fffu + ((u >> 16) & 1u); return (bf16_t)(u >> 16); }
DI float sigm(float x) { return 1.f / (1.f + __expf(-x)); }
DI float wave_sum(float v) { for (int o = 32; o > 0; o >>= 1) v += __shfl_xor(v, o); return v; }
DI float wave_max(float v) { for (int o = 32; o > 0; o >>= 1) v = fmaxf(v, __shfl_xor(v, o)); return v; }
DI float ldf(const float* p) { return *p; }
DI float ldf(const bf16_t* p) { return bf2f(*p); }


namespace pg8 {
#define PG8_LAS __attribute__((address_space(3)))
typedef unsigned short bf16_t;
typedef short bf16x8 __attribute__((ext_vector_type(8)));
typedef float f32x4 __attribute__((ext_vector_type(4)));
typedef unsigned u32x4 __attribute__((ext_vector_type(4)));
constexpr int BM = 256, BK = 64, HALF = 128, HTB = HALF * BK * 2  , STAGE_BYTES = 8 * HTB, NXCD = 8, WGM = 8;

__host__ __device__ __forceinline__ int lds_byte(int r, int c) { const int st = (r >> 4) * 2 + (c >> 5), rr = r & 15, cc = c & 31, ob = rr * 64 + cc * 2; return st * 1024 + (ob ^ (((ob >> 9) & 1) << 5)); }
__host__ __device__ __forceinline__ void stage_rc(int b, int& R, int& C) { const int st = b / 1024, sb = b % 1024, swz = sb ^ (((sb >> 9) & 1) << 5); R = (st >> 1) * 16 + swz / 64; C = (st & 1) * 32 + (swz % 64) / 2; }
__host__ __device__ __forceinline__ int perm32(int rho) { const int n = rho >> 4, i = rho & 15; return 8 * (i >> 2) + 4 * n + (i & 3); }

constexpr int HWTID_OFF = 131072 + 1024;
__device__ __forceinline__ unsigned hw_slot() { const unsigned h = (unsigned)__builtin_amdgcn_s_getreg((6 << 11) | (0 << 6) | 4); return h & 63u; }
__device__ __forceinline__ void hw_tid_init(PG8_LAS unsigned char* lds) { if ((threadIdx.x & 63) == 0) *(PG8_LAS unsigned*)(lds + HWTID_OFF + 4 * hw_slot()) = threadIdx.x >> 6; }
__device__ __forceinline__ int hw_tid(PG8_LAS unsigned char* lds) {
    const unsigned w = *(PG8_LAS unsigned*)(lds + HWTID_OFF + 4 * hw_slot());
    int lane; asm volatile("v_mbcnt_lo_u32_b32 %0, -1, 0\n\tv_mbcnt_hi_u32_b32 %0, -1, %0" : "=v"(lane));
    return (int)__builtin_amdgcn_readfirstlane(w) * 64 + lane;
}
struct Unit { int pm, pn; };
struct Gemm { const bf16_t* A; const bf16_t* Bt; int M, N, K; };

struct StaticOrder {
    int nM, nN, nwg, G, c;
    __host__ __device__ void init(int M, int N, int G_, int c_) { nM = M / BM; nN = N / BM; nwg = nM * nN; G = G_; c = c_; }
    __host__ __device__ bool next(int i, Unit& u) const {
        const long L = (long)i * G + c; if (L >= nwg) return false;
        int wgid = (int)L; { const int q = nwg / NXCD, r = nwg % NXCD, xcd = wgid % NXCD, off = wgid / NXCD; wgid = (xcd < r ? xcd * (q + 1) : r * (q + 1) + (xcd - r) * q) + off; }
        const int nig = WGM * nN, gid = wgid / nig, fm = gid * WGM, gsz = (nM - fm) < WGM ? (nM - fm) : WGM;
        u.pm = fm + ((wgid % nig) % gsz); u.pn = (wgid % nig) / gsz; return true;
    }
    __device__ __forceinline__ void a_ready(const Unit&) const {}
    __device__ __forceinline__ void done(const Unit&) const {}
};

__device__ __forceinline__ unsigned cvt_pk_bf16(float lo, float hi) { unsigned r; asm volatile("v_cvt_pk_bf16_f32 %0, %1, %2" : "=v"(r) : "v"(lo), "v"(hi)); return r; }

template <class Epi, class Sched, bool ALIGN_EPI = false, bool SP2 = false>
__device__ __forceinline__ void gemm_phase(PG8_LAS unsigned char* lds, const Gemm g, const Sched& S, const Epi& E) {
    int tid_ = hw_tid(lds); asm volatile("" : "+v"(tid_));
    const int tid = tid_, wid = __builtin_amdgcn_readfirstlane(tid >> 6), lane = tid & 63, wr = wid >> 2, wc = wid & 3, fr = lane & 15, fq = lane >> 4;
    int K_ = g.K; asm volatile("" : "+s"(K_));
    __builtin_assume(K_ >= 128 && K_ % 128 == 0);
    const int K = K_, nt = K / BK;
    unsigned voffA[2], voffB[2];
#pragma unroll
    for (int i = 0; i < 2; ++i) { int R, C; stage_rc(tid * 16 + i * 8192, R, C); const int Rb = Epi::PERM ? ((R & ~31) + perm32(R & 31)) : R;
        voffA[i] = (unsigned)(R * K + C) * 2u; voffB[i] = (unsigned)(Rb * K + C) * 2u; }
    const size_t kstep = (size_t)(BK * 2);
    const size_t hstep = (size_t)HALF * K * 2;
    const size_t tstep = 2 * hstep;
    const unsigned ldsw = (unsigned)wid * 1024u;
    const int aoff = lds_byte(wr * 64 + fr, fq * 8), boff = lds_byte(wc * 32 + fr, fq * 8);
#define PG8_SA(b, h) (((b) * 2 + (h)) * HTB)
#define PG8_SB(b, h) ((4 + (b) * 2 + (h)) * HTB)
#define PG8_STAGE(bufoff, gbase, voff) do { _Pragma("unroll") for (int _i = 0; _i < 2; ++_i) \
        __builtin_amdgcn_global_load_lds((const unsigned*)((const char*)(gbase) + (voff)[_i]), (PG8_LAS unsigned*)(lds + (bufoff) + ldsw + _i * 8192), 16, 0, 0); } while (0)
#define PG8_LDA(dst, b, h) do { _Pragma("unroll") for (int m = 0; m < 4; ++m) _Pragma("unroll") for (int k = 0; k < 2; ++k) dst[m][k] = *(const PG8_LAS bf16x8*)(lds + PG8_SA(b, h) + aoff + m * 2048 + k * 1024); } while (0)
#define PG8_LDB(dst, b, h) do { _Pragma("unroll") for (int n = 0; n < 2; ++n) _Pragma("unroll") for (int k = 0; k < 2; ++k) dst[n][k] = *(const PG8_LAS bf16x8*)(lds + PG8_SB(b, h) + boff + n * 2048 + k * 1024); } while (0)
#define PG8_MMA(ai, bj, At, Bt) do { __builtin_amdgcn_s_setprio(1); _Pragma("unroll") for (int m = 0; m < 4; ++m) _Pragma("unroll") for (int n = 0; n < 2; ++n) _Pragma("unroll") for (int k = 0; k < 2; ++k) \
        acc[ai][bj][m][n] = __builtin_amdgcn_mfma_f32_16x16x32_bf16(Bt[n][k], At[m][k], acc[ai][bj][m][n], 0, 0, 0); __builtin_amdgcn_s_setprio(0); } while (0)
#define PG8_WAIT_V(n) asm volatile("s_waitcnt vmcnt(" #n ")" ::: "memory")
#define PG8_WAIT_L(n) asm volatile("s_waitcnt lgkmcnt(" #n ")" ::: "memory")
#define PG8_BAR __builtin_amdgcn_s_barrier()
#define PG8_SCHED __builtin_amdgcn_sched_barrier(0)
    Unit cur, nxt; int ui = 0;
    if (!S.next(0, cur)) return;
    float zf_ = 0.f; asm volatile("" : "+v"(zf_));
    f32x4 acc[2][2][4][2];
#pragma unroll
    for (int a = 0; a < 2; ++a)
#pragma unroll
        for (int b = 0; b < 2; ++b)
#pragma unroll
            for (int m = 0; m < 4; ++m)
#pragma unroll
                for (int n = 0; n < 2; ++n) acc[a][b][m][n] = (f32x4){zf_, zf_, zf_, zf_};
    bf16x8 At[4][2], B0[2][2], B1[2][2];
    const char* cA = (const char*)g.A + (size_t)cur.pm * tstep; const char* cB = (const char*)g.Bt + (size_t)cur.pn * tstep;
    S.a_ready(cur);
    if constexpr (SP2) {
        PG8_STAGE(PG8_SB(0, 0), cB, voffB); PG8_STAGE(PG8_SB(0, 1), cB + hstep, voffB); PG8_STAGE(PG8_SA(0, 0), cA, voffA); PG8_STAGE(PG8_SA(0, 1), cA + hstep, voffA);
        if (wr == 1) PG8_BAR;
        PG8_WAIT_V(2); PG8_BAR;
        PG8_STAGE(PG8_SB(1, 0), cB + kstep, voffB); PG8_STAGE(PG8_SA(1, 0), cA + kstep, voffA); PG8_STAGE(PG8_SB(1, 1), cB + hstep + kstep, voffB);
        PG8_WAIT_V(6); PG8_BAR;
    } else {
        PG8_STAGE(PG8_SB(0, 0), cB, voffB); PG8_STAGE(PG8_SA(0, 0), cA, voffA); PG8_STAGE(PG8_SB(0, 1), cB + hstep, voffB); PG8_STAGE(PG8_SA(0, 1), cA + hstep, voffA);
        if (wr == 1) PG8_BAR;
        PG8_WAIT_V(4); PG8_BAR;
        PG8_STAGE(PG8_SB(1, 0), cB + kstep, voffB); PG8_STAGE(PG8_SA(1, 0), cA + kstep, voffA); PG8_STAGE(PG8_SB(1, 1), cB + hstep + kstep, voffB);
        PG8_WAIT_V(6); PG8_BAR;
    }
    for (;;) {
        const bool has_next = S.next(ui + 1, nxt);
        const char* nA = has_next ? (const char*)g.A + (size_t)nxt.pm * tstep : cA; const char* nB = has_next ? (const char*)g.Bt + (size_t)nxt.pn * tstep : cB;
        for (int t = 0; t < nt; t += 2) {
            const bool last = (t == nt - 2);
            const char* a1 = cA + (size_t)(t + 1) * kstep;
            const char* a2 = last ? nA : cA + (size_t)(t + 2) * kstep; const char* b2 = last ? nB : cB + (size_t)(t + 2) * kstep;
            const char* a3 = a2 + kstep; const char* b3 = b2 + kstep;
            if (last && has_next) S.a_ready(nxt);
            if constexpr (SP2) {
            PG8_LDB(B0, 0, 0); PG8_LDB(B1, 0, 1); PG8_SCHED; PG8_LDA(At, 0, 0); PG8_STAGE(PG8_SA(1, 1), a1 + hstep, voffA);
            PG8_WAIT_V(8); PG8_WAIT_L(0); PG8_BAR; PG8_MMA(0, 0, At, B0); PG8_MMA(0, 1, At, B1); PG8_BAR; PG8_SCHED;
            PG8_LDA(At, 0, 1); PG8_STAGE(PG8_SB(0, 0), b2, voffB); PG8_STAGE(PG8_SB(0, 1), b2 + hstep, voffB); PG8_STAGE(PG8_SA(0, 0), a2, voffA);
            PG8_WAIT_V(8); PG8_WAIT_L(0); PG8_BAR; PG8_MMA(1, 0, At, B0); PG8_MMA(1, 1, At, B1); PG8_BAR; PG8_SCHED;
            PG8_LDB(B0, 1, 0); PG8_LDB(B1, 1, 1); PG8_SCHED; PG8_LDA(At, 1, 0); PG8_STAGE(PG8_SA(0, 1), a2 + hstep, voffA);
            PG8_WAIT_V(8); PG8_WAIT_L(0); PG8_BAR; PG8_MMA(0, 0, At, B0); PG8_MMA(0, 1, At, B1); PG8_BAR; PG8_SCHED;
            PG8_LDA(At, 1, 1); PG8_STAGE(PG8_SB(1, 0), b3, voffB); PG8_STAGE(PG8_SB(1, 1), b3 + hstep, voffB); PG8_STAGE(PG8_SA(1, 0), a3, voffA);
            PG8_WAIT_V(8); PG8_WAIT_L(0); PG8_BAR; PG8_MMA(1, 0, At, B0); PG8_MMA(1, 1, At, B1); PG8_BAR; PG8_SCHED;
            } else {
            PG8_LDB(B0, 0, 0); PG8_SCHED; PG8_LDA(At, 0, 0); PG8_STAGE(PG8_SA(1, 1), a1 + hstep, voffA);
            PG8_WAIT_L(8); PG8_BAR; PG8_WAIT_L(0); PG8_MMA(0, 0, At, B0); PG8_BAR; PG8_SCHED;
            PG8_LDB(B1, 0, 1); PG8_STAGE(PG8_SB(0, 0), b2, voffB);
            PG8_BAR; PG8_WAIT_L(0); PG8_MMA(0, 1, At, B1); PG8_BAR;
            PG8_LDA(At, 0, 1); PG8_STAGE(PG8_SA(0, 0), a2, voffA);
            PG8_BAR; PG8_WAIT_L(0); PG8_MMA(1, 0, At, B0); PG8_BAR; PG8_SCHED;
            PG8_STAGE(PG8_SB(0, 1), b2 + hstep, voffB);
            PG8_WAIT_V(6); PG8_BAR; PG8_MMA(1, 1, At, B1); PG8_BAR;
            PG8_LDB(B0, 1, 0); PG8_SCHED; PG8_LDA(At, 1, 0); PG8_STAGE(PG8_SA(0, 1), a2 + hstep, voffA);
            PG8_WAIT_L(8); PG8_BAR; PG8_WAIT_L(0); PG8_MMA(0, 0, At, B0); PG8_BAR; PG8_SCHED;
            PG8_LDB(B1, 1, 1); PG8_STAGE(PG8_SB(1, 0), b3, voffB);
            PG8_BAR; PG8_WAIT_L(0); PG8_MMA(0, 1, At, B1); PG8_BAR;
            PG8_LDA(At, 1, 1); PG8_STAGE(PG8_SA(1, 0), a3, voffA);
            PG8_BAR; PG8_WAIT_L(0); PG8_MMA(1, 0, At, B0); PG8_BAR; PG8_SCHED;
            PG8_STAGE(PG8_SB(1, 1), b3 + hstep, voffB);
            PG8_WAIT_V(6); PG8_BAR; PG8_MMA(1, 1, At, B1); PG8_BAR;
            }
        }
        if constexpr (ALIGN_EPI) { if (wr == 0) PG8_BAR; }
        if constexpr (!Epi::AFTER_DRAIN) { E(acc, cur, wr, wc, fr, fq); S.done(cur); }
        if (!has_next) break;
#pragma unroll
        for (int a = 0; a < 2; ++a)
#pragma unroll
            for (int b = 0; b < 2; ++b)
#pragma unroll
                for (int m = 0; m < 4; ++m)
#pragma unroll
                    for (int n = 0; n < 2; ++n) acc[a][b][m][n] = (f32x4){zf_, zf_, zf_, zf_};
        asm volatile("" : "+v"(zf_));
        cur = nxt; cA = nA; cB = nB; ++ui;
        if constexpr (ALIGN_EPI) { if (wr == 1) PG8_BAR; }
    }
    PG8_WAIT_V(0);
    if constexpr (!ALIGN_EPI) { if (wr == 0) PG8_BAR; }
    PG8_BAR;
    if constexpr (Epi::AFTER_DRAIN) { E.fused(acc, cur, wr, wc, fr, fq, lds, wid, lane); S.done(cur); }
#undef PG8_SA
#undef PG8_SB
#undef PG8_STAGE
#undef PG8_LDA
#undef PG8_LDB
#undef PG8_MMA
#undef PG8_WAIT_V
#undef PG8_WAIT_L
#undef PG8_BAR
#undef PG8_SCHED
}
}

#define GAS __attribute__((address_space(1)))
#define LAS __attribute__((address_space(3)))
typedef float f32x4 __attribute__((ext_vector_type(4)));
typedef unsigned u32x4 __attribute__((ext_vector_type(4)));
constexpr int NWAVES = 8, NTHREADS = 512;
constexpr int RING_BYTES = 131072, LDSCTL_OFF = RING_BYTES, LDS_BYTES = 147456;
constexpr int NPAD = 11264;
constexpr size_t WO_WIN = 0;
constexpr size_t WO_WUQ = WO_WIN + (size_t)NPAD * 1024 * 2;
constexpr size_t WO_WUKV = WO_WUQ + (size_t)768 * 384 * 2;
constexpr size_t WO_W1 = WO_WUKV + (size_t)1024 * 128 * 2;
constexpr size_t WO_WABC = WO_W1 + (size_t)2 * 256 * 2048 * 2;
constexpr size_t WO_WOUT = WO_WABC + (size_t)3 * 1024 * 512 * 2;
constexpr size_t WO_WPLG = WO_WOUT + (size_t)1024 * 1024 * 2;
constexpr size_t WO_WPLE = WO_WPLG + (size_t)1024 * 1024 * 2;
constexpr size_t WO_PBF = WO_WPLE + (size_t)1024 * 256 * 2;
constexpr size_t WSET_BYTES = WO_PBF + (size_t)T * 256 * 2;
constexpr size_t WS_WSET = WS_END;
constexpr size_t WS_END2 = WS_WSET + 2 * WSET_BYTES;
static_assert(WS_END2 <= (size_t)725090304, "fits the guaranteed workspace (4 x the largest tensor)");
constexpr int CW_BAR = 4096;
constexpr int CW_QUEUE = 16384;
constexpr size_t CTL_GRAN = 256 * 1024;

DI unsigned pk2(float lo, float hi) { return (unsigned)f2bf(lo) | ((unsigned)f2bf(hi) << 16); }
typedef float f32x2_t_ __attribute__((ext_vector_type(2))); typedef __bf16 bf16x2_t_ __attribute__((ext_vector_type(2)));
DI unsigned cvt2(float lo, float hi) { f32x2_t_ v = {lo, hi}; bf16x2_t_ b = __builtin_convertvector(v, bf16x2_t_); return __builtin_bit_cast(unsigned, b); }
DI u32x4 pack8(f32x4 a, f32x4 b) { u32x4 w; w.x = cvt2(a[0], a[1]); w.y = cvt2(a[2], a[3]); w.z = cvt2(b[0], b[1]); w.w = cvt2(b[2], b[3]); return w; }
DI float shx(float v, int lane, int m) { return __int_as_float(__builtin_amdgcn_ds_bpermute((lane ^ m) << 2, __float_as_int(v))); }
DI float sigf(float x) { return __builtin_amdgcn_rcpf(1.f + __expf(-x)); }
DI int epi_lane() { int lane; asm volatile("v_mbcnt_lo_u32_b32 %0, -1, 0\n\tv_mbcnt_hi_u32_b32 %0, -1, %0" : "=v"(lane)); return lane; }
DI float bflo(unsigned w) { return __uint_as_float(w << 16); }
DI float bfhi(unsigned w) { return __uint_as_float(w & 0xffff0000u); }

DI int win_rowmap(int c) {
    if (c < 512) return A_AQ + c;
    if (c < 1280) return A_AKV + c - 512;
    if (c < 1304) return LDA + VB_GATE + c - 1280;
    if (c < 1816) return LDA + B_ZA + c - 1304;
    if (c < 2200) return A_BCQ + c - 1816;
    if (c < 2328) return A_BCKV + c - 2200;
    if (c < 2360) return A_BKR + c - 2328;
    if (c < 2872) return LDA + B_ZB + c - 2360;
    if (c < 7480) return A_CQKV + c - 2872;
    if (c < 7992) return LDA + B_ZC + c - 7480;
    return LDA + VB_MG + c - 7992;
}
constexpr int WIN_VALID = LDA + VB_GATE + 24;

using pg8::Unit;
struct EpiWin { static constexpr bool PERM = true, AFTER_DRAIN = false;
    bf16_t* ua; bf16_t* ub; const float* tab;
    DI void operator()(const f32x4 (&acc)[2][2][4][2], const Unit& u, int wr, int wc, int, int) const {
        const int tl_ = epi_lane(); const int fr = tl_ & 15, fq = tl_ >> 4;
        const int lane = fr + 16 * fq;
        float rsr[8];
        { extern __shared__ __attribute__((aligned(16))) unsigned char lds_raw_w[];
          PG8_LAS const float* rsl = (PG8_LAS const float*)((PG8_LAS unsigned char*)lds_raw_w + LDSCTL_OFF + 8192) + (u.pm & 7) * 256 + wr * 64 + fr;
#pragma unroll
          for (int i = 0; i < 8; ++i) rsr[i] = rsl[(i >> 2) * 128 + (i & 3) * 16]; }
#pragma unroll
        for (int bj = 0; bj < 2; ++bj) {
            const int c32 = u.pn * 256 + bj * 128 + wc * 32;
            const int n0 = c32 + 8 * fq;
            int kind = 0;
            if (c32 < 512) kind = ((c32 & 63) == 0) ? 1 : 0;
            else if (c32 < 1280) kind = (((((c32 - 512) >> 7) & 1) == 0) && ((c32 & 63) == 0)) ? 1 : 0;
            else if (c32 >= A_BKR && c32 < A_CQKV) kind = 2;
            else if (c32 >= A_CQKV && c32 < LDA) { const int cc = c32 - A_CQKV; kind = (((cc % 1536) < 1024) && ((cc & 63) == 0)) ? 1 : 0; }
            bf16_t* dst; int ld;
            const int cb = c32 - LDA;
            const bool is_mg = cb >= VB_MG && cb < VB_GATE;
            if (n0 < LDA) { dst = ua + n0; ld = LDA; } else if (cb < VB_MG) { dst = ub + (n0 - LDA); ld = LDB; } else { dst = ub + B_GATE + (n0 - LDA - VB_GATE); ld = LDB; }
            if (is_mg) { dst = (bf16_t*)((unsigned char*)ub + B_MG8 + (n0 - LDA - VB_MG)); ld = LDB; }
            const bool wr_ok = n0 < WIN_VALID;
            const float qs = (c32 < 512 || (c32 >= A_CQKV && c32 < LDA && ((c32 - A_CQKV) % 1536) < 512)) ? 0.125f * 1.4426950408889634f : 1.f;
#pragma unroll
            for (int ai = 0; ai < 2; ++ai)
#pragma unroll
                for (int m = 0; m < 4; ++m) { __builtin_amdgcn_sched_barrier(0);
                    const int row = u.pm * 256 + ai * 128 + wr * 64 + m * 16 + fr;
                    f32x4 v0 = acc[ai][bj][m][0] * (rsr[ai * 4 + m] * qs), v1 = acc[ai][bj][m][1] * (rsr[ai * 4 + m] * qs);
                    if (kind == 1) {
                        f32x4 p0, p1;
#pragma unroll
                        for (int e = 0; e < 4; ++e) { p0[e] = shx(v0[e], lane, 16); p1[e] = shx(v1[e], lane, 16); }
                        if (fq < 2) {
                            const float* tb = tab + (size_t)row * 48;
                            const f32x4 c0 = *(const f32x4*)(tb), c1 = *(const f32x4*)(tb + 4), s0 = *(const f32x4*)(tb + 8), s1 = *(const f32x4*)(tb + 12);
                            const float sg = (fq == 0) ? -1.f : 1.f;
                            v0 = v0 * c0 + sg * (p0 * s0); v1 = v1 * c1 + sg * (p1 * s1);
                        }
                    } else if (kind == 2) {
                        f32x4 p0, p1;
#pragma unroll
                        for (int e = 0; e < 4; ++e) { p0[e] = shx(v0[e], lane, 32); p1[e] = shx(v1[e], lane, 32); }
                        const float* tb = tab + (size_t)row * 48 + 16 + (fq & 1) * 8;
                        const f32x4 c0 = *(const f32x4*)(tb), c1 = *(const f32x4*)(tb + 4), s0 = *(const f32x4*)(tb + 16), s1 = *(const f32x4*)(tb + 20);
                        const float sg = (fq < 2) ? -1.f : 1.f;
                        v0 = v0 * c0 + sg * (p0 * s0); v1 = v1 * c1 + sg * (p1 * s1);
                    }
                    if (is_mg) { int w0 = 0, w1 = 0;
#pragma unroll
                        for (int e = 0; e < 4; ++e) { v0[e] = __builtin_amdgcn_fmed3f(v0[e], -448.f, 448.f); v1[e] = __builtin_amdgcn_fmed3f(v1[e], -448.f, 448.f); }
                        w0 = __builtin_amdgcn_cvt_pk_fp8_f32(v0[0], v0[1], w0, false); w0 = __builtin_amdgcn_cvt_pk_fp8_f32(v0[2], v0[3], w0, true);
                        w1 = __builtin_amdgcn_cvt_pk_fp8_f32(v1[0], v1[1], w1, false); w1 = __builtin_amdgcn_cvt_pk_fp8_f32(v1[2], v1[3], w1, true);
                        *(unsigned long long*)(dst + (size_t)row * ld) = (unsigned long long)(unsigned)w0 | ((unsigned long long)(unsigned)w1 << 32); }
                    else if (wr_ok) *(u32x4*)(dst + (size_t)row * ld) = pack8(v0, v1);
                }
        }
    }
};
struct EpiQm { static constexpr bool PERM = true, AFTER_DRAIN = false;
    bf16_t* qm; const float* tab;
    DI void operator()(const f32x4 (&acc)[2][2][4][2], const Unit& u, int wr, int wc, int, int) const {
        const int tl_ = epi_lane(); const int fr = tl_ & 15, fq = tl_ >> 4;
        const int lane = fr + 16 * fq;
#pragma unroll
        for (int bj = 0; bj < 2; ++bj) {
            const int c32 = u.pn * 256 + bj * 128 + wc * 32;
            const int n0 = c32 + 8 * fq;
            const bool rope = ((c32 >> 5) % 3) == 2;
#pragma unroll
            for (int ai = 0; ai < 2; ++ai) {
                f32x4 tc0[4], tc1[4], ts0[4], ts1[4];
                if (rope) {
#pragma unroll
                    for (int m = 0; m < 4; ++m) { const float* tb = tab + (size_t)(u.pm * 256 + ai * 128 + wr * 64 + m * 16 + fr) * 48 + 16 + (fq & 1) * 8;
                        tc0[m] = *(const f32x4*)(tb); tc1[m] = *(const f32x4*)(tb + 4); ts0[m] = *(const f32x4*)(tb + 16); ts1[m] = *(const f32x4*)(tb + 20); }
                }
#pragma unroll
                for (int m = 0; m < 4; ++m) {
                    const int row = u.pm * 256 + ai * 128 + wr * 64 + m * 16 + fr;
                    f32x4 v0 = acc[ai][bj][m][0] * (0.10206207261596577f * 1.4426950408889634f), v1 = acc[ai][bj][m][1] * (0.10206207261596577f * 1.4426950408889634f);
                    if (rope) {
                        f32x4 p0, p1;
#pragma unroll
                        for (int e = 0; e < 4; ++e) { p0[e] = shx(v0[e], lane, 32); p1[e] = shx(v1[e], lane, 32); }
                        const float sg = (fq < 2) ? -1.f : 1.f;
                        v0 = v0 * tc0[m] + sg * (p0 * ts0[m]); v1 = v1 * tc1[m] + sg * (p1 * ts1[m]);
                    }
                    *(u32x4*)(qm + (size_t)row * 768 + n0) = pack8(v0, v1);
                }
            }
        }
    }
};
struct EpiBfPlain { static constexpr bool PERM = true, AFTER_DRAIN = false;
    bf16_t* c; int ldc; int pad;
    DI void operator()(const f32x4 (&acc)[2][2][4][2], const Unit& u, int wr, int wc, int, int) const {
        const int tl_ = epi_lane(); const int fr = tl_ & 15, fq = tl_ >> 4;
#pragma unroll
        for (int bj = 0; bj < 2; ++bj) { const int n0 = u.pn * 256 + bj * 128 + wc * 32 + 8 * fq;
#pragma unroll
            for (int ai = 0; ai < 2; ++ai)
#pragma unroll
                for (int m = 0; m < 4; ++m) { __builtin_amdgcn_sched_barrier(0); const int row = u.pm * 256 + ai * 128 + wr * 64 + m * 16 + fr;
                    *(u32x4*)(c + (size_t)row * ldc + n0) = pack8(acc[ai][bj][m][0], acc[ai][bj][m][1]); } }
    }
};
template <int ACT  > struct EpiF32 { static constexpr bool PERM = true, AFTER_DRAIN = false;
    float* c; int ldc; int pnmask;
    DI void operator()(const f32x4 (&acc)[2][2][4][2], const Unit& u, int wr, int wc, int, int) const {
        const int tl_ = epi_lane(); const int fr = tl_ & 15, fq = tl_ >> 4;
#pragma unroll
        for (int bj = 0; bj < 2; ++bj) { const int n0 = (u.pn & pnmask) * 256 + bj * 128 + wc * 32 + 8 * fq;
#pragma unroll
            for (int ai = 0; ai < 2; ++ai)
#pragma unroll
                for (int m = 0; m < 4; ++m) { __builtin_amdgcn_sched_barrier(0); const int row = u.pm * 256 + ai * 128 + wr * 64 + m * 16 + fr;
                    f32x4 v0 = acc[ai][bj][m][0], v1 = acc[ai][bj][m][1];
                    if (ACT == 1) {
#pragma unroll
                        for (int e = 0; e < 4; ++e) { v0[e] = v0[e] * sigf(v0[e]); v1[e] = v1[e] * sigf(v1[e]); } }
                    float* p = c + (size_t)row * ldc + n0; *(f32x4*)p = v0; *(f32x4*)(p + 4) = v1; } }
    }
};
struct EpiYabc { static constexpr bool PERM = true, AFTER_DRAIN = false;
    bf16_t* ymixb; const bf16_t* ub;
    DI void operator()(const f32x4 (&acc)[2][2][4][2], const Unit& u, int wr, int wc, int, int) const {
        const int tl_ = epi_lane(); const int fr = tl_ & 15, fq = tl_ >> 4;
        const int x = u.pm >> 6, pm = u.pm & 63, pn = u.pn & 3;
        const int row0 = pm * 256 + wr * 64 + fr, n00 = pn * 256 + wc * 32 + 8 * fq;
        unsigned long long g8[2][2][4];
#pragma unroll
        for (int bj = 0; bj < 2; ++bj)
#pragma unroll
            for (int ai = 0; ai < 2; ++ai)
#pragma unroll
                for (int m = 0; m < 4; ++m) g8[bj][ai][m] = *(const unsigned long long*)((const unsigned char*)ub + (size_t)(row0 + ai * 128 + m * 16) * (LDB * 2) + B_MG8 + x * 1024 + n00 + bj * 128);
        f32x4 v[2][2][4][2];
#pragma unroll
        for (int bj = 0; bj < 2; ++bj)
#pragma unroll
            for (int ai = 0; ai < 2; ++ai)
#pragma unroll
                for (int m = 0; m < 4; ++m) { const int glo = (int)(unsigned)g8[bj][ai][m], ghi = (int)(unsigned)(g8[bj][ai][m] >> 32);
                    f32x4 g0, g1; g0[0] = sigf(__builtin_amdgcn_cvt_f32_fp8(glo, 0)); g0[1] = sigf(__builtin_amdgcn_cvt_f32_fp8(glo, 1)); g0[2] = sigf(__builtin_amdgcn_cvt_f32_fp8(glo, 2)); g0[3] = sigf(__builtin_amdgcn_cvt_f32_fp8(glo, 3));
                    g1[0] = sigf(__builtin_amdgcn_cvt_f32_fp8(ghi, 0)); g1[1] = sigf(__builtin_amdgcn_cvt_f32_fp8(ghi, 1)); g1[2] = sigf(__builtin_amdgcn_cvt_f32_fp8(ghi, 2)); g1[3] = sigf(__builtin_amdgcn_cvt_f32_fp8(ghi, 3));
                    v[bj][ai][m][0] = acc[ai][bj][m][0] * g0; v[bj][ai][m][1] = acc[ai][bj][m][1] * g1; }
        if (x > 0) {
            u32x4 gw[2][2][4];
#pragma unroll
            for (int bj = 0; bj < 2; ++bj)
#pragma unroll
                for (int ai = 0; ai < 2; ++ai)
#pragma unroll
                    for (int m = 0; m < 4; ++m) gw[bj][ai][m] = *(const u32x4*)(ymixb + (size_t)(row0 + ai * 128 + m * 16) * D + n00 + bj * 128);
#pragma unroll
            for (int bj = 0; bj < 2; ++bj)
#pragma unroll
                for (int ai = 0; ai < 2; ++ai)
#pragma unroll
                    for (int m = 0; m < 4; ++m) { const u32x4 q = gw[bj][ai][m];
                        v[bj][ai][m][0][0] += bflo(q.x); v[bj][ai][m][0][1] += bfhi(q.x); v[bj][ai][m][0][2] += bflo(q.y); v[bj][ai][m][0][3] += bfhi(q.y);
                        v[bj][ai][m][1][0] += bflo(q.z); v[bj][ai][m][1][1] += bfhi(q.z); v[bj][ai][m][1][2] += bflo(q.w); v[bj][ai][m][1][3] += bfhi(q.w); }
        }
#pragma unroll
        for (int bj = 0; bj < 2; ++bj)
#pragma unroll
            for (int ai = 0; ai < 2; ++ai)
#pragma unroll
                for (int m = 0; m < 4; ++m) *(u32x4*)(ymixb + (size_t)(row0 + ai * 128 + m * 16) * D + n00 + bj * 128) = pack8(v[bj][ai][m][0], v[bj][ai][m][1]);
    }
};
struct EpiPlgF { static constexpr bool PERM = true, AFTER_DRAIN = false;
    const bf16_t* xh; float* xo; const bf16_t* e; bf16_t* xb2; float* ssq;
    DI void operator()(const f32x4 (&acc)[2][2][4][2], const Unit& u, int wr, int wc, int, int) const {
        const int tl_ = epi_lane(); const int fr = tl_ & 15, fq = tl_ >> 4;
        extern __shared__ __attribute__((aligned(16))) unsigned char lds_raw_e[];
        PG8_LAS float* red = (PG8_LAS float*)((PG8_LAS unsigned char*)lds_raw_e + LDSCTL_OFF + 4096);
        const int n00 = u.pn * 256 + wc * 32 + 8 * fq;
#pragma unroll
        for (int ai = 0; ai < 2; ++ai) {
            u32x4 ew[4][2], xw[4][2];
#pragma unroll
            for (int m = 0; m < 4; ++m)
#pragma unroll
                for (int bj = 0; bj < 2; ++bj) { const size_t o = (size_t)(u.pm * 256 + ai * 128 + wr * 64 + m * 16 + fr) * D + n00 + bj * 128;
                    ew[m][bj] = *(const u32x4*)(e + o); xw[m][bj] = *(const u32x4*)(xh + o); }
#pragma unroll
            for (int m = 0; m < 4; ++m) {
                float sq = 0.f;
#pragma unroll
                for (int bj = 0; bj < 2; ++bj) { const size_t o = (size_t)(u.pm * 256 + ai * 128 + wr * 64 + m * 16 + fr) * D + n00 + bj * 128;
                    const f32x4 v0 = acc[ai][bj][m][0], v1 = acc[ai][bj][m][1]; const u32x4 w = ew[m][bj], xq = xw[m][bj];
                    const f32x4 e0 = {bflo(w.x), bfhi(w.x), bflo(w.y), bfhi(w.y)}, e1 = {bflo(w.z), bfhi(w.z), bflo(w.w), bfhi(w.w)};
                    f32x4 x0 = {bflo(xq.x), bfhi(xq.x), bflo(xq.y), bfhi(xq.y)}, x1 = {bflo(xq.z), bfhi(xq.z), bflo(xq.w), bfhi(xq.w)};
#pragma unroll
                    for (int k = 0; k < 4; ++k) { x0[k] += sigf(v0[k]) * e0[k]; x1[k] += sigf(v1[k]) * e1[k]; sq += x0[k] * x0[k] + x1[k] * x1[k]; }
                    if (xo) { *(f32x4*)(xo + o) = x0; *(f32x4*)(xo + o + 4) = x1; }
                    *(u32x4*)(xb2 + o) = pack8(x0, x1); }
                sq += shx(sq, tl_, 16); sq += shx(sq, tl_, 32);
                if (fq == 0) red[(ai * 128 + wr * 64 + m * 16 + fr) * 4 + wc] = sq;
            }
            __builtin_amdgcn_sched_barrier(0);
        }
        asm volatile("s_waitcnt lgkmcnt(0)" ::: "memory"); __builtin_amdgcn_s_barrier(); asm volatile("" ::: "memory");
        { const int t = (wr * 4 + wc) * 64 + tl_;
          if (t < 256) { const f32x4 q = *(PG8_LAS const f32x4*)(red + 4 * t); ssq[(size_t)(u.pm * 256 + t) * 4 + u.pn] = (q[0] + q[1]) + (q[2] + q[3]); } }
    }
};
struct EpiPost { static constexpr bool PERM = true, AFTER_DRAIN = false;
    const bf16_t* xsrc; const float* g; bf16_t* hb; unsigned long long* gran; unsigned epoch; int pad;
    DI void operator()(const f32x4 (&acc)[2][2][4][2], const Unit& u, int wr, int wc, int, int) const {
        const int tl_ = epi_lane(); const int fr = tl_ & 15, fq = tl_ >> 4;
        extern __shared__ __attribute__((aligned(16))) unsigned char lds_raw_p[];
        PG8_LAS float* red = (PG8_LAS float*)((PG8_LAS unsigned char*)lds_raw_p + LDSCTL_OFF + 4096);
        PG8_LAS float* rsl = red + 1024;
#pragma unroll
        for (int ai = 0; ai < 2; ++ai)
#pragma unroll
            for (int m = 0; m < 4; ++m) { float sq = 0.f;
#pragma unroll
                for (int bj = 0; bj < 2; ++bj) { const f32x4 v0 = acc[ai][bj][m][0], v1 = acc[ai][bj][m][1];
                    sq += ((v0[0] * v0[0] + v0[1] * v0[1]) + (v0[2] * v0[2] + v0[3] * v0[3])) + ((v1[0] * v1[0] + v1[1] * v1[1]) + (v1[2] * v1[2] + v1[3] * v1[3])); }
                sq += shx(sq, tl_, 16); sq += shx(sq, tl_, 32);
                if (fq == 0) red[(ai * 128 + wr * 64 + m * 16 + fr) * 4 + wc] = sq; }
        asm volatile("s_waitcnt lgkmcnt(0)" ::: "memory"); __builtin_amdgcn_s_barrier(); asm volatile("" ::: "memory");
        { const int t = (wr * 4 + wc) * 64 + tl_;
          if (t < 256) {
              const f32x4 q = *(PG8_LAS const f32x4*)(red + 4 * t); const float part = (q[0] + q[1]) + (q[2] + q[3]);
              typedef __attribute__((address_space(1))) unsigned long long gu64_t;
              gu64_t* gp = (gu64_t*)gran + (size_t)(u.pm * 256 + t) * 4;
              __hip_atomic_store(gp + u.pn, ((unsigned long long)epoch << 32) | (unsigned long long)__float_as_uint(part), __ATOMIC_RELAXED, __HIP_MEMORY_SCOPE_AGENT);
              float tot = 0.f;
              for (unsigned spin = 0; spin < (1u << 20); ++spin) {
                  const unsigned long long a0 = __hip_atomic_load(gp + 0, __ATOMIC_RELAXED, __HIP_MEMORY_SCOPE_AGENT), a1 = __hip_atomic_load(gp + 1, __ATOMIC_RELAXED, __HIP_MEMORY_SCOPE_AGENT);
                  const unsigned long long a2 = __hip_atomic_load(gp + 2, __ATOMIC_RELAXED, __HIP_MEMORY_SCOPE_AGENT), a3 = __hip_atomic_load(gp + 3, __ATOMIC_RELAXED, __HIP_MEMORY_SCOPE_AGENT);
                  tot = (__uint_as_float((unsigned)a0) + __uint_as_float((unsigned)a1)) + (__uint_as_float((unsigned)a2) + __uint_as_float((unsigned)a3));
                  if ((unsigned)(a0 >> 32) == epoch && (unsigned)(a1 >> 32) == epoch && (unsigned)(a2 >> 32) == epoch && (unsigned)(a3 >> 32) == epoch) break;
                  __builtin_amdgcn_s_sleep(2);
              }
              rsl[t] = rsqrtf(tot * (1.f / 1024.f) + 1e-6f);
          } }
        asm volatile("s_waitcnt lgkmcnt(0)" ::: "memory"); __builtin_amdgcn_s_barrier(); asm volatile("" ::: "memory");
        const int n00 = u.pn * 256 + wc * 32 + 8 * fq;
        f32x4 gg[2][2];
#pragma unroll
        for (int bj = 0; bj < 2; ++bj) { gg[bj][0] = *(const f32x4*)(g + n00 + bj * 128); gg[bj][1] = *(const f32x4*)(g + n00 + bj * 128 + 4); }
        u32x4 xw[2][4][2];
#pragma unroll
        for (int ai = 0; ai < 2; ++ai)
#pragma unroll
            for (int m = 0; m < 4; ++m)
#pragma unroll
                for (int bj = 0; bj < 2; ++bj) xw[ai][m][bj] = *(const u32x4*)(xsrc + (size_t)(u.pm * 256 + ai * 128 + wr * 64 + m * 16 + fr) * D + n00 + bj * 128);
#pragma unroll
        for (int ai = 0; ai < 2; ++ai)
#pragma unroll
            for (int m = 0; m < 4; ++m) { const int rl = ai * 128 + wr * 64 + m * 16 + fr; const float rs = rsl[rl];
#pragma unroll
                for (int bj = 0; bj < 2; ++bj) { const size_t o = (size_t)(u.pm * 256 + rl) * D + n00 + bj * 128; const u32x4 w = xw[ai][m][bj];
                    const f32x4 xa = {bflo(w.x), bfhi(w.x), bflo(w.y), bfhi(w.y)}, xb = {bflo(w.z), bfhi(w.z), bflo(w.w), bfhi(w.w)};
                    const f32x4 x0 = xa + acc[ai][bj][m][0] * rs * gg[bj][0], x1 = xb + acc[ai][bj][m][1] * rs * gg[bj][1];
                    *(u32x4*)(hb + o) = pack8(x0, x1); } }
    }
};
struct YabcOrder {
    int G, vcu;
    DI bool next(int i, Unit& u) const { const int tile = (i / 3) * G + vcu, x = i % 3; if (tile >= 256) return false; u.pm = x * 64 + (tile >> 2); u.pn = x * 4 + (tile & 3); return true; }
    DI void a_ready(const Unit&) const {}
    DI void done(const Unit&) const {}
};
struct HidOrder {
    int G, c;
    DI bool next(int i, Unit& u) const { const int id = c - (G - 64); if (i > 0 || id < 0) return false; u.pm = (id >> 3) * 8 + (id & 7); u.pn = id >> 3; return true; }
    DI void a_ready(const Unit&) const {}
    DI void done(const Unit&) const {}
};
DI void tr_item(const float* W, int K, int N, bf16_t* WT, LAS unsigned char* scr, int item, int lane, bool perm, const float* gk) {
    const int nblk = (N + 63) / 64, kb = item / nblk, nb = item % nblk, k0 = 64 * kb, n0 = 64 * nb;
    const int nn = n0 + lane; const bool ok = nn < N;
    const float* wp = W + (size_t)k0 * N + (ok ? nn : 0);
    float v[64];
#pragma unroll
    for (int i = 0; i < 64; ++i) v[i] = wp[(size_t)i * N];
#pragma unroll
    for (int i = 0; i < 32; ++i) { const float g0 = gk ? gk[k0 + 2 * i] : 1.f, g1 = gk ? gk[k0 + 2 * i + 1] : 1.f;
        *(LAS unsigned*)(scr + lane * 132 + 4 * i) = ok ? pk2(v[2 * i] * g0, v[2 * i + 1] * g1) : 0u; }
    asm volatile("s_waitcnt lgkmcnt(0)" ::: "memory");
    const int c = lane & 7;
#pragma unroll
    for (int j = 0; j < 8; ++j) { const int n = (lane >> 3) + 8 * j; LAS const unsigned* s = (LAS const unsigned*)(scr + n * 132 + 16 * c);
        u32x4 o; o.x = s[0]; o.y = s[1]; o.z = s[2]; o.w = s[3];
        if (n0 + n < N) { const int rr = perm ? win_rowmap(n0 + n) : (n0 + n); *(u32x4*)(WT + (size_t)rr * K + k0 + 8 * c) = o; } }
    asm volatile("s_waitcnt lgkmcnt(0)" ::: "memory");
}
struct RmIdent { int off; DI int operator()(int n) const { return off + n; } };
struct RmWin { DI int operator()(int n) const { return win_rowmap(n); } };

DI float wsum(float v, int lane) {
#pragma unroll
    for (int o = 1; o < 64; o <<= 1) v += shx(v, lane, o);
    return v;
}
DI void rms_row_f32(const float* xrow, const float* g, bf16_t* orow, int lane) {
    const f32x4* xr = (const f32x4*)xrow + lane; const f32x4* gr = (const f32x4*)g + lane;
    f32x4 v[4]; float s = 0.f;
#pragma unroll
    for (int j = 0; j < 4; ++j) { v[j] = xr[64 * j]; s += (v[j][0] * v[j][0] + v[j][1] * v[j][1]) + (v[j][2] * v[j][2] + v[j][3] * v[j][3]); }
    const float rs = rsqrtf(wsum(s, lane) * (1.f / 1024.f) + 1e-6f);
    unsigned long long* o8 = (unsigned long long*)orow + lane;
#pragma unroll
    for (int j = 0; j < 4; ++j) { const f32x4 gg = gr[64 * j];
        o8[64 * j] = (unsigned long long)pk2(v[j][0] * rs * gg[0], v[j][1] * rs * gg[1]) | ((unsigned long long)pk2(v[j][2] * rs * gg[2], v[j][3] * rs * gg[3]) << 32); }
}

constexpr int CI_IN = 16 * 173, CI_UQ = 6 * 12, CI_UKV = 2 * 16, CI_W1 = 32 * 4, CI_ABC = 8 * 16, CI_OUT = 16 * 16, CI_PLE = 4 * 16;
constexpr int CI_NTR = CI_IN + CI_UQ + CI_UKV + 2 * CI_W1 + 3 * CI_ABC + 2 * CI_OUT + CI_PLE;
constexpr int CB_TOTAL = 256;
static_assert(CI_NTR <= CB_TOTAL * 16 && T * 256 / 8 == CB_TOTAL * 2048 && (NPAD - WIN_VALID) * 1024 / 8 == CB_TOTAL * 100, "conversion work splits evenly");
typedef __attribute__((address_space(4))) const char* kptr2_t;
DI const float* conv_in(int idx) { kptr2_t p = (kptr2_t)__builtin_amdgcn_kernarg_segment_ptr(); asm volatile("" : "+s"(p)); typedef const float* fp_t; return *(__attribute__((address_space(4))) const fp_t*)(p + 8 * idx); }
DI void conv_block_item(LAS unsigned char* lds, int tid, int bi, int Lc, unsigned char* wset) {
    const int lane = tid & 63, wave = __builtin_amdgcn_readfirstlane(tid >> 6);
    {
        const float* ps = conv_in(1) + (size_t)Lc * T * 256; bf16_t* PBF = (bf16_t*)(wset + WO_PBF);
#pragma unroll
        for (int q = 0; q < 4; ++q) { const size_t i = (size_t)bi * 2048 + q * 512 + tid;
            const f32x4 a = *(const f32x4*)(ps + i * 8), b = *(const f32x4*)(ps + i * 8 + 4);
            u32x4 w; w.x = pk2(a[0], a[1]); w.y = pk2(a[2], a[3]); w.z = pk2(b[0], b[1]); w.w = pk2(b[2], b[3]); *(u32x4*)(PBF + i * 8) = w; }
        if (tid < 100) { unsigned z0 = 0u; asm volatile("" : "+v"(z0)); const u32x4 z = {z0, z0, z0, z0};
            *(u32x4*)((bf16_t*)(wset + WO_WIN) + (size_t)WIN_VALID * 1024 + ((size_t)bi * 100 + tid) * 8) = z; }
    }
    LAS unsigned char* scr = lds + wave * 16384;
#pragma unroll 1
    for (int q = 0; q < 2; ++q) {
        int r = bi * 16 + q * 8 + wave; if (r >= CI_NTR) break;
        int widx; size_t soff, doff; int K_, N_; bool perm = false;
        if (r < CI_IN) { widx = 5; soff = (size_t)Lc * D * DIN; doff = WO_WIN; K_ = D; N_ = DIN; perm = true; }
        else if ((r -= CI_IN) < CI_UQ) { widx = 11; soff = (size_t)Lc * 384 * 768; doff = WO_WUQ; K_ = 384; N_ = 768; }
        else if ((r -= CI_UQ) < CI_UKV) { widx = 13; soff = (size_t)Lc * 128 * 1024; doff = WO_WUKV; K_ = 128; N_ = 1024; }
        else if ((r -= CI_UKV) < 2 * CI_W1) { const int kv = r / CI_W1; r %= CI_W1; const int ks = r / 32;
            widx = 7; soff = ((size_t)Lc * 2 + kv) * 2048 * 256 + (size_t)ks * 512 * 256; doff = WO_W1 + (size_t)(ks * 2 + kv) * 256 * 512 * 2; K_ = 512; N_ = 256; r %= 32; }
        else if ((r -= 2 * CI_W1) < 3 * CI_ABC) { const int x = r / CI_ABC; r %= CI_ABC; widx = (x == 0) ? 9 : (x == 1) ? 14 : 15; soff = (size_t)Lc * 512 * D; doff = WO_WABC + (size_t)x * 1024 * 512 * 2; K_ = 512; N_ = D; }
        else if ((r -= 3 * CI_ABC) < CI_OUT) { widx = 16; soff = (size_t)Lc * D * D; doff = WO_WOUT; K_ = D; N_ = D; }
        else if ((r -= CI_OUT) < CI_OUT) { widx = 18; soff = (size_t)Lc * D * D; doff = WO_WPLG; K_ = D; N_ = D; }
        else { r -= CI_OUT; widx = 17; soff = (size_t)Lc * 256 * D; doff = WO_WPLE; K_ = 256; N_ = D; }
        tr_item(conv_in(widx) + soff, K_, N_, (bf16_t*)(wset + doff), scr, r, lane, perm, perm ? conv_in(3) + (size_t)Lc * D : nullptr);
    }
}

namespace fa {
typedef short bf16x8 __attribute__((ext_vector_type(8)));
typedef float f32x16 __attribute__((ext_vector_type(16)));
typedef short v4i16 __attribute__((ext_vector_type(4)));
constexpr int KCS = 1040, VPS = 1040;
constexpr int KBUF = 0, KBUF_SZ = 12800, VBUF = 25600, VBUF_SZ = 8448, OVBUF = 42496, IMP_OFF = 51200, IMP_LD = 65, SELM_OFF = IMP_OFF + 4 * 64 * IMP_LD * 4, UNI_OFF = SELM_OFF + 512, WQ_OFF = UNI_OFF + 64, PM_OFF = WQ_OFF + 16;
static_assert(WQ_OFF + 64 <= 131072, "attention LDS map");
constexpr float LOG2E = 1.4426950408889634f;

DI int crow(int r, int hi) { return (r & 3) + 8 * (r >> 2) + 4 * hi; }
DI float xhalf_max(float v) { auto rr = __builtin_amdgcn_permlane32_swap(__float_as_uint(v), __float_as_uint(v), false, false); return fmaxf(__uint_as_float(rr[0]), __uint_as_float(rr[1])); }
DI float xhalf_sum(float v) { auto rr = __builtin_amdgcn_permlane32_swap(__float_as_uint(v), __float_as_uint(v), false, false); return __uint_as_float(rr[0]) + __uint_as_float(rr[1]); }
typedef float f32x2_t __attribute__((ext_vector_type(2))); typedef __bf16 bf16x2_t __attribute__((ext_vector_type(2)));
DI unsigned cvtpk(float lo, float hi) { f32x2_t v = {lo, hi}; bf16x2_t b = __builtin_convertvector(v, bf16x2_t); return __builtin_bit_cast(unsigned, b); }

struct St { f32x16 o[2]; f32x16 ol; float m; };
DI void st_init(St& s) {
#pragma unroll
    for (int i = 0; i < 16; ++i) { s.o[0][i] = 0.f; s.o[1][i] = 0.f; s.ol[i] = 0.f; }
    s.m = -1e30f;
}

template <int NQ> DI void qk_tile(f32x16& p0, f32x16& p1, LAS const unsigned char* kt, const bf16x8 (&qf)[NQ], int r32, int hi, const f32x16& ci) {
    LAS const unsigned char* kb = kt + hi * KCS + r32 * 16;
    bf16x8 kf[2 * NQ];
#pragma unroll
    for (int d0 = 0; d0 < NQ; ++d0) { kf[2 * d0] = *(LAS const bf16x8*)(kb + d0 * 2 * KCS); kf[2 * d0 + 1] = *(LAS const bf16x8*)(kb + d0 * 2 * KCS + 512); }
    __builtin_amdgcn_sched_barrier(0);
    p0 = __builtin_amdgcn_mfma_f32_32x32x16_bf16(kf[0], qf[0], ci, 0, 0, 0);
    p1 = __builtin_amdgcn_mfma_f32_32x32x16_bf16(kf[1], qf[0], ci, 0, 0, 0);
#pragma unroll
    for (int d0 = 1; d0 < NQ; ++d0) {
        p0 = __builtin_amdgcn_mfma_f32_32x32x16_bf16(kf[2 * d0], qf[d0], p0, 0, 0, 0);
        p1 = __builtin_amdgcn_mfma_f32_32x32x16_bf16(kf[2 * d0 + 1], qf[d0], p1, 0, 0, 0);
    }
    __builtin_amdgcn_sched_barrier(0);
}
template <int NQ> DI void qk_tile_lean(f32x16& p0, f32x16& p1, LAS const unsigned char* kt, const bf16x8 (&qf)[NQ], int r32, int hi, const f32x16& ci) {
    LAS const unsigned char* kb = kt + hi * KCS + r32 * 16;
#pragma unroll
    for (int d0 = 0; d0 < NQ; ++d0) {
        const bf16x8 k0 = *(LAS const bf16x8*)(kb + d0 * 2 * KCS), k1 = *(LAS const bf16x8*)(kb + d0 * 2 * KCS + 512);
        __builtin_amdgcn_sched_barrier(0);
        if (d0 == 0) { p0 = __builtin_amdgcn_mfma_f32_32x32x16_bf16(k0, qf[0], ci, 0, 0, 0); p1 = __builtin_amdgcn_mfma_f32_32x32x16_bf16(k1, qf[0], ci, 0, 0, 0); }
        else { p0 = __builtin_amdgcn_mfma_f32_32x32x16_bf16(k0, qf[d0], p0, 0, 0, 0); p1 = __builtin_amdgcn_mfma_f32_32x32x16_bf16(k1, qf[d0], p1, 0, 0, 0); }
        __builtin_amdgcn_sched_barrier(0);
    }
}
template <bool MMASUM = true> DI float softmax_tile(St& s, f32x16& p0, f32x16& p1, float c, bf16x8 (&pa)[4], bool row_on) {
    float mx = fmaxf(p0[0], p1[0]);
#pragma unroll
    for (int i = 1; i < 16; ++i) mx = __builtin_fmaxf(__builtin_fmaxf(p0[i], p1[i]), mx);
    mx = xhalf_max(mx);
    if (!row_on) mx = -INFINITY;
    const float mn = fmaxf(s.m, mx);
    const float alpha = __builtin_amdgcn_exp2f((s.m - mn) * c);
    s.m = mn;
    const float nmc = row_on ? -mn * c : -INFINITY;
#pragma unroll
    for (int i = 0; i < 16; ++i) { p0[i] = __builtin_amdgcn_exp2f(fmaf(p0[i], c, nmc)); p1[i] = __builtin_amdgcn_exp2f(fmaf(p1[i], c, nmc)); }
    if (!__all(alpha == 1.f)) {
#pragma unroll
        for (int i = 0; i < 16; ++i) { s.o[0][i] *= alpha; s.o[1][i] *= alpha; s.ol[i] *= alpha; }
    }
    u32x4 w;
    w.x = cvtpk(p0[0], p0[1]); w.y = cvtpk(p0[2], p0[3]); w.z = cvtpk(p0[4], p0[5]); w.w = cvtpk(p0[6], p0[7]); pa[0] = __builtin_bit_cast(bf16x8, w);
    w.x = cvtpk(p0[8], p0[9]); w.y = cvtpk(p0[10], p0[11]); w.z = cvtpk(p0[12], p0[13]); w.w = cvtpk(p0[14], p0[15]); pa[1] = __builtin_bit_cast(bf16x8, w);
    w.x = cvtpk(p1[0], p1[1]); w.y = cvtpk(p1[2], p1[3]); w.z = cvtpk(p1[4], p1[5]); w.w = cvtpk(p1[6], p1[7]); pa[2] = __builtin_bit_cast(bf16x8, w);
    w.x = cvtpk(p1[8], p1[9]); w.y = cvtpk(p1[10], p1[11]); w.z = cvtpk(p1[12], p1[13]); w.w = cvtpk(p1[14], p1[15]); pa[3] = __builtin_bit_cast(bf16x8, w);
    if constexpr (MMASUM) {
        const bf16x8 ones = {0x3F80, 0x3F80, 0x3F80, 0x3F80, 0x3F80, 0x3F80, 0x3F80, 0x3F80};
#pragma unroll
        for (int ks = 0; ks < 4; ++ks) s.ol = __builtin_amdgcn_mfma_f32_32x32x16_bf16(ones, pa[ks], s.ol, 0, 0, 0);
    } else {
        float sum = 0.f;
#pragma unroll
        for (int i = 0; i < 16; ++i) sum += p0[i] + p1[i];
        s.ol[0] += sum;
    }
    return alpha;
}
template <bool MMASUM> DI void softmax_ref(St& s, f32x16& p0, f32x16& p1, bf16x8 (&pa)[4]) {
#pragma unroll
    for (int i = 0; i < 16; ++i) { p0[i] = __builtin_amdgcn_exp2f(p0[i]); p1[i] = __builtin_amdgcn_exp2f(p1[i]); }
    u32x4 w;
    w.x = cvtpk(p0[0], p0[1]); w.y = cvtpk(p0[2], p0[3]); w.z = cvtpk(p0[4], p0[5]); w.w = cvtpk(p0[6], p0[7]); pa[0] = __builtin_bit_cast(bf16x8, w);
    w.x = cvtpk(p0[8], p0[9]); w.y = cvtpk(p0[10], p0[11]); w.z = cvtpk(p0[12], p0[13]); w.w = cvtpk(p0[14], p0[15]); pa[1] = __builtin_bit_cast(bf16x8, w);
    w.x = cvtpk(p1[0], p1[1]); w.y = cvtpk(p1[2], p1[3]); w.z = cvtpk(p1[4], p1[5]); w.w = cvtpk(p1[6], p1[7]); pa[2] = __builtin_bit_cast(bf16x8, w);
    w.x = cvtpk(p1[8], p1[9]); w.y = cvtpk(p1[10], p1[11]); w.z = cvtpk(p1[12], p1[13]); w.w = cvtpk(p1[14], p1[15]); pa[3] = __builtin_bit_cast(bf16x8, w);
    if constexpr (MMASUM) {
        const bf16x8 ones = {0x3F80, 0x3F80, 0x3F80, 0x3F80, 0x3F80, 0x3F80, 0x3F80, 0x3F80};
#pragma unroll
        for (int ks = 0; ks < 4; ++ks) s.ol = __builtin_amdgcn_mfma_f32_32x32x16_bf16(ones, pa[ks], s.ol, 0, 0, 0);
    } else {
        float sum = 0.f;
#pragma unroll
        for (int i = 0; i < 16; ++i) sum += p0[i] + p1[i];
        s.ol[0] += sum;
    }
}
DI void pv_tile(f32x16 (&o)[2], LAS const unsigned char* vt, const bf16x8 (&pa)[4], int lane) {
    const int hi = lane >> 5;
    LAS const unsigned char* vb = vt + ((lane >> 4) & 1) * 32 + (lane & 3) * 8 + (4 * hi + ((lane & 15) >> 2)) * 64;
#pragma unroll
    for (int d0 = 0; d0 < 2; ++d0) {
        v4i16 lo[4], hv[4];
#pragma unroll
        for (int ks = 0; ks < 4; ++ks) {
            lo[ks] = __builtin_amdgcn_ds_read_tr16_b64_v4i16((LAS v4i16*)(vb + d0 * 4 * VPS + ks * VPS));
            hv[ks] = __builtin_amdgcn_ds_read_tr16_b64_v4i16((LAS v4i16*)(vb + d0 * 4 * VPS + ks * VPS + 512));
        }
        __builtin_amdgcn_sched_barrier(0);
#pragma unroll
        for (int ks = 0; ks < 4; ++ks) {
            const bf16x8 vf = (bf16x8){lo[ks][0], lo[ks][1], lo[ks][2], lo[ks][3], hv[ks][0], hv[ks][1], hv[ks][2], hv[ks][3]};
            o[d0] = __builtin_amdgcn_mfma_f32_32x32x16_bf16(vf, pa[ks], o[d0], 0, 0, 0);
        }
        __builtin_amdgcn_sched_barrier(0);
    }
}
template <int NQ, int VAR = 0> DI void fused_step(f32x16& n0, f32x16& n1, LAS const unsigned char* kt, const bf16x8 (&qf)[NQ], int r32, int hi, const f32x16& ci, f32x16& c0, f32x16& c1,
                                     St& st, LAS const unsigned char* vt, int lane) {
    LAS const unsigned char* kb = kt + hi * KCS + r32 * 16;
    LAS const unsigned char* vb = vt + ((lane >> 4) & 1) * 32 + (lane & 3) * 8 + (4 * hi + ((lane & 15) >> 2)) * 64;
    constexpr int M = 2 * NQ, W = 4, NOP = 64, VG = M - 2;
    bf16x8 kf[M];
    if (!(VAR & 16)) {
#pragma unroll
    for (int g = 0; g < W; ++g) kf[g] = *(LAS const bf16x8*)(kb + (g >> 1) * 2 * KCS + (g & 1) * 512);
    }
    __builtin_amdgcn_sched_barrier(0);
    unsigned pw[16];
    f32x2_t acc = {st.ol[0], st.ol[1]};
    v4i16 lo0[4], hv0[4], lo1[4], hv1[4];
#pragma unroll
    for (int g = 0; g < M; ++g) {
        if (g + W < M && !(VAR & 16)) kf[g + W] = *(LAS const bf16x8*)(kb + ((g + W) >> 1) * 2 * KCS + ((g + W) & 1) * 512);
        if (g == VG && !(VAR & 2)) {
#pragma unroll
            for (int ks = 0; ks < 4; ++ks) {
                lo0[ks] = __builtin_amdgcn_ds_read_tr16_b64_v4i16((LAS v4i16*)(vb + ks * VPS));
                hv0[ks] = __builtin_amdgcn_ds_read_tr16_b64_v4i16((LAS v4i16*)(vb + ks * VPS + 512));
            }
        }
        if (!(VAR & 16)) {
        if (g & 1) n1 = __builtin_amdgcn_mfma_f32_32x32x16_bf16(kf[g], qf[g >> 1], g == 1 ? ci : n1, 0, 0, 0);
        else       n0 = __builtin_amdgcn_mfma_f32_32x32x16_bf16(kf[g], qf[g >> 1], g == 0 ? ci : n0, 0, 0, 0);
        } else if (g < 2) { if (g & 1) n1 = ci; else n0 = ci; }
#pragma unroll
        for (int i = (g * NOP) / M; i < ((g + 1) * NOP) / M; ++i) {
            if (VAR & 1) { if (i < 16) pw[i] = 0x3F803F80u; continue; }
            const int blk = i >> 4, w = i & 15;
            if (w < 8) { const int e = blk * 8 + w;
                if (e < 16) c0[e] = __builtin_amdgcn_exp2f(c0[e]); else c1[e - 16] = __builtin_amdgcn_exp2f(c1[e - 16]); }
            else { const int k = (w & 1) + 2 * ((w - 8) >> 2), e = blk * 8 + 2 * k;
                const float x = (e < 16) ? c0[e] : c1[e - 16], y = (e < 16) ? c0[e + 1] : c1[e - 15];
                if (((w - 8) & 2) == 0) { pw[blk * 4 + k] = cvtpk(x, y); asm volatile("" : "+v"(pw[blk * 4 + k])); }
                else { acc[0] += x; asm volatile("" : "+v"(acc[0])); acc[1] += y; asm volatile("" : "+v"(acc[1])); } }
        }
        __builtin_amdgcn_sched_barrier(0);
    }
    st.ol[0] = acc[0]; st.ol[1] = acc[1];
    bf16x8 pa[4];
#pragma unroll
    for (int b = 0; b < 4; ++b) { u32x4 w; w.x = pw[4 * b]; w.y = pw[4 * b + 1]; w.z = pw[4 * b + 2]; w.w = pw[4 * b + 3]; pa[b] = __builtin_bit_cast(bf16x8, w); }
    if (VAR & 2) return;
#pragma unroll
    for (int ks = 0; ks < 4; ++ks) {
        lo1[ks] = __builtin_amdgcn_ds_read_tr16_b64_v4i16((LAS v4i16*)(vb + 4 * VPS + ks * VPS));
        hv1[ks] = __builtin_amdgcn_ds_read_tr16_b64_v4i16((LAS v4i16*)(vb + 4 * VPS + ks * VPS + 512));
    }
    __builtin_amdgcn_sched_barrier(0);
#pragma unroll
    for (int ks = 0; ks < 4; ++ks) {
        const bf16x8 vf = (bf16x8){lo0[ks][0], lo0[ks][1], lo0[ks][2], lo0[ks][3], hv0[ks][0], hv0[ks][1], hv0[ks][2], hv0[ks][3]};
        st.o[0] = __builtin_amdgcn_mfma_f32_32x32x16_bf16(vf, pa[ks], st.o[0], 0, 0, 0);
    }
    __builtin_amdgcn_sched_barrier(0);
#pragma unroll
    for (int ks = 0; ks < 4; ++ks) {
        const bf16x8 vf = (bf16x8){lo1[ks][0], lo1[ks][1], lo1[ks][2], lo1[ks][3], hv1[ks][0], hv1[ks][1], hv1[ks][2], hv1[ks][3]};
        st.o[1] = __builtin_amdgcn_mfma_f32_32x32x16_bf16(vf, pa[ks], st.o[1], 0, 0, 0);
    }
    __builtin_amdgcn_sched_barrier(0);
}
template <int NQ, int VAR = 0> DI void fused3(f32x16& n0, f32x16& n1, LAS const unsigned char* kt, const bf16x8 (&qf)[NQ], int r32, int hi, const f32x16& ci, f32x16& c0, f32x16& c1,
                                             St& st, bf16x8 (&pa)[4], LAS const unsigned char* vt, int lane) {
    LAS const unsigned char* kb = kt + hi * KCS + r32 * 16;
    LAS const unsigned char* vb = vt + ((lane >> 4) & 1) * 32 + (lane & 3) * 8 + (4 * hi + ((lane & 15) >> 2)) * 64;
    constexpr int MQ = 2 * NQ, MT = MQ + 8, DL = 3, NOP2 = 48;
    bf16x8 kf[MQ];
    v4i16 lo[8], hv[8];
    unsigned pw[16];
    float s0 = st.ol[0], s1 = st.ol[1];
#define F3_FETCH(s) do { if ((s) < MT) { \
        if ((s) < 8) { if (!(VAR & 2)) { const int p_ = (s); lo[p_] = __builtin_amdgcn_ds_read_tr16_b64_v4i16((LAS v4i16*)(vb + (p_ >> 2) * 4 * VPS + (p_ & 3) * VPS)); \
                                                       hv[p_] = __builtin_amdgcn_ds_read_tr16_b64_v4i16((LAS v4i16*)(vb + (p_ >> 2) * 4 * VPS + (p_ & 3) * VPS + 512)); } } \
        else if (!(VAR & 16)) { const int g_ = (s) - 8; kf[g_] = *(LAS const bf16x8*)(kb + (g_ >> 1) * 2 * KCS + (g_ & 1) * 512); } } } while (0)
#pragma unroll
    for (int s = 0; s < DL; ++s) F3_FETCH(s);
    __builtin_amdgcn_sched_barrier(0);
#pragma unroll
    for (int s = 0; s < MT; ++s) {
        F3_FETCH(s + DL);
        if (s < 8) {
            if (!(VAR & 2)) { const int p = s;
                const bf16x8 vf = (bf16x8){lo[p][0], lo[p][1], lo[p][2], lo[p][3], hv[p][0], hv[p][1], hv[p][2], hv[p][3]};
                if (p < 4) st.o[0] = __builtin_amdgcn_mfma_f32_32x32x16_bf16(vf, pa[p & 3], st.o[0], 0, 0, 0);
                else       st.o[1] = __builtin_amdgcn_mfma_f32_32x32x16_bf16(vf, pa[p & 3], st.o[1], 0, 0, 0); }
            if (!(VAR & 1)) {
#pragma unroll
                for (int w = 0; w < 4; ++w) { const int e = 4 * s + w;
                    if (e < 16) c0[e] = __builtin_amdgcn_exp2f(c0[e]); else c1[e - 16] = __builtin_amdgcn_exp2f(c1[e - 16]); }
            }
        } else { const int g = s - 8;
            if (!(VAR & 16)) {
                if (g & 1) n1 = __builtin_amdgcn_mfma_f32_32x32x16_bf16(kf[g], qf[g >> 1], g == 1 ? ci : n1, 0, 0, 0);
                else       n0 = __builtin_amdgcn_mfma_f32_32x32x16_bf16(kf[g], qf[g >> 1], g == 0 ? ci : n0, 0, 0, 0);
            } else if (g < 2) { if (g & 1) n1 = ci; else n0 = ci; }
#pragma unroll
            for (int i = (g * NOP2) / MQ; i < ((g + 1) * NOP2) / MQ; ++i) {
                if (VAR & 1) { if (i < 16) pw[i] = 0x3F803F80u; continue; }
                const int q = i / 3, r = i % 3, e = 2 * q;
                const float x = (e < 16) ? c0[e] : c1[e - 16], y = (e < 16) ? c0[e + 1] : c1[e - 15];
                if (r == 0) { pw[q] = cvtpk(x, y); asm volatile("" : "+v"(pw[q])); }
                else if (r == 1) { s0 += x; asm volatile("" : "+v"(s0)); }
                else { s1 += y; asm volatile("" : "+v"(s1)); }
            }
        }
        __builtin_amdgcn_sched_barrier(0);
    }
#undef F3_FETCH
    st.ol[0] = s0; st.ol[1] = s1;
#pragma unroll
    for (int b = 0; b < 4; ++b) { u32x4 w; w.x = pw[4 * b]; w.y = pw[4 * b + 1]; w.z = pw[4 * b + 2]; w.w = pw[4 * b + 3]; pa[b] = __builtin_bit_cast(bf16x8, w); }
}
DI void softmax_pack(St& st, f32x16& p0, f32x16& p1, bf16x8 (&pa)[4]) {
#pragma unroll
    for (int i = 0; i < 16; ++i) { p0[i] = __builtin_amdgcn_exp2f(p0[i]); p1[i] = __builtin_amdgcn_exp2f(p1[i]); }
    u32x4 w;
    w.x = cvtpk(p0[0], p0[1]); w.y = cvtpk(p0[2], p0[3]); w.z = cvtpk(p0[4], p0[5]); w.w = cvtpk(p0[6], p0[7]); pa[0] = __builtin_bit_cast(bf16x8, w);
    w.x = cvtpk(p0[8], p0[9]); w.y = cvtpk(p0[10], p0[11]); w.z = cvtpk(p0[12], p0[13]); w.w = cvtpk(p0[14], p0[15]); pa[1] = __builtin_bit_cast(bf16x8, w);
    w.x = cvtpk(p1[0], p1[1]); w.y = cvtpk(p1[2], p1[3]); w.z = cvtpk(p1[4], p1[5]); w.w = cvtpk(p1[6], p1[7]); pa[2] = __builtin_bit_cast(bf16x8, w);
    w.x = cvtpk(p1[8], p1[9]); w.y = cvtpk(p1[10], p1[11]); w.z = cvtpk(p1[12], p1[13]); w.w = cvtpk(p1[14], p1[15]); pa[3] = __builtin_bit_cast(bf16x8, w);
    float s0 = 0.f, s1 = 0.f;
#pragma unroll
    for (int i = 0; i < 16; i += 2) { s0 += p0[i] + p1[i]; s1 += p0[i + 1] + p1[i + 1]; }
    st.ol[0] += s0; st.ol[1] += s1;
}
DI int k_lds_off(int key, int chunk) { return chunk * KCS + key * 16; }
DI int v_lds_off(int key, int c8) { return ((c8 >> 2) * 4 + (key >> 4)) * VPS + (key & 15) * 64 + (c8 & 3) * 16; }

constexpr int TEND = 1 << 20;
struct SeqRange { int j0, j1; DI int first() const { return j0 < j1 ? j0 : TEND; } DI int next(int j) const { return j + 1 < j1 ? j + 1 : TEND; } };
struct SeqMask { unsigned long long m;
    DI int first() const { return m ? (int)__builtin_ctzll(m) : TEND; }
    DI int next(int j) const { const unsigned long long r = (j >= 63) ? 0ull : (m >> (j + 1)); return r ? j + 1 + (int)__builtin_ctzll(r) : TEND; } };
template <int NQ, int VAR, class Src, class Mask, class Seq>
DI void run_stage(LAS unsigned char* lds, const Src& src, const Mask& mask, const Seq& seq, int jw0, int jw1, const bf16x8 (&qf)[NQ], St& st, int tid, int qpos) {
    int tk_ = tid; asm volatile("" : "+v"(tk_));
    const int lane = tk_ & 63, r32 = lane & 31, hi = lane >> 5;
    const int key = tk_ >> 3, ch = tk_ & 7;
    u32x4 rk, rk2, rv;
    rk2 = (u32x4){0u, 0u, 0u, 0u};
#ifdef PROBE_PM
    const int pm_ = *(LAS const int*)(lds + PM_OFF);
#else
    constexpr int pm_ = -1;
#endif
    auto gloadK = [&](int j) {
        const int kpos = (64 * j + key) & pm_;
        rk = *(const u32x4*)(src.krow(kpos) + ch * 8);
        if (NQ == 6 && ch < 4) rk2 = *(const u32x4*)(src.krow2(kpos) + ch * 8);
    };
    auto gloadV = [&](int j) { rv = *(const u32x4*)(src.vrow((64 * j + key) & pm_) + ch * 8); };
    auto storeK = [&](int buf) {
        *(LAS u32x4*)(lds + KBUF + buf * KBUF_SZ + k_lds_off(key, ch)) = rk;
        if (NQ == 6 && ch < 4) *(LAS u32x4*)(lds + KBUF + buf * KBUF_SZ + k_lds_off(key, 8 + ch)) = rk2;
    };
    auto storeV = [&](int buf) { *(LAS u32x4*)(lds + VBUF + buf * VBUF_SZ + v_lds_off(key, ch)) = rv; };
    int j = seq.first();
    if (j == TEND) return;
    int j1 = seq.next(j);
    gloadK(j); storeK(0);
    if (j1 != TEND) { gloadK(j1); storeK(1); }
    { unsigned z0_ = 0u; asm volatile("" : "+v"(z0_)); *(LAS u32x4*)(lds + VBUF + VBUF_SZ + v_lds_off(key, ch)) = (u32x4){z0_, z0_, z0_, z0_}; }
    __syncthreads();
    f32x16 sa0, sa1, sb0, sb1;
    f32x16 negm;
#pragma unroll
    for (int i = 0; i < 16; ++i) { sa0[i] = 0.f; sa1[i] = 0.f; sb0[i] = 0.f; sb1[i] = 0.f; negm[i] = 0.f; }
    bf16x8 pA[4];
#pragma unroll
    for (int i = 0; i < 4; ++i) pA[i] = (bf16x8){0, 0, 0, 0, 0, 0, 0, 0};
    bool a_prev = false;
    bool have_ref = false;
    st.m = 0.f;
    bool a_cur = (j >= jw0 && j < jw1 && !mask.skip(j));
#define FA_ESTABLISH(P0, P1, KT, JJ) do { \
        { const f32x16 ci = mask.cinit(negm, JJ); qk_tile_lean<NQ>(P0, P1, KT, qf, r32, hi, ci); } \
        mask.apply(P0, P1, JJ, qpos, hi); \
        float mx = fmaxf(P0[0], P1[0]); \
        _Pragma("unroll") for (int i = 1; i < 16; ++i) mx = __builtin_fmaxf(__builtin_fmaxf(P0[i], P1[i]), mx); \
        mx = xhalf_max(mx); \
        const float mref = (mx > -3.0e38f) ? mx : 0.f; \
        _Pragma("unroll") for (int i = 0; i < 16; ++i) { negm[i] = -mref; P0[i] -= mref; P1[i] -= mref; } \
        st.m = mref; have_ref = true; } while (0)
    if (a_cur) FA_ESTABLISH(sa0, sa1, lds + KBUF, j);
    __syncthreads();
    int pb = 0;
#define FA_STEP(C0, C1, N0, N1) do { \
        const int j2 = (j1 != TEND) ? seq.next(j1) : TEND; \
        if (!(VAR & 4)) { if (j2 != TEND) gloadK(j2); \
        gloadV(j); } \
        const bool a_next = (j1 != TEND) && (j1 >= jw0 && j1 < jw1 && !mask.skip(j1)); \
        if (a_cur) {     \
            mask.apply(C0, C1, j, qpos, hi); \
            const f32x16 ci = mask.cinit(negm, j1); \
            fused3<NQ, VAR>(N0, N1, lds + KBUF + (pb ^ 1) * KBUF_SZ, qf, r32, hi, ci, C0, C1, st, pA, lds + VBUF + (pb ^ 1) * VBUF_SZ, lane); \
        } else { \
            if (a_next) { \
                if (!have_ref) FA_ESTABLISH(N0, N1, lds + KBUF + (pb ^ 1) * KBUF_SZ, j1); \
                else { const f32x16 ci = mask.cinit(negm, j1); qk_tile<NQ>(N0, N1, lds + KBUF + (pb ^ 1) * KBUF_SZ, qf, r32, hi, ci); } } \
            if (a_prev) pv_tile(st.o, lds + VBUF + (pb ^ 1) * VBUF_SZ, pA, lane); \
            _Pragma("unroll") for (int i = 0; i < 4; ++i) pA[i] = (bf16x8){0, 0, 0, 0, 0, 0, 0, 0}; \
        } \
        if (!(VAR & 4)) { if (j2 != TEND) storeK(pb); \
        storeV(pb); } \
        if (!(VAR & 8)) __syncthreads(); \
        a_prev = a_cur; a_cur = a_next; j = j1; j1 = j2; pb ^= 1; } while (0)
    for (;;) {
        FA_STEP(sa0, sa1, sb0, sb1); if (j == TEND) break;
        FA_STEP(sb0, sb1, sa0, sa1); if (j == TEND) break;
    }
    if (a_prev) pv_tile(st.o, lds + VBUF + (pb ^ 1) * VBUF_SZ, pA, lane);
    __syncthreads();
#undef FA_STEP
#undef FA_ESTABLISH
    st.ol[0] = xhalf_sum(st.ol[0] + st.ol[1]);
}
DI void dma16(const bf16_t* gsrc, LAS const unsigned char* dst) {
    const unsigned m0v = (unsigned)(size_t)dst;
    asm volatile("s_mov_b32 m0, %1\n\ts_nop 0\n\tglobal_load_lds_dwordx4 %0, off" :: "v"(gsrc), "s"(m0v) : "memory", "m0");
}
template <int NQ, int VAR, class Src, class Mask, class Seq>
DI void run_stage_dma(LAS unsigned char* lds, const Src& src, const Mask& mask, const Seq& seq, int jw0, int jw1, const bf16x8 (&qf)[NQ], St& st, int tid, int qpos) {
    constexpr int KTS = 2 * NQ * KCS, VTS = 8 * VPS, VB0 = 3 * KTS;
    static_assert(NQ == 6 || VB0 + 3 * VTS <= IMP_OFF, "64-dim rings stay below the importance / gated-sum region");
    int tk_ = tid; asm volatile("" : "+v"(tk_));
    const int lane = tk_ & 63, r32 = lane & 31, hi = lane >> 5;
    const int w = __builtin_amdgcn_readfirstlane(tk_ >> 6);
    auto dmaK = [&](int jt, int buf) {
        const int kpos = 64 * jt + lane;
        dma16(src.krow(kpos) + w * 8, lds + buf * KTS + w * KCS);
        if (NQ == 6 && w < 4) dma16(src.krow2(kpos) + w * 8, lds + buf * KTS + (8 + w) * KCS);
    };
    auto dmaV = [&](int jt, int buf) {
        const int kpos = 64 * jt + 16 * (w & 3) + (lane >> 2);
        dma16(src.vrow(kpos) + (w >> 2) * 32 + (lane & 3) * 8, lds + VB0 + buf * VTS + w * VPS);
    };
    int j = seq.first();
    if (j == TEND) return;
    int j1 = seq.next(j);
    int j2 = (j1 != TEND) ? seq.next(j1) : TEND;
    dmaK(j, 0); dmaK(j1 != TEND ? j1 : j, 1); dmaK(j2 != TEND ? j2 : j, 2); dmaV(j, 0);
    asm volatile("s_waitcnt vmcnt(0)" ::: "memory");
    __syncthreads();
    f32x16 sa0, sa1, sb0, sb1;
    f32x16 negm;
#pragma unroll
    for (int i = 0; i < 16; ++i) { sa0[i] = 0.f; sa1[i] = 0.f; sb0[i] = 0.f; sb1[i] = 0.f; negm[i] = 0.f; }
    bf16x8 pA[4];
#pragma unroll
    for (int i = 0; i < 4; ++i) pA[i] = (bf16x8){0, 0, 0, 0, 0, 0, 0, 0};
    bool a_prev = false, have_ref = false;
    st.m = 0.f;
    bool a_cur = (j >= jw0 && j < jw1 && !mask.skip(j));
#define FA_ESTABLISH(P0, P1, KT, JJ) do { \
        { const f32x16 ci = mask.cinit(negm, JJ); qk_tile_lean<NQ>(P0, P1, KT, qf, r32, hi, ci); } \
        mask.apply(P0, P1, JJ, qpos, hi); \
        float mx = fmaxf(P0[0], P1[0]); \
        _Pragma("unroll") for (int i = 1; i < 16; ++i) mx = __builtin_fmaxf(__builtin_fmaxf(P0[i], P1[i]), mx); \
        mx = xhalf_max(mx); \
        const float mref = (mx > -3.0e38f) ? mx : 0.f; \
        _Pragma("unroll") for (int i = 0; i < 16; ++i) { negm[i] = -mref; P0[i] -= mref; P1[i] -= mref; } \
        st.m = mref; have_ref = true; } while (0)
    if (a_cur) FA_ESTABLISH(sa0, sa1, lds, j);
    asm volatile("s_waitcnt lgkmcnt(0)" ::: "memory");
    __builtin_amdgcn_s_barrier();
    int ic = 0, in1 = 1, ip = 2;
    bool first = true;
#define FA_STEP(C0, C1, N0, N1) do { \
        const int j3 = (j2 != TEND) ? seq.next(j2) : TEND; \
        dmaK(j3 != TEND ? j3 : j, ic); \
        dmaV(j1 != TEND ? j1 : j, in1); \
        const bool a_next = (j1 != TEND) && (j1 >= jw0 && j1 < jw1 && !mask.skip(j1)); \
        LAS const unsigned char* kn_ = lds + in1 * KTS; \
        LAS const unsigned char* vp_ = lds + VB0 + (first ? ic : ip) * VTS;     \
        if (a_cur) { \
            mask.apply(C0, C1, j, qpos, hi); \
            const f32x16 ci = mask.cinit(negm, j1); \
            fused3<NQ, VAR>(N0, N1, kn_, qf, r32, hi, ci, C0, C1, st, pA, vp_, lane); \
        } else { \
            if (a_next) { \
                if (!have_ref) FA_ESTABLISH(N0, N1, kn_, j1); \
                else { const f32x16 ci = mask.cinit(negm, j1); qk_tile<NQ>(N0, N1, kn_, qf, r32, hi, ci); } } \
            if (a_prev) pv_tile(st.o, vp_, pA, lane); \
            _Pragma("unroll") for (int i = 0; i < 4; ++i) pA[i] = (bf16x8){0, 0, 0, 0, 0, 0, 0, 0}; \
        } \
        if (NQ == 6 && w < 4) asm volatile("s_waitcnt vmcnt(3) lgkmcnt(0)" ::: "memory"); else asm volatile("s_waitcnt vmcnt(2) lgkmcnt(0)" ::: "memory");     \
        __builtin_amdgcn_s_barrier();     \
        a_prev = a_cur; a_cur = a_next; j = j1; j1 = j2; j2 = j3; first = false; \
        { const int t_ = ic; ic = in1; in1 = ip; ip = t_; } } while (0)
    for (;;) {
        FA_STEP(sa0, sa1, sb0, sb1); if (j == TEND) break;
        FA_STEP(sb0, sb1, sa0, sa1); if (j == TEND) break;
    }
    if (a_prev) pv_tile(st.o, lds + VB0 + ip * VTS, pA, lane);
    asm volatile("s_waitcnt vmcnt(0)" ::: "memory");
    __syncthreads();
#undef FA_STEP
#undef FA_ESTABLISH
    st.ol[0] = xhalf_sum(st.ol[0] + st.ol[1]);
}
template <int NQ, int VAR, class Src, class Mask, class Seq>
DI void run_stage2(LAS unsigned char* lds, const Src& src, const Mask& mask, const Seq& seq, int jw0, int jw1, const bf16x8 (&qf)[NQ], St& st, int tid, int qpos) {
    const int lane = tid & 63, r32 = lane & 31, hi = lane >> 5;
    int tk_ = tid; asm volatile("" : "+v"(tk_));
    const int key = tk_ >> 3, ch = tk_ & 7;
    u32x4 rk, rk2, rv;
    rk2 = (u32x4){0u, 0u, 0u, 0u};
    auto gloadK = [&](int j) {
        const int kpos = 64 * j + key;
        rk = *(const u32x4*)(src.krow(kpos) + ch * 8);
        if (NQ == 6 && ch < 4) rk2 = *(const u32x4*)(src.krow2(kpos) + ch * 8);
    };
    auto gloadV = [&](int j) { rv = *(const u32x4*)(src.vrow(64 * j + key) + ch * 8); };
    auto storeK = [&](int buf) {
        *(LAS u32x4*)(lds + KBUF + buf * KBUF_SZ + k_lds_off(key, ch)) = rk;
        if (NQ == 6 && ch < 4) *(LAS u32x4*)(lds + KBUF + buf * KBUF_SZ + k_lds_off(key, 8 + ch)) = rk2;
    };
    auto storeV = [&](int buf) { *(LAS u32x4*)(lds + VBUF + buf * VBUF_SZ + v_lds_off(key, ch)) = rv; };
    int j = seq.first();
    if (j == TEND) return;
    int j1 = seq.next(j);
    gloadK(j); gloadV(j); storeK(0); storeV(0);
    if (j1 != TEND) { gloadK(j1); storeK(1); }
    __syncthreads();
    f32x16 sa0, sa1, sb0, sb1;
    f32x16 negm;
#pragma unroll
    for (int i = 0; i < 16; ++i) { sa0[i] = 0.f; sa1[i] = 0.f; sb0[i] = 0.f; sb1[i] = 0.f; negm[i] = 0.f; }
    bool have_ref = false;
    st.m = 0.f;
    bool a_cur = (j >= jw0 && j < jw1 && !mask.skip(j));
#define FA_ESTABLISH(P0, P1, KT, JJ) do { \
        { const f32x16 ci = mask.cinit(negm, JJ); qk_tile_lean<NQ>(P0, P1, KT, qf, r32, hi, ci); } \
        mask.apply(P0, P1, JJ, qpos, hi); \
        float mx = fmaxf(P0[0], P1[0]); \
        _Pragma("unroll") for (int i = 1; i < 16; ++i) mx = __builtin_fmaxf(__builtin_fmaxf(P0[i], P1[i]), mx); \
        mx = xhalf_max(mx); \
        const float mref = (mx > -3.0e38f) ? mx : 0.f; \
        _Pragma("unroll") for (int i = 0; i < 16; ++i) { negm[i] = -mref; P0[i] -= mref; P1[i] -= mref; } \
        st.m = mref; have_ref = true; } while (0)
    if (a_cur) FA_ESTABLISH(sa0, sa1, lds + KBUF, j);
    __syncthreads();
    int pb = 0;
#define FA_STEP(C0, C1, N0, N1) do { \
        const int j2 = (j1 != TEND) ? seq.next(j1) : TEND; \
        if (!(VAR & 4)) { if (j2 != TEND) gloadK(j2); \
        if (j1 != TEND) gloadV(j1); } \
        const bool a_next = (j1 != TEND) && (j1 >= jw0 && j1 < jw1 && !mask.skip(j1)); \
        if (a_cur) {     \
            mask.apply(C0, C1, j, qpos, hi); \
            const f32x16 ci = mask.cinit(negm, j1); \
            fused_step<NQ, VAR>(N0, N1, lds + KBUF + (pb ^ 1) * KBUF_SZ, qf, r32, hi, ci, C0, C1, st, lds + VBUF + pb * VBUF_SZ, lane); \
        } else if (a_next) { \
            if (!have_ref) FA_ESTABLISH(N0, N1, lds + KBUF + (pb ^ 1) * KBUF_SZ, j1); \
            else { const f32x16 ci = mask.cinit(negm, j1); qk_tile<NQ>(N0, N1, lds + KBUF + (pb ^ 1) * KBUF_SZ, qf, r32, hi, ci); } } \
        if (!(VAR & 4)) { if (j2 != TEND) storeK(pb); \
        if (j1 != TEND) storeV(pb ^ 1); } \
        if (!(VAR & 8)) __syncthreads(); \
        a_cur = a_next; j = j1; j1 = j2; pb ^= 1; } while (0)
    for (;;) {
        FA_STEP(sa0, sa1, sb0, sb1); if (j == TEND) break;
        FA_STEP(sb0, sb1, sa0, sa1); if (j == TEND) break;
    }
#undef FA_STEP
#undef FA_ESTABLISH
    st.ol[0] = xhalf_sum(st.ol[0] + st.ol[1]);
}
struct MaskBand { int maxd;
    DI bool skip(int) const { return false; }
    DI bool rowon(int) const { return true; }
    DI const f32x16& cinit(const f32x16& negm, int) const { return negm; }
    DI void apply(f32x16& p0, f32x16& p1, int j, int qpos, int hi) const {
        const int kb = 64 * j + 4 * hi, q0 = qpos & ~31;
        if (64 * j + 63 <= q0 && q0 + 31 - (64 * j) <= maxd) return;
        int db = qpos - kb; asm volatile("" : "+v"(db));
#pragma unroll
        for (int r = 0; r < 16; ++r) { const int cr = (r & 3) + 8 * (r >> 2);
            if (db < cr || db > maxd + cr) p0[r] = -INFINITY; if (db < cr + 32 || db > maxd + cr + 32) p1[r] = -INFINITY; }
    } };
constexpr int RT_V = 8 * KCS, RT_TILE = 8 * KCS + 8 * VPS;
static_assert(7 * RT_TILE <= SELM_OFF, "resident tiles (and the one-tile lookahead read past them) stay below the control words");
template <int VAR, class Src>
DI void run_resident(LAS unsigned char* lds, const Src& src, int maxd, int jt0, int jt1, int jw0, int jw1, const bf16x8 (&qf)[4], St& st, int tid, int qpos) {
    int tk_ = tid; asm volatile("" : "+v"(tk_));
    const int lane = tk_ & 63, r32 = lane & 31, hi = lane >> 5;
    const int key = tk_ >> 3, ch = tk_ & 7;
    const int nt = jt1 - jt0;
    { u32x4 rkk[6], rvv[6];
#pragma unroll
      for (int t = 0; t < 6; ++t) if (t < nt) { const int kpos = 64 * (jt0 + t) + key; rkk[t] = *(const u32x4*)(src.krow(kpos) + ch * 8); rvv[t] = *(const u32x4*)(src.vrow(kpos) + ch * 8); }
#pragma unroll
      for (int t = 0; t < 6; ++t) if (t < nt) { *(LAS u32x4*)(lds + t * RT_TILE + k_lds_off(key, ch)) = rkk[t]; *(LAS u32x4*)(lds + t * RT_TILE + RT_V + v_lds_off(key, ch)) = rvv[t]; } }
    __syncthreads();
    const int ja = jt0 > jw0 ? jt0 : jw0, jb = jt1 < jw1 ? jt1 : jw1;
    st.m = 0.f;
    if (ja < jb) {
        const MaskBand mask{maxd};
        f32x16 sa0, sa1, sb0, sb1, negm;
#pragma unroll
        for (int i = 0; i < 16; ++i) { sb0[i] = 0.f; sb1[i] = 0.f; negm[i] = 0.f; }
        bf16x8 pA[4];
#pragma unroll
        for (int i = 0; i < 4; ++i) pA[i] = (bf16x8){0, 0, 0, 0, 0, 0, 0, 0};
        { qk_tile_lean<4>(sa0, sa1, lds + (ja - jt0) * RT_TILE, qf, r32, hi, negm);
          mask.apply(sa0, sa1, ja, qpos, hi);
          float mx = fmaxf(sa0[0], sa1[0]);
#pragma unroll
          for (int i = 1; i < 16; ++i) mx = __builtin_fmaxf(__builtin_fmaxf(sa0[i], sa1[i]), mx);
          mx = xhalf_max(mx);
          const float mref = (mx > -3.0e38f) ? mx : 0.f;
#pragma unroll
          for (int i = 0; i < 16; ++i) { negm[i] = -mref; sa0[i] -= mref; sa1[i] -= mref; }
          st.m = mref; }
        int j = ja;
#define RT_STEP(C0, C1, N0, N1) do { \
            mask.apply(C0, C1, j, qpos, hi); \
            const int jp = (j > ja) ? j - 1 : ja; \
            fused3<4, VAR>(N0, N1, lds + (j + 1 - jt0) * RT_TILE, qf, r32, hi, negm, C0, C1, st, pA, lds + (jp - jt0) * RT_TILE + RT_V, lane); \
            ++j; } while (0)
        for (;;) {
            RT_STEP(sa0, sa1, sb0, sb1); if (j == jb) break;
            RT_STEP(sb0, sb1, sa0, sa1); if (j == jb) break;
        }
#undef RT_STEP
        pv_tile(st.o, lds + (jb - 1 - jt0) * RT_TILE + RT_V, pA, lane);
    }
    __syncthreads();
    st.ol[0] = xhalf_sum(st.ol[0] + st.ol[1]);
}
struct SrcMla { const bf16_t* kvu; const bf16_t* ua; int b, h;
    DI const bf16_t* krow(int kpos) const { return kvu + (size_t)(b * S + kpos) * 1024 + h * 128; }
    DI const bf16_t* vrow(int kpos) const { return kvu + (size_t)(b * S + kpos) * 1024 + h * 128 + 64; }
    DI const bf16_t* krow2(int kpos) const { return ua + (size_t)(b * S + kpos) * LDA + A_BKR; } };

constexpr int OT_PITCH = 144, OT_WAVE = 32 * OT_PITCH;
static_assert(8 * OT_WAVE <= VBUF + 2 * VBUF_SZ, "output images fit in the staging buffers");
DI void tile_rows_out(LAS unsigned char* wl, int lane_, bf16_t* out0, size_t rstride) {
    int lane = lane_; asm volatile("" : "+v"(lane));
#pragma unroll
    for (int k = 0; k < 4; ++k) { const int row = (lane >> 3) + 8 * k;
        const u32x4 v = *(LAS const u32x4*)(wl + row * OT_PITCH + (lane & 7) * 16);
        *(u32x4*)(out0 + (size_t)row * rstride + (lane & 7) * 8) = v; }
}
DI void store_o(const f32x16 (&o)[2], float inv, LAS unsigned char* wl, int lane, bf16_t* out0, size_t rstride) {
    const int r32 = lane & 31, hi = lane >> 5;
#pragma unroll
    for (int d0 = 0; d0 < 2; ++d0)
#pragma unroll
        for (int i = 0; i < 4; ++i) {
            const unsigned lo = cvtpk(o[d0][4 * i] * inv, o[d0][4 * i + 1] * inv), hv = cvtpk(o[d0][4 * i + 2] * inv, o[d0][4 * i + 3] * inv);
            *(LAS unsigned long long*)(wl + r32 * OT_PITCH + (32 * d0 + 8 * i + 4 * hi) * 2) = (unsigned long long)lo | ((unsigned long long)hv << 32);
        }
    tile_rows_out(wl, lane, out0, rstride);
}
DI void gated_store(const f32x16 (&o)[2], float scale, const bf16_t* zrow, LAS unsigned char* wl, int lane, bf16_t* out0, size_t rstride) {
    const int r32 = lane & 31, hi = lane >> 5;
    unsigned long long zw[2][4];
#pragma unroll
    for (int d0 = 0; d0 < 2; ++d0)
#pragma unroll
        for (int i = 0; i < 4; ++i) zw[d0][i] = *(const unsigned long long*)(zrow + 32 * d0 + 8 * i + 4 * hi);
#pragma unroll
    for (int d0 = 0; d0 < 2; ++d0)
#pragma unroll
        for (int i = 0; i < 4; ++i) {
            const unsigned long long w = zw[d0][i];
            const float z0 = bflo((unsigned)w), z1 = bfhi((unsigned)w), z2 = bflo((unsigned)(w >> 32)), z3 = bfhi((unsigned)(w >> 32));
            const unsigned lo = cvtpk(o[d0][4 * i] * scale * z0 * sigf(z0), o[d0][4 * i + 1] * scale * z1 * sigf(z1)), hv = cvtpk(o[d0][4 * i + 2] * scale * z2 * sigf(z2), o[d0][4 * i + 3] * scale * z3 * sigf(z3));
            *(LAS unsigned long long*)(wl + r32 * OT_PITCH + (32 * d0 + 8 * i + 4 * hi) * 2) = (unsigned long long)lo | ((unsigned long long)hv << 32);
        }
    tile_rows_out(wl, lane, out0, rstride);
}
template <int VAR = 0> DI unsigned unit_mla(LAS unsigned char* lds, int tid, int b, int h, int qblk, const bf16_t* qm, const bf16_t* kvu, const bf16_t* ua, const bf16_t* ub, bf16_t* ob, unsigned* qctr) {
    const int lane = tid & 63, r32 = lane & 31, hi = lane >> 5, wave = __builtin_amdgcn_readfirstlane(tid >> 6);
    const int q0 = 256 * qblk + 32 * wave, qpos = q0 + r32;
    const bf16_t* qrow = qm + (size_t)(b * S + qpos) * 768 + h * 96;
    bf16x8 qf[6];
#pragma unroll
    for (int d0 = 0; d0 < 6; ++d0) qf[d0] = *(const bf16x8*)(qrow + d0 * 16 + hi * 8);
    St st; st_init(st);
    SrcMla src{kvu, ua, b, h};
    MaskBand mk{1 << 30};
    run_stage_dma<6, VAR>(lds, src, mk, SeqRange{0, 4 * qblk + 4}, 0, (q0 + 31) / 64 + 1, qf, st, tid, qpos);
    unsigned nxt_ = 0u;
    if (tid == 0) nxt_ = atomicAdd(qctr, 1u);
    const float lt = st.ol[0], inv = __builtin_amdgcn_rcpf(lt);
    const bf16_t* zrow = ub + (size_t)(b * S + qpos) * LDB + B_ZB + h * 64;
    if (!(VAR & 32)) gated_store(st.o, inv, zrow, lds + wave * OT_WAVE, lane, ob + (size_t)(b * S + q0) * 512 + h * 64, 512);
    return nxt_;
}
struct SrcDil { const bf16_t* base; int dil;
    DI const bf16_t* krow(int kpos) const { return base + (size_t)kpos * dil * LDA + 512; }
    DI const bf16_t* vrow(int kpos) const { return base + (size_t)kpos * dil * LDA + 1024; }
    DI const bf16_t* krow2(int) const { return base; } };
template <int VAR = 0> DI unsigned unit_dil(LAS unsigned char* lds, int tid, int gi, int b, int h, int r, int qblk, const bf16_t* ua, bf16_t* od, float* lse, unsigned* qctr) {
    const int lane = tid & 63, r32 = lane & 31, hi = lane >> 5, wave = __builtin_amdgcn_readfirstlane(tid >> 6);
    const int dil = (gi == 0) ? 1 : (gi == 1) ? 4 : 16;
    const int q0 = 256 * qblk + 32 * wave, qpos = q0 + r32;
    const bf16_t* base = ua + (size_t)(b * S + r) * LDA + A_CQKV + gi * 1536 + h * 64;
    const size_t tok = (size_t)b * S + (size_t)qpos * dil + r;
    const bf16_t* qrow = base + (size_t)qpos * dil * LDA;
    bf16x8 qf[4];
#pragma unroll
    for (int d0 = 0; d0 < 4; ++d0) qf[d0] = *(const bf16x8*)(qrow + d0 * 16 + hi * 8);
    St st; st_init(st);
    SrcDil src{base, dil};
    MaskBand mk{128};
    const int jt0 = (4 * qblk - 2) > 0 ? (4 * qblk - 2) : 0, jw0 = ((q0 - 128) >> 6) > 0 ? ((q0 - 128) >> 6) : 0;
    run_resident<VAR>(lds, src, 128, jt0, 4 * qblk + 4, jw0, (q0 + 31) / 64 + 1, qf, st, tid, qpos);
    unsigned nxt_ = 0u;
    if (tid == 0) nxt_ = atomicAdd(qctr, 1u);
    const float lt = st.ol[0];
    if (!(VAR & 32)) store_o(st.o, __builtin_amdgcn_rcpf(lt), lds + wave * OT_WAVE, lane, od + ((size_t)b * S + (size_t)q0 * dil + r) * 512 + h * 64, (size_t)dil * 512);
    if (hi == 0) lse[tok * 8 + h] = st.m * 0.6931471805599453f + __logf(lt);
    return nxt_;
}
struct MaskSel { unsigned lo, hi32;
    DI bool bit(int j) const { return ((j < 32 ? lo >> j : hi32 >> (j - 32)) & 1u) != 0u; }
    DI bool skip(int j) const { return !__any(bit(j)); }
    DI bool rowon(int j) const { return bit(j); }
    DI f32x16 cinit(const f32x16& negm, int j) const { f32x16 r; const bool on = bit(j);
#pragma unroll
        for (int i = 0; i < 16; ++i) r[i] = on ? negm[i] : -INFINITY;
        return r; }
    DI void apply(f32x16& p0, f32x16& p1, int j, int qpos, int hi) const {
        if (64 * j + 63 <= (qpos & ~31)) return;
        const int kb = 64 * j + 4 * hi;
        int db = qpos - kb; asm volatile("" : "+v"(db));
#pragma unroll
        for (int r = 0; r < 16; ++r) { const int cr = (r & 3) + 8 * (r >> 2);
            if (db < cr) p0[r] = -INFINITY; if (db < cr + 32) p1[r] = -INFINITY; }
    } };
struct SrcAkv { const bf16_t* base;
    DI const bf16_t* krow(int kpos) const { return base + (size_t)kpos * LDA; }
    DI const bf16_t* vrow(int kpos) const { return base + (size_t)kpos * LDA + 128; }
    DI const bf16_t* krow2(int) const { return base; } };

template <int VAR = 0> DI unsigned unit_nsa(LAS unsigned char* lds, int tid, int b, int hk, int qb, const bf16_t* ua, const bf16_t* ub, const bf16_t* kc, bf16_t* oa, unsigned* qctr) {
    const int lane = tid & 63, r32 = lane & 31, hi = lane >> 5, wave = __builtin_amdgcn_readfirstlane(tid >> 6);
    const int g = wave >> 1, half = wave & 1, hq = hk * 4 + g;
    const int q0 = 64 * qb + 32 * half, qpos = q0 + r32;
    const size_t tok = (size_t)b * S + qpos;
    auto tokf = [&]() { int q_ = qpos; asm volatile("" : "+v"(q_)); return (size_t)b * S + q_; };
    bf16x8 qf[4];
    { const bf16_t* qrow = ua + tok * LDA + A_AQ + hq * 64;
#pragma unroll
      for (int d0 = 0; d0 < 4; ++d0) qf[d0] = *(const bf16x8*)(qrow + d0 * 16 + hi * 8); }
    const float c = 1.f;
    LAS float* oaccl = (LAS float*)(lds + IMP_OFF) + wave * 2048 + lane;
    f32x16 ocmp[2];
    {
        St st; st_init(st);
        f32x16 o2[2];
#pragma unroll
        for (int i = 0; i < 16; ++i) { o2[0][i] = 0.f; o2[1][i] = 0.f; }
        const int ntile = (VAR & 128) ? 0 : ((4 * qb + 2) >> 6) + 1;
        const int key = tid >> 3, ch = tid & 7;
        u32x4 rk, rv;
        { const int cc = key < NC ? key : NC - 1; const bf16_t* kr = kc + ((size_t)(b * NC + cc) * 2 + hk) * 64;
          rk = *(const u32x4*)(kr + ch * 8); rv = *(const u32x4*)(kr + (size_t)CROWS * 64 + ch * 8); }
        for (int t = 0; t < ntile; ++t) {
            const int cidx = 64 * t + key;
            *(LAS u32x4*)(lds + KBUF + k_lds_off(key, ch)) = rk;
            *(LAS u32x4*)(lds + VBUF + v_lds_off(key, ch)) = rv;
            if (t + 1 < ntile) {
                const int cn = cidx + 64, cc = cn < NC ? cn : NC - 1; const bf16_t* kr = kc + ((size_t)(b * NC + cc) * 2 + hk) * 64;
                rk = *(const u32x4*)(kr + ch * 8); rv = *(const u32x4*)(kr + (size_t)CROWS * 64 + ch * 8); }
            {
              const int jb = cidx >> 2, e3 = cidx & 3; unsigned short w[8];
#pragma unroll
              for (int e = 0; e < 8; ++e) { const int j = 8 * ch + e; w[e] = (cidx >= NC) ? 0 : (j == jb) ? (e3 < 3 ? 0x3F80 : 0x3F00) : (j == jb + 1 && e3 == 3) ? 0x3F00 : 0; }
              u32x4 ov; ov.x = w[0] | ((unsigned)w[1] << 16); ov.y = w[2] | ((unsigned)w[3] << 16); ov.z = w[4] | ((unsigned)w[5] << 16); ov.w = w[6] | ((unsigned)w[7] << 16);
              *(LAS u32x4*)(lds + OVBUF + v_lds_off(key, ch)) = ov; }
            __syncthreads();
            {
                f32x16 p0, p1; bf16x8 pa[4];
                { const f32x16 z16 = {0.f, 0.f, 0.f, 0.f, 0.f, 0.f, 0.f, 0.f, 0.f, 0.f, 0.f, 0.f, 0.f, 0.f, 0.f, 0.f}; qk_tile<4>(p0, p1, lds + KBUF, qf, r32, hi, z16); }
                int db = qpos - 31 - 16 * (64 * t + 4 * hi); asm volatile("" : "+v"(db));
#pragma unroll
                for (int r = 0; r < 16; ++r) { const int cr = (r & 3) + 8 * (r >> 2);
                    if (db < 16 * cr) p0[r] = -INFINITY; if (db < 16 * (cr + 32)) p1[r] = -INFINITY; }
                const float alpha = softmax_tile(st, p0, p1, c, pa, true);
#pragma unroll
                for (int i = 0; i < 16; ++i) { o2[0][i] *= alpha; o2[1][i] *= alpha; }
                pv_tile(st.o, lds + VBUF, pa, lane);
                pv_tile(o2, lds + OVBUF, pa, lane);
            }
            __syncthreads();
        }
        const float lt = st.ol[0], inv = lt > 0.f ? __builtin_amdgcn_rcpf(lt) : 0.f;
        const float g0 = sigf(bf2f(ub[tokf() * LDB + B_GATE + hq * 3 + 0])) * inv;
#pragma unroll
        for (int i = 0; i < 16; ++i) { ocmp[0][i] = st.o[0][i] * g0; ocmp[1][i] = st.o[1][i] * g0; }
        LAS float* imp = (LAS float*)(lds + IMP_OFF) + (g * 64 + 32 * half + r32) * IMP_LD;
#pragma unroll
        for (int d0 = 0; d0 < 2; ++d0)
#pragma unroll
            for (int r = 0; r < 16; ++r) imp[32 * d0 + crow(r, hi)] = o2[d0][r] * inv;
    }
    __syncthreads();
    {
        LAS const float* impb = (LAS const float*)(lds + IMP_OFF);
        unsigned long long uw = 0ull;
        int ln = lane; asm volatile("" : "+v"(ln));
        const bool valid = ln <= qb, forced = (ln == 0) || (ln == qb) || (ln == qb - 1);
        unsigned kv[8], thr[8];
#pragma unroll
        for (int i = 0; i < 8; ++i) { const int tk = wave * 8 + i;
            float v = impb[(0 * 64 + tk) * IMP_LD + ln]; v += impb[(1 * 64 + tk) * IMP_LD + ln]; v += impb[(2 * 64 + tk) * IMP_LD + ln]; v += impb[(3 * 64 + tk) * IMP_LD + ln];
            kv[i] = forced ? 0x7FFFFFFFu : (valid ? __float_as_uint(v) + 1u : 0u); thr[i] = 0u; }
        if (!(VAR & 64)) {
#pragma clang loop unroll(disable)
            for (int bit = 30; bit >= 0; --bit) {
#pragma unroll
                for (int i = 0; i < 8; ++i) { const unsigned cand = thr[i] | (1u << bit); if (__builtin_popcountll(__ballot(kv[i] >= cand)) >= 16) thr[i] = cand; }
            }
        }
#pragma unroll
        for (int i = 0; i < 8; ++i) { const int tk = wave * 8 + i;
            const unsigned long long gt = __ballot(kv[i] > thr[i]), eq = __ballot(kv[i] == thr[i]);
            const int below = (int)__builtin_amdgcn_mbcnt_hi((unsigned)(eq >> 32), __builtin_amdgcn_mbcnt_lo((unsigned)eq, 0u));
            const bool sel = (kv[i] > thr[i]) || (kv[i] == thr[i] && (int)__builtin_popcountll(gt) + below < 16);
            const unsigned long long m = __ballot(sel && valid);
            if (lane == 0) *(LAS unsigned long long*)(lds + SELM_OFF + 8 * tk) = m;
            uw |= m;
        }
        if (lane == 0) *(LAS unsigned long long*)(lds + UNI_OFF + 8 * wave) = uw;
    }
    __syncthreads();
#pragma unroll
    for (int i = 0; i < 16; ++i) { oaccl[i * 64] = ocmp[0][i]; oaccl[(16 + i) * 64] = ocmp[1][i]; }
    {
        St st; st_init(st);
        const unsigned long long m = *(LAS const unsigned long long*)(lds + SELM_OFF + 8 * (32 * half + r32));
        unsigned long long um = 0ull;
#pragma unroll
        for (int w8 = 0; w8 < 8; ++w8) um |= *(LAS const unsigned long long*)(lds + UNI_OFF + 8 * w8);
        um = ((unsigned long long)__builtin_amdgcn_readfirstlane((unsigned)(um >> 32)) << 32) | (unsigned)__builtin_amdgcn_readfirstlane((unsigned)um);
        MaskSel mk{(unsigned)m, (unsigned)(m >> 32)};
        SrcAkv src{ua + (size_t)b * S * LDA + A_AKV + 2 * 128 + hk * 64};
        run_stage_dma<4, VAR>(lds, src, mk, SeqMask{um}, 0, qb + 1, qf, st, tid, qpos);
        const float lt = st.ol[0];
        const float g1 = sigf(bf2f(ub[tokf() * LDB + B_GATE + hq * 3 + 1])) * __builtin_amdgcn_rcpf(lt);
#pragma unroll
        for (int i = 0; i < 16; ++i) { oaccl[i * 64] += st.o[0][i] * g1; oaccl[(16 + i) * 64] += st.o[1][i] * g1; }
    }
    unsigned nxt_ = 0u;
    if (tid == 0) nxt_ = atomicAdd(qctr, 1u);
    {
        f32x16 oacc[2];
        St st; st_init(st);
        MaskBand mk{511};
        SrcAkv src{ua + (size_t)b * S * LDA + A_AKV + 4 * 128 + hk * 64};
        const int jt0 = qb > 8 ? qb - 8 : 0;
        int jw0 = (q0 - 511) >> 6; jw0 = jw0 > jt0 ? jw0 : jt0;
        run_stage_dma<4, VAR>(lds, src, mk, SeqRange{jt0, qb + 1}, jw0, qb + 1, qf, st, tid, qpos);
        const float lt = st.ol[0];
        const float g2 = sigf(bf2f(ub[tokf() * LDB + B_GATE + hq * 3 + 2])) * __builtin_amdgcn_rcpf(lt);
#pragma unroll
        for (int i = 0; i < 16; ++i) { oacc[0][i] = oaccl[i * 64] + st.o[0][i] * g2; oacc[1][i] = oaccl[(16 + i) * 64] + st.o[1][i] * g2; }
        if (!(VAR & 32)) { const size_t t3 = tokf(); gated_store(oacc, 1.f, ub + t3 * LDB + B_ZA + hq * 64, lds + wave * OT_WAVE, lane, oa + ((size_t)b * S + q0) * 512 + hq * 64, 512); }
    }
    return nxt_;
}
}
#define XB_TMO      128
#define XB_XCNT(j)  (256  + 64 * (j))
#define XB_XSUB(j)  (1280 + 64 * (j))
#define XB_XGEN(j)  (2304 + 64 * (j))
#define XB_TOP      3328
#define XB_TOPGEN   3392
#define XCD_BAR_WORDS 3456
#define XB_SPIN_CAP (1u << 18)

__device__ __forceinline__ unsigned xb_ld(unsigned* p)              { return __hip_atomic_load(p, __ATOMIC_RELAXED, __HIP_MEMORY_SCOPE_AGENT); }
__device__ __forceinline__ unsigned xb_add(unsigned* p, unsigned v) { return __hip_atomic_fetch_add(p, v, __ATOMIC_RELAXED, __HIP_MEMORY_SCOPE_AGENT); }
__device__ __forceinline__ unsigned xb_xcc_id() { return (unsigned)__builtin_amdgcn_s_getreg((3 << 11) | 20) & 0xFu; }
#define XB_SPIN(cond, bar) do { unsigned _sp = 0; while (cond) { __builtin_amdgcn_s_sleep(1); \
    if ((++_sp & 255u) == 0u) { if (xb_ld(&(bar)[XB_TMO])) break; if (_sp > XB_SPIN_CAP) { atomicAdd(&(bar)[XB_TMO], 1u); break; } } } } while (0)

struct XcdBarrier {
    unsigned* bar; unsigned x;
    volatile LAS unsigned* st;
};

__device__ __forceinline__ XcdBarrier xcd_barrier_post(unsigned* bar, volatile LAS unsigned* st) {
    XcdBarrier b; b.bar = bar; b.x = xb_xcc_id(); b.st = st;
    if (threadIdx.x == 0) (void)xb_add(&bar[XB_XCNT(b.x)], 1u);
    return b;
}
__device__ __forceinline__ void xcd_barrier_complete(unsigned* bar, unsigned x, unsigned& nloc, unsigned& nx) {
    const unsigned G = gridDim.x * gridDim.y * gridDim.z;
    unsigned sum, cnt, mine, sp = 0u;
    for (;;) {
        sum = 0u; cnt = 0u; mine = 0u;
#pragma unroll
        for (unsigned j = 0; j < 16; ++j) { const unsigned c = xb_ld(&bar[XB_XCNT(j)]); sum += c; cnt += (c > 0u) ? 1u : 0u; mine = (j == x) ? c : mine; }
        if (sum == G) break;
        __builtin_amdgcn_s_sleep(1);
        if ((++sp & 255u) == 0u) { if (xb_ld(&bar[XB_TMO])) break; if (sp > XB_SPIN_CAP) { atomicAdd(&bar[XB_TMO], 1u); break; } }
    }
    nloc = mine > 0u ? mine : 1u; nx = cnt > 0u ? cnt : 1u;
}

__device__ __forceinline__ void xcd_barrier(const XcdBarrier& b) {
    asm volatile("s_waitcnt vmcnt(0)" ::: "memory");
    __syncthreads();
    if (threadIdx.x == 0) {
        unsigned* bar = b.bar;
        __builtin_amdgcn_s_waitcnt(0);
        unsigned nloc = b.st[0], nx = b.st[1];
        if (nloc == 0u) { xcd_barrier_complete(bar, b.x, nloc, nx); b.st[0] = nloc; b.st[1] = nx; }
        const unsigned old = xb_add(&bar[XB_XSUB(b.x)], 1u);
        const unsigned gen = old / nloc;
        if (old + 1u == (gen + 1u) * nloc) {
            __builtin_amdgcn_fence(__ATOMIC_RELEASE, "agent");
            asm volatile("s_waitcnt vmcnt(0)" ::: "memory");
            const unsigned og = xb_add(&bar[XB_TOP], 1u);
            const unsigned tg = og / nx;
            if (og + 1u == (tg + 1u) * nx) xb_add(&bar[XB_TOPGEN], 1u);
            else XB_SPIN(xb_ld(&bar[XB_TOPGEN]) == tg, bar);
            __builtin_amdgcn_fence(__ATOMIC_ACQUIRE, "agent");
            xb_add(&bar[XB_XGEN(b.x)], 1u);
            asm volatile("s_waitcnt vmcnt(0)" ::: "memory");
        } else {
            XB_SPIN(xb_ld(&bar[XB_XGEN(b.x)]) == gen, bar);
            __builtin_amdgcn_fence(__ATOMIC_ACQUIRE, "agent");
            asm volatile("s_waitcnt vmcnt(0)" ::: "memory");
        }
    }
    __syncthreads();
}

enum { PH_CONV = 0, PH_WIN, PH_PREP, PH_G2, PH_KC, PH_ATT1, PH_COMB, PH_YABC, PH_WOUT, PH_PLE, PH_COUNT };
struct MArgs { const void* in[19]; float* out; unsigned char* ws; int ph_lo, ph_hi, l_lo, l_hi; };
static_assert(sizeof(MArgs) == 19 * 8 + 8 + 8 + 16, "no padding");

typedef __attribute__((address_space(4))) const char* kptr_t;
DI kptr_t kbase() { kptr_t p = (kptr_t)__builtin_amdgcn_kernarg_segment_ptr(); asm volatile("" : "+s"(p)); return p; }
template <typename Tp> DI Tp* kload_ptr(int off) { typedef Tp* ptr_t; typedef __attribute__((address_space(4))) const ptr_t* slot_t; return *(slot_t)(kbase() + off); }
DI int kload_int(int off) { typedef __attribute__((address_space(4))) const int* slot_t; return *(slot_t)(kbase() + off); }
#define KIN(type, i) kload_ptr<type>(8 * (i))
#define KOUT() kload_ptr<float>(152)
#define KWS() kload_ptr<unsigned char>(160)
#define KINT(off) kload_int(off)
#define WSP(type, off) ((type*)(KWS() + (off)))
#define WSETP(type, off) ((type*)(KWS() + WS_WSET + (size_t)(L & 1) * WSET_BYTES + (off)))

DI void grid_barrier(unsigned* barw) {
    extern __shared__ __attribute__((aligned(16))) unsigned char lds_raw[];
    XcdBarrier b; b.bar = barw; b.x = xb_xcc_id(); b.st = (volatile LAS unsigned*)((LAS unsigned char*)lds_raw + LDSCTL_OFF + 64);
    xcd_barrier(b);
}

__global__ void __launch_bounds__(NTHREADS, 2) mega(MArgs) {
    extern __shared__ __attribute__((aligned(16))) unsigned char lds_raw[];
    LAS unsigned char* lds = (LAS unsigned char*)lds_raw;
#define G ((int)gridDim.x)
#define bx ((int)blockIdx.x)
#define vcu ((G % 8 == 0) ? (bx % 8) * (G / 8) + bx / 8 : bx)
#define NGW (G * NWAVES)
    for (int u = threadIdx.x; u < (LDS_BYTES - LDSCTL_OFF) / 4; u += NTHREADS) ((LAS unsigned*)(lds + LDSCTL_OFF))[u] = 0u;
    __syncthreads();
    pg8::hw_tid_init(lds);
    __syncthreads();
    (void)xcd_barrier_post(WSP(unsigned, WS_CTL) + CW_BAR, (volatile LAS unsigned*)(lds + LDSCTL_OFF + 64));
#define GRID_BAR() grid_barrier(WSP(unsigned, WS_CTL) + CW_BAR)

#define IN(k) (KINT(168) <= (k) && (k) < KINT(172))
#define SEAM(k) do { if (IN(k) && (IN((k) + 1) || ((k) == PH_COUNT - 1 && L + 1 < KINT(180) && KINT(168) == 0))) GRID_BAR(); } while (0)

    for (int L = KINT(176); L < KINT(180); ++L) {
        if (IN(PH_CONV) && L == 0) {
            int tid_ = pg8::hw_tid(lds); asm volatile("" : "+v"(tid_)); const int tid = tid_, lane = tid & 63, wave = __builtin_amdgcn_readfirstlane(tid >> 6); const int gw = vcu * NWAVES + wave;
            for (int bi = vcu; bi < CB_TOTAL; bi += G) { conv_block_item(lds, tid, bi, 0, KWS() + WS_WSET); __syncthreads(); }
            { const int* pos = KIN(const int, 2); float* TAB = WSP(float, WS_TAB);
              for (int i = gw * 64 + lane; i < T * 24; i += NGW * 64) {
                  const int t = i / 24, j = i % 24; const float p = (float)pos[t];
                  if (j < 8) { const float a = p * powf(500000.0f, -(float)(2 * j) / 16.0f); TAB[(size_t)t * 48 + j] = cosf(a); TAB[(size_t)t * 48 + 8 + j] = sinf(a); }
                  else { const int jj = j - 8; const float a = p * powf(500000.0f, -(float)(2 * jj) / 32.0f); TAB[(size_t)t * 48 + 16 + jj] = cosf(a); TAB[(size_t)t * 48 + 32 + jj] = sinf(a); }
              } }
            { const float* x = KIN(const float, 0); bf16_t* XB2 = WSP(bf16_t, WS_XB2); float* SSQ = WSP(float, WS_SSQ);
              for (int m = gw; m < T; m += NGW) {
                  const f32x4* xr = (const f32x4*)(x + (size_t)m * D) + lane; unsigned long long* o8 = (unsigned long long*)(XB2 + (size_t)m * D) + lane; float s = 0.f;
#pragma unroll
                  for (int j = 0; j < 4; ++j) { const f32x4 v = xr[64 * j]; s += (v[0] * v[0] + v[1] * v[1]) + (v[2] * v[2] + v[3] * v[3]);
                      o8[64 * j] = (unsigned long long)pk2(v[0], v[1]) | ((unsigned long long)pk2(v[2], v[3]) << 32); }
                  s = wsum(s, lane);
                  if (lane < 4) SSQ[(size_t)m * 4 + lane] = (lane == 0) ? s : 0.f;
              } }
        }
        if (L == 0) SEAM(PH_CONV);
        if (IN(PH_WIN)) {
            {
              int tid_ = pg8::hw_tid(lds); asm volatile("" : "+v"(tid_));
              const float* SSQ = WSP(float, WS_SSQ) + (size_t)(bx & 7) * 2048 * 4; LAS float* rsl = (LAS float*)(lds + LDSCTL_OFF + 8192);
#pragma unroll
              for (int q = 0; q < 4; ++q) { const int r = q * 512 + tid_; const f32x4 a = *(const f32x4*)(SSQ + (size_t)r * 4); rsl[r] = rsqrtf(((a[0] + a[1]) + (a[2] + a[3])) * (1.f / 1024.f) + 1e-6f); }
              __syncthreads(); }
            pg8::Gemm g{WSP(bf16_t, WS_XB2), WSETP(bf16_t, WO_WIN), T, NPAD, D}; pg8::StaticOrder S; S.init(T, NPAD, G, bx);
            EpiWin Ep{WSP(bf16_t, WS_UA), WSP(bf16_t, WS_UB), WSP(float, WS_TAB)};
            pg8::gemm_phase<EpiWin, pg8::StaticOrder, true, true>(lds, g, S, Ep);
        }
        SEAM(PH_WIN);
        if (IN(PH_PREP)) {
            int tid_ = pg8::hw_tid(lds); asm volatile("" : "+v"(tid_)); const int tid = tid_, lane = tid & 63, wave = __builtin_amdgcn_readfirstlane(tid >> 6); const int gw = vcu * NWAVES + wave;
            { const bf16_t* UA = WSP(bf16_t, WS_UA); bf16_t* QN = WSP(bf16_t, WS_QN); bf16_t* KVN = WSP(bf16_t, WS_KVN);
              const float* gq = KIN(const float, 10) + (size_t)L * 384; const float* gkv = KIN(const float, 12) + (size_t)L * 128;
#pragma unroll 2
              for (int m = gw; m < T; m += NGW) {
                  const bool isq = lane < 48; const int e0 = isq ? lane * 8 : (lane - 48) * 8;
                  const u32x4 w = *(const u32x4*)(UA + (size_t)m * LDA + (isq ? A_BCQ : A_BCKV) + e0);
                  float v[8] = {bflo(w.x), bfhi(w.x), bflo(w.y), bfhi(w.y), bflo(w.z), bfhi(w.z), bflo(w.w), bfhi(w.w)};
                  float ss = 0.f;
#pragma unroll
                  for (int e = 0; e < 8; ++e) ss += v[e] * v[e];
                  const float sq = wsum(isq ? ss : 0.f, lane), sk = wsum(isq ? 0.f : ss, lane);
                  const float rs = isq ? rsqrtf(sq * (1.f / 384.f) + 1e-6f) : rsqrtf(sk * (1.f / 128.f) + 1e-6f);
                  const float* gp = (isq ? gq : gkv) + e0;
                  const f32x4 g0 = *(const f32x4*)gp, g1 = *(const f32x4*)(gp + 4);
                  u32x4 o; o.x = pk2(v[0] * rs * g0[0], v[1] * rs * g0[1]); o.y = pk2(v[2] * rs * g0[2], v[3] * rs * g0[3]); o.z = pk2(v[4] * rs * g1[0], v[5] * rs * g1[1]); o.w = pk2(v[6] * rs * g1[2], v[7] * rs * g1[3]);
                  if (isq) *(u32x4*)(QN + (size_t)m * 384 + e0) = o; else *(u32x4*)(KVN + (size_t)m * 128 + e0) = o;
              } }
            { const bf16_t* UA = WSP(bf16_t, WS_UA); bf16_t* FLAT = WSP(bf16_t, WS_FLAT); const float* pe = KIN(const float, 6) + (size_t)L * 2 * 32 * 64;
#pragma unroll 4
              for (int i = gw * 64 + lane; i < 2 * CROWS * 256; i += NGW * 64) {
                  const int kv = i / (CROWS * 256), rem = i % (CROWS * 256), row = rem >> 8, gcol = rem & 255, l = gcol >> 3, d = (gcol & 7) * 8;
                  u32x4 o = {0u, 0u, 0u, 0u};
                  if (row < NB * NC * 2) {
                      const int hk = row & 1, bc = row >> 1, b = bc / NC, c = bc % NC;
                      const u32x4 w = *(const u32x4*)(UA + (size_t)(b * S + 16 * c + l) * LDA + A_AKV + kv * 128 + hk * 64 + d);
                      const float* pp = pe + (kv * 32 + l) * 64 + d; const f32x4 p0 = *(const f32x4*)pp, p1 = *(const f32x4*)(pp + 4);
                      o.x = pk2(bflo(w.x) + p0[0], bfhi(w.x) + p0[1]); o.y = pk2(bflo(w.y) + p0[2], bfhi(w.y) + p0[3]); o.z = pk2(bflo(w.z) + p1[0], bfhi(w.z) + p1[1]); o.w = pk2(bflo(w.w) + p1[2], bfhi(w.w) + p1[3]);
                  }
                  *(u32x4*)(FLAT + ((size_t)(((gcol >> 6) * 2 + kv) * CROWS + row) * 512 + (gcol & 63) * 8)) = o;
              } }
        }
        SEAM(PH_PREP);
        if (IN(PH_G2)) {
            { pg8::Gemm g{WSP(bf16_t, WS_FLAT), WSETP(bf16_t, WO_W1), 8 * CROWS, 8 * 256, 512}; HidOrder S{G, bx};
              EpiF32<0> Ep{WSP(float, WS_HIDP), 256, 0};
              pg8::gemm_phase<EpiF32<0>, HidOrder, true, true>(lds, g, S, Ep); }
            __syncthreads();
            { pg8::Gemm g{WSP(bf16_t, WS_QN), WSETP(bf16_t, WO_WUQ), T, 768, 384}; pg8::StaticOrder S; S.init(T, 768, G, bx); EpiQm Ep{WSP(bf16_t, WS_QM), WSP(float, WS_TAB)};
              pg8::gemm_phase<EpiQm, pg8::StaticOrder, true, true>(lds, g, S, Ep); }
            __syncthreads();
            { pg8::Gemm g{WSP(bf16_t, WS_KVN), WSETP(bf16_t, WO_WUKV), T, 1024, 128}; pg8::StaticOrder S; S.init(T, 1024, G, bx); EpiBfPlain Ep{WSP(bf16_t, WS_KVU), 1024, 0};
              pg8::gemm_phase<EpiBfPlain, pg8::StaticOrder, true, true>(lds, g, S, Ep); }
            __syncthreads();
            { pg8::Gemm g{WSETP(bf16_t, WO_PBF), WSETP(bf16_t, WO_WPLE), T, D, 256}; pg8::StaticOrder S; S.init(T, D, G, bx); EpiBfPlain Ep{WSP(bf16_t, WS_EB), D, 0};
              pg8::gemm_phase<EpiBfPlain, pg8::StaticOrder, true, true>(lds, g, S, Ep); }
        }
        SEAM(PH_G2);
        if (IN(PH_KC)) {
            int tid_ = pg8::hw_tid(lds); asm volatile("" : "+v"(tid_)); const int tid = tid_, lane = tid & 63, wave = __builtin_amdgcn_readfirstlane(tid >> 6);
            const float* HIDP = WSP(float, WS_HIDP); bf16_t* KC = WSP(bf16_t, WS_KC);
            for (int blk = vcu; blk < 2 * CROWS / 16; blk += G) {
                const int kv = blk / (CROWS / 16);
                const float* w2 = KIN(const float, 8) + ((size_t)L * 2 + kv) * 256 * 64;
                for (int i = tid; i < 256 * 64 / 4; i += NTHREADS) *(LAS f32x4*)(lds + 16 * i) = *(const f32x4*)(w2 + 4 * i);
                LAS float* hrow = (LAS float*)(lds + 65536 + wave * 2048);
#pragma unroll
                for (int rr = 0; rr < 2; ++rr) {
                    const size_t r = (size_t)blk * 16 + wave * 2 + rr;
                    f32x4 h = *(const f32x4*)(HIDP + r * 256 + 4 * lane);
#pragma unroll
                    for (int ks = 1; ks < 4; ++ks) { const f32x4 q = *(const f32x4*)(HIDP + ((size_t)ks * 2 * CROWS + r) * 256 + 4 * lane); h = h + q; }
#pragma unroll
                    for (int e = 0; e < 4; ++e) h[e] = h[e] * sigf(h[e]);
                    *(LAS f32x4*)(hrow + rr * 256 + 4 * lane) = h;
                }
                __syncthreads();
                const LAS float* w2s = (const LAS float*)lds;
                float a0 = 0.f, a1 = 0.f;
#pragma unroll 8
                for (int k = 0; k < 256; ++k) { const float w = w2s[k * 64 + lane]; a0 += hrow[k] * w; a1 += hrow[256 + k] * w; }
                const size_t r0 = (size_t)blk * 16 + wave * 2;
                KC[r0 * 64 + lane] = f2bf(a0); KC[(r0 + 1) * 64 + lane] = f2bf(a1);
                __syncthreads();
            }
        }
        SEAM(PH_KC);
        if (IN(PH_ATT1)) {
            unsigned* qctr = WSP(unsigned, WS_CTL) + CW_QUEUE + 64 * L;
            LAS unsigned* wq = (LAS unsigned*)(lds + fa::WQ_OFF);
            unsigned nxt = 0u;
            if (pg8::hw_tid(lds) == 0) nxt = atomicAdd(qctr, 1u);
            for (unsigned it = 0;; ++it) {
                const int tid = pg8::hw_tid(lds);
                if (tid == 0) wq[it & 1u] = nxt;
                __syncthreads();
                const int id = (int)wq[it & 1u];
                if (id >= 2560) break;
                if (id < 1024) {
                    const int gq = id >> 6, r = id & 63;
                    if (r >= 8 && r < 40) { const int bh = r - 8;
                        nxt = fa::unit_mla(lds, tid, bh >> 3, bh & 7, 15 - gq, WSP(bf16_t, WS_QM), WSP(bf16_t, WS_KVU), WSP(bf16_t, WS_UA), WSP(bf16_t, WS_UB), WSP(bf16_t, WS_O7) + O7_STRIDE, qctr);
                    } else { const int k = (r < 8) ? 0 : ((r - 40) >> 3) + 1, bk = r & 7;
                        nxt = fa::unit_nsa(lds, tid, bk >> 1, bk & 1, 63 - 4 * gq - k, WSP(bf16_t, WS_UA), WSP(bf16_t, WS_UB), WSP(bf16_t, WS_KC), WSP(bf16_t, WS_O7), qctr); }
                } else {
                    const int e = id - 1024, gi = e >> 9, bh = e & 31, rest = (e >> 5) & 15;
                    const int dil = (gi == 0) ? 1 : (gi == 1) ? 4 : 16;
                    nxt = fa::unit_dil(lds, tid, gi, bh >> 3, bh & 7, rest % dil, rest / dil, WSP(bf16_t, WS_UA),
                                 WSP(bf16_t, WS_O7) + (size_t)(gi == 0 ? 2 : gi == 1 ? 5 : 6) * O7_STRIDE, WSP(float, WS_LSE) + (size_t)gi * T * 8, qctr);
                }
            }
        }
        SEAM(PH_ATT1);
        if (IN(PH_COMB)) {
            int tid_ = pg8::hw_tid(lds); asm volatile("" : "+v"(tid_)); const int tid = tid_, lane = tid & 63, wave = __builtin_amdgcn_readfirstlane(tid >> 6); const int gw = vcu * NWAVES + wave;
            bf16_t* O7 = WSP(bf16_t, WS_O7); const float* LSE = WSP(float, WS_LSE); const bf16_t* UB = WSP(bf16_t, WS_UB);
            bf16_t* od0 = O7 + 2 * O7_STRIDE; const bf16_t* od1 = O7 + 5 * O7_STRIDE; const bf16_t* od2 = O7 + 6 * O7_STRIDE;
#pragma unroll 4
            for (int i = gw * 64 + lane; i < T * 64; i += NGW * 64) {
                const int t = i >> 6, col = (i & 63) * 8, h = col >> 6;
                const float l0 = LSE[((size_t)0 * T + t) * 8 + h], l1 = LSE[((size_t)1 * T + t) * 8 + h], l2 = LSE[((size_t)2 * T + t) * 8 + h];
                const float mx = fmaxf(l0, fmaxf(l1, l2));
                float w0 = __expf(l0 - mx), w1 = __expf(l1 - mx), w2 = __expf(l2 - mx); const float iw = __builtin_amdgcn_rcpf(w0 + w1 + w2); w0 *= iw; w1 *= iw; w2 *= iw;
                const size_t o = (size_t)t * 512 + col;
                const u32x4 a = *(const u32x4*)(od0 + o), b = *(const u32x4*)(od1 + o), c = *(const u32x4*)(od2 + o), z = *(const u32x4*)(UB + (size_t)t * LDB + B_ZC + col);
                const unsigned aw[4] = {a.x, a.y, a.z, a.w}, bw[4] = {b.x, b.y, b.z, b.w}, cw[4] = {c.x, c.y, c.z, c.w}, zw[4] = {z.x, z.y, z.z, z.w}; unsigned ow[4];
#pragma unroll
                for (int e = 0; e < 4; ++e) { const float z0 = bflo(zw[e]), z1 = bfhi(zw[e]);
                    ow[e] = pk2((w0 * bflo(aw[e]) + w1 * bflo(bw[e]) + w2 * bflo(cw[e])) * z0 * sigf(z0), (w0 * bfhi(aw[e]) + w1 * bfhi(bw[e]) + w2 * bfhi(cw[e])) * z1 * sigf(z1)); }
                *(u32x4*)(od0 + o) = (u32x4){ow[0], ow[1], ow[2], ow[3]};
            }
            if (L + 1 < DEPTH) for (int bi = vcu; bi < CB_TOTAL; bi += G) { __syncthreads(); conv_block_item(lds, tid, bi, L + 1, KWS() + WS_WSET + (size_t)((L + 1) & 1) * WSET_BYTES); }
        }
        SEAM(PH_COMB);
        if (IN(PH_YABC)) {
            pg8::Gemm g{WSP(bf16_t, WS_O7), WSETP(bf16_t, WO_WABC), 3 * T, 3 * 1024, 512}; YabcOrder S{G, vcu};
            EpiYabc Ep{WSP(bf16_t, WS_YMIXB), WSP(bf16_t, WS_UB)};
            pg8::gemm_phase<EpiYabc, YabcOrder, true, true>(lds, g, S, Ep);
        }
        SEAM(PH_YABC);
        if (IN(PH_WOUT)) {
            pg8::Gemm g{WSP(bf16_t, WS_YMIXB), WSETP(bf16_t, WO_WOUT), T, D, D}; pg8::StaticOrder S; S.init(T, D, G, bx);
            EpiPost Ep{WSP(bf16_t, WS_XB2), KIN(const float, 4) + (size_t)L * D, WSP(bf16_t, WS_H), (unsigned long long*)(KWS() + WS_CTL + CTL_GRAN), (unsigned)(L + 1), 0};
            pg8::gemm_phase<EpiPost, pg8::StaticOrder, true, true>(lds, g, S, Ep);
        }
        SEAM(PH_WOUT);
        if (IN(PH_PLE)) {
            pg8::Gemm g{WSP(bf16_t, WS_H), WSETP(bf16_t, WO_WPLG), T, D, D}; pg8::StaticOrder S; S.init(T, D, G, bx); EpiPlgF Ep{WSP(bf16_t, WS_H), (L == DEPTH - 1) ? KOUT() : (float*)nullptr, WSP(bf16_t, WS_EB), WSP(bf16_t, WS_XB2), WSP(float, WS_SSQ)};
            pg8::gemm_phase<EpiPlgF, pg8::StaticOrder, true, true>(lds, g, S, Ep);
        }
        SEAM(PH_PLE);
    }
#undef IN
#undef SEAM
#undef G
#undef bx
#undef vcu
#undef NGW
}

static void launch_mega(hipStream_t st, void* const* d_in, void* d_out, void* d_ws, int ph_lo, int ph_hi, int l_lo, int l_hi) {
    MArgs a{};
    for (int i = 0; i < 19; ++i) a.in[i] = d_in[i];
    a.out = (float*)d_out; a.ws = (unsigned char*)d_ws; a.ph_lo = ph_lo; a.ph_hi = ph_hi; a.l_lo = l_lo; a.l_hi = l_hi;
    (void)hipMemsetAsync((char*)d_ws + WS_CTL, 0, 1 << 20, st);
    hipLaunchKernelGGL(mega, dim3(256), dim3(NTHREADS), LDS_BYTES, st, a);
}
extern "C" void kernel_launch(void* const* d_in, const int* in_sizes, int n_in, void* d_out, int out_size, void* d_ws, size_t ws_size, hipStream_t stream) {
    if (ws_size < WS_END2 || n_in != 19) return;
    (void)hipFuncSetAttribute((const void*)mega, hipFuncAttributeMaxDynamicSharedMemorySize, LDS_BYTES);
    launch_mega(stream, d_in, d_out, d_ws, 0, PH_COUNT, 0, DEPTH);
}
```

```cpp
#include <hip/hip_runtime.h>
#include <stdint.h>
#include <math.h>

typedef unsigned short bf16_t;
#define DI __device__ __forceinline__

constexpr int NB = 4, S = 4096, T = NB * S, D = 1024, DEPTH = 4;
constexpr int DIN = 11064;
constexpr int A_AQ = 0, A_AKV = 512, A_BCQ = 1280, A_BCKV = 1664, A_BKR = 1792, A_CQKV = 1824, LDA = 6432;
constexpr int B_ZA = 0, B_ZB = 512, B_ZC = 1024, B_GATE = 1536, LDB = 3104;
constexpr int B_MG8 = 3136;
constexpr int VB_MG = 1536, VB_GATE = 4608;
constexpr int NC = 255;
constexpr int CROWS = 2048;

constexpr size_t al256(size_t x) { return (x + 255) & ~(size_t)255; }
constexpr size_t WS_CTL = 0;
constexpr size_t WS_UA = 1 << 20;
constexpr size_t WS_UB = WS_UA + al256((size_t)T * LDA * 2);
constexpr size_t WS_H = WS_UB + al256((size_t)T * LDB * 2);
constexpr size_t WS_O7 = WS_H + al256((size_t)T * 1024 * 2);
constexpr size_t O7_STRIDE = (size_t)T * 512;
constexpr size_t WS_LSE = WS_O7 + al256(7 * O7_STRIDE * 2);
constexpr size_t WS_QM = WS_LSE + al256((size_t)3 * T * 8 * 4);
constexpr size_t WS_KVU = WS_QM + al256((size_t)T * 768 * 2);
constexpr size_t WS_FLAT = WS_KVU + al256((size_t)T * 1024 * 2);
constexpr size_t WS_KC = WS_FLAT + al256((size_t)2 * CROWS * 2048 * 2);
constexpr size_t WS_TAB = WS_KC + al256((size_t)2 * CROWS * 64 * 2);
constexpr size_t WS_SSQ = WS_TAB + al256((size_t)T * 48 * 4);
constexpr size_t WS_XB2 = WS_SSQ + al256((size_t)T * 4 * 4);
constexpr size_t WS_END = WS_XB2 + al256((size_t)T * 1024 * 2);
constexpr size_t WS_YMIXB = WS_UA;
constexpr size_t WS_Y2 = WS_YMIXB + (size_t)T * 1024 * 2;
static_assert(WS_Y2 + (size_t)T * 1024 * 4 <= WS_UB, "alias region fits in UA");
constexpr size_t WS_QN = WS_H;
constexpr size_t WS_KVN = WS_QN + (size_t)T * 384 * 2;
constexpr size_t WS_HIDP = WS_KVN + (size_t)T * 128 * 2;
static_assert(WS_HIDP + (size_t)4 * 2 * CROWS * 256 * 4 <= WS_O7, "H aliases");
constexpr size_t WS_EB = WS_O7 + 3 * O7_STRIDE * 2;

DI float bf2f(bf16_t v) { return __uint_as_float(((unsigned)v) << 16); }
DI bf16_t f2bf(float f) { unsigned u = __float_as_uint(f); u += 0x7fffu + ((u >> 16) & 1u); return (bf16_t)(u >> 16); }
DI float sigm(float x) { return 1.f / (1.f + __expf(-x)); }
DI float wave_sum(float v) { for (int o = 32; o > 0; o >>= 1) v += __shfl_xor(v, o); return v; }
DI float wave_max(float v) { for (int o = 32; o > 0; o >>= 1) v = fmaxf(v, __shfl_xor(v, o)); return v; }
DI float ldf(const float* p) { return *p; }
DI float ldf(const bf16_t* p) { return bf2f(*p); }


namespace pg8 {
#define PG8_LAS __attribute__((address_space(3)))
typedef unsigned short bf16_t;
typedef short bf16x8 __attribute__((ext_vector_type(8)));
typedef float f32x4 __attribute__((ext_vector_type(4)));
typedef unsigned u32x4 __attribute__((ext_vector_type(4)));
constexpr int BM = 256, BK = 64, HALF = 128, HTB = HALF * BK * 2  , STAGE_BYTES = 8 * HTB, NXCD = 8, WGM = 8;

__host__ __device__ __forceinline__ int lds_byte(int r, int c) { const int st = (r >> 4) * 2 + (c >> 5), rr = r & 15, cc = c & 31, ob = rr * 64 + cc * 2; return st * 1024 + (ob ^ (((ob >> 9) & 1) << 5)); }
__host__ __device__ __forceinline__ void stage_rc(int b, int& R, int& C) { const int st = b / 1024, sb = b % 1024, swz = sb ^ (((sb >> 9) & 1) << 5); R = (st >> 1) * 16 + swz / 64; C = (st & 1) * 32 + (swz % 64) / 2; }
__host__ __device__ __forceinline__ int perm32(int rho) { const int n = rho >> 4, i = rho & 15; return 8 * (i >> 2) + 4 * n + (i & 3); }

constexpr int HWTID_OFF = 131072 + 1024;
__device__ __forceinline__ unsigned hw_slot() { const unsigned h = (unsigned)__builtin_amdgcn_s_getreg((6 << 11) | (0 << 6) | 4); return h & 63u; }
__device__ __forceinline__ void hw_tid_init(PG8_LAS unsigned char* lds) { if ((threadIdx.x & 63) == 0) *(PG8_LAS unsigned*)(lds + HWTID_OFF + 4 * hw_slot()) = threadIdx.x >> 6; }
__device__ __forceinline__ int hw_tid(PG8_LAS unsigned char* lds) {
    const unsigned w = *(PG8_LAS unsigned*)(lds + HWTID_OFF + 4 * hw_slot());
    int lane; asm volatile("v_mbcnt_lo_u32_b32 %0, -1, 0\n\tv_mbcnt_hi_u32_b32 %0, -1, %0" : "=v"(lane));
    return (int)__builtin_amdgcn_readfirstlane(w) * 64 + lane;
}
struct Unit { int pm, pn; };
struct Gemm { const bf16_t* A; const bf16_t* Bt; int M, N, K; };

struct StaticOrder {
    int nM, nN, nwg, G, c;
    __host__ __device__ void init(int M, int N, int G_, int c_) { nM = M / BM; nN = N / BM; nwg = nM * nN; G = G_; c = c_; }
    __host__ __device__ bool next(int i, Unit& u) const {
        const long L = (long)i * G + c; if (L >= nwg) return false;
        int wgid = (int)L; { const int q = nwg / NXCD, r = nwg % NXCD, xcd = wgid % NXCD, off = wgid / NXCD; wgid = (xcd < r ? xcd * (q + 1) : r * (q + 1) + (xcd - r) * q) + off; }
        const int nig = WGM * nN, gid = wgid / nig, fm = gid * WGM, gsz = (nM - fm) < WGM ? (nM - fm) : WGM;
        u.pm = fm + ((wgid % nig) % gsz); u.pn = (wgid % nig) / gsz; return true;
    }
    __device__ __forceinline__ void a_ready(const Unit&) const {}
    __device__ __forceinline__ void done(const Unit&) const {}
};

__device__ __forceinline__ unsigned cvt_pk_bf16(float lo, float hi) { unsigned r; asm volatile("v_cvt_pk_bf16_f32 %0, %1, %2" : "=v"(r) : "v"(lo), "v"(hi)); return r; }

template <class Epi, class Sched, bool ALIGN_EPI = false, bool SP2 = false>
__device__ __forceinline__ void gemm_phase(PG8_LAS unsigned char* lds, const Gemm g, const Sched& S, const Epi& E) {
    int tid_ = hw_tid(lds); asm volatile("" : "+v"(tid_));
    const int tid = tid_, wid = __builtin_amdgcn_readfirstlane(tid >> 6), lane = tid & 63, wr = wid >> 2, wc = wid & 3, fr = lane & 15, fq = lane >> 4;
    int K_ = g.K; asm volatile("" : "+s"(K_));
    __builtin_assume(K_ >= 128 && K_ % 128 == 0);
    const int K = K_, nt = K / BK;
    unsigned voffA[2], voffB[2];
#pragma unroll
    for (int i = 0; i < 2; ++i) { int R, C; stage_rc(tid * 16 + i * 8192, R, C); const int Rb = Epi::PERM ? ((R & ~31) + perm32(R & 31)) : R;
        voffA[i] = (unsigned)(R * K + C) * 2u; voffB[i] = (unsigned)(Rb * K + C) * 2u; }
    const size_t kstep = (size_t)(BK * 2);
    const size_t hstep = (size_t)HALF * K * 2;
    const size_t tstep = 2 * hstep;
    const unsigned ldsw = (unsigned)wid * 1024u;
    const int aoff = lds_byte(wr * 64 + fr, fq * 8), boff = lds_byte(wc * 32 + fr, fq * 8);
#define PG8_SA(b, h) (((b) * 2 + (h)) * HTB)
#define PG8_SB(b, h) ((4 + (b) * 2 + (h)) * HTB)
#define PG8_STAGE(bufoff, gbase, voff) do { _Pragma("unroll") for (int _i = 0; _i < 2; ++_i) \
        __builtin_amdgcn_global_load_lds((const unsigned*)((const char*)(gbase) + (voff)[_i]), (PG8_LAS unsigned*)(lds + (bufoff) + ldsw + _i * 8192), 16, 0, 0); } while (0)
#define PG8_LDA(dst, b, h) do { _Pragma("unroll") for (int m = 0; m < 4; ++m) _Pragma("unroll") for (int k = 0; k < 2; ++k) dst[m][k] = *(const PG8_LAS bf16x8*)(lds + PG8_SA(b, h) + aoff + m * 2048 + k * 1024); } while (0)
#define PG8_LDB(dst, b, h) do { _Pragma("unroll") for (int n = 0; n < 2; ++n) _Pragma("unroll") for (int k = 0; k < 2; ++k) dst[n][k] = *(const PG8_LAS bf16x8*)(lds + PG8_SB(b, h) + boff + n * 2048 + k * 1024); } while (0)
#define PG8_MMA(ai, bj, At, Bt) do { __builtin_amdgcn_s_setprio(1); _Pragma("unroll") for (int m = 0; m < 4; ++m) _Pragma("unroll") for (int n = 0; n < 2; ++n) _Pragma("unroll") for (int k = 0; k < 2; ++k) \
        acc[ai][bj][m][n] = __builtin_amdgcn_mfma_f32_16x16x32_bf16(Bt[n][k], At[m][k], acc[ai][bj][m][n], 0, 0, 0); __builtin_amdgcn_s_setprio(0); } while (0)
#define PG8_WAIT_V(n) asm volatile("s_waitcnt vmcnt(" #n ")" ::: "memory")
#define PG8_WAIT_L(n) asm volatile("s_waitcnt lgkmcnt(" #n ")" ::: "memory")
#define PG8_BAR __builtin_amdgcn_s_barrier()
#define PG8_SCHED __builtin_amdgcn_sched_barrier(0)
    Unit cur, nxt; int ui = 0;
    if (!S.next(0, cur)) return;
    float zf_ = 0.f; asm volatile("" : "+v"(zf_));
    f32x4 acc[2][2][4][2];
#pragma unroll
    for (int a = 0; a < 2; ++a)
#pragma unroll
        for (int b = 0; b < 2; ++b)
#pragma unroll
            for (int m = 0; m < 4; ++m)
#pragma unroll
                for (int n = 0; n < 2; ++n) acc[a][b][m][n] = (f32x4){zf_, zf_, zf_, zf_};
    bf16x8 At[4][2], B0[2][2], B1[2][2];
    const char* cA = (const char*)g.A + (size_t)cur.pm * tstep; const char* cB = (const char*)g.Bt + (size_t)cur.pn * tstep;
    S.a_ready(cur);
    if constexpr (SP2) {
        PG8_STAGE(PG8_SB(0, 0), cB, voffB); PG8_STAGE(PG8_SB(0, 1), cB + hstep, voffB); PG8_STAGE(PG8_SA(0, 0), cA, voffA); PG8_STAGE(PG8_SA(0, 1), cA + hstep, voffA);
        if (wr == 1) PG8_BAR;
        PG8_WAIT_V(2); PG8_BAR;
        PG8_STAGE(PG8_SB(1, 0), cB + kstep, voffB); PG8_STAGE(PG8_SA(1, 0), cA + kstep, voffA); PG8_STAGE(PG8_SB(1, 1), cB + hstep + kstep, voffB);
        PG8_WAIT_V(6); PG8_BAR;
    } else {
        PG8_STAGE(PG8_SB(0, 0), cB, voffB); PG8_STAGE(PG8_SA(0, 0), cA, voffA); PG8_STAGE(PG8_SB(0, 1), cB + hstep, voffB); PG8_STAGE(PG8_SA(0, 1), cA + hstep, voffA);
        if (wr == 1) PG8_BAR;
        PG8_WAIT_V(4); PG8_BAR;
        PG8_STAGE(PG8_SB(1, 0), cB + kstep, voffB); PG8_STAGE(PG8_SA(1, 0), cA + kstep, voffA); PG8_STAGE(PG8_SB(1, 1), cB + hstep + kstep, voffB);
        PG8_WAIT_V(6); PG8_BAR;
    }
    for (;;) {
        const bool has_next = S.next(ui + 1, nxt);
        const char* nA = has_next ? (const char*)g.A + (size_t)nxt.pm * tstep : cA; const char* nB = has_next ? (const char*)g.Bt + (size_t)nxt.pn * tstep : cB;
        for (int t = 0; t < nt; t += 2) {
            const bool last = (t == nt - 2);
            const char* a1 = cA + (size_t)(t + 1) * kstep;
            const char* a2 = last ? nA : cA + (size_t)(t + 2) * kstep; const char* b2 = last ? nB : cB + (size_t)(t + 2) * kstep;
            const char* a3 = a2 + kstep; const char* b3 = b2 + kstep;
            if (last && has_next) S.a_ready(nxt);
            if constexpr (SP2) {
            PG8_LDB(B0, 0, 0); PG8_LDB(B1, 0, 1); PG8_SCHED; PG8_LDA(At, 0, 0); PG8_STAGE(PG8_SA(1, 1), a1 + hstep, voffA);
            PG8_WAIT_V(8); PG8_WAIT_L(0); PG8_BAR; PG8_MMA(0, 0, At, B0); PG8_MMA(0, 1, At, B1); PG8_BAR; PG8_SCHED;
            PG8_LDA(At, 0, 1); PG8_STAGE(PG8_SB(0, 0), b2, voffB); PG8_STAGE(PG8_SB(0, 1), b2 + hstep, voffB); PG8_STAGE(PG8_SA(0, 0), a2, voffA);
            PG8_WAIT_V(8); PG8_WAIT_L(0); PG8_BAR; PG8_MMA(1, 0, At, B0); PG8_MMA(1, 1, At, B1); PG8_BAR; PG8_SCHED;
            PG8_LDB(B0, 1, 0); PG8_LDB(B1, 1, 1); PG8_SCHED; PG8_LDA(At, 1, 0); PG8_STAGE(PG8_SA(0, 1), a2 + hstep, voffA);
            PG8_WAIT_V(8); PG8_WAIT_L(0); PG8_BAR; PG8_MMA(0, 0, At, B0); PG8_MMA(0, 1, At, B1); PG8_BAR; PG8_SCHED;
            PG8_LDA(At, 1, 1); PG8_STAGE(PG8_SB(1, 0), b3, voffB); PG8_STAGE(PG8_SB(1, 1), b3 + hstep, voffB); PG8_STAGE(PG8_SA(1, 0), a3, voffA);
            PG8_WAIT_V(8); PG8_WAIT_L(0); PG8_BAR; PG8_MMA(1, 0, At, B0); PG8_MMA(1, 1, At, B1); PG8_BAR; PG8_SCHED;
            } else {
            PG8_LDB(B0, 0, 0); PG8_SCHED; PG8_LDA(At, 0, 0); PG8_STAGE(PG8_SA(1, 1), a1 + hstep, voffA);
            PG8_WAIT_L(8); PG8_BAR; PG8_WAIT_L(0); PG8_MMA(0, 0, At, B0); PG8_BAR; PG8_SCHED;
            PG8_LDB(B1, 0, 1); PG8_STAGE(PG8_SB(0, 0), b2, voffB);
            PG8_BAR; PG8_WAIT_L(0); PG8_MMA(0, 1, At, B1); PG8_BAR;
            PG8_LDA(At, 0, 1); PG8_STAGE(PG8_SA(0, 0), a2, voffA);
            PG8_BAR; PG8_WAIT_L(0); PG8_MMA(1, 0, At, B0); PG8_BAR; PG8_SCHED;
            PG8_STAGE(PG8_SB(0, 1), b2 + hstep, voffB);
            PG8_WAIT_V(6); PG8_BAR; PG8_MMA(1, 1, At, B1); PG8_BAR;
            PG8_LDB(B0, 1, 0); PG8_SCHED; PG8_LDA(At, 1, 0); PG8_STAGE(PG8_SA(0, 1), a2 + hstep, voffA);
            PG8_WAIT_L(8); PG8_BAR; PG8_WAIT_L(0); PG8_MMA(0, 0, At, B0); PG8_BAR; PG8_SCHED;
            PG8_LDB(B1, 1, 1); PG8_STAGE(PG8_SB(1, 0), b3, voffB);
            PG8_BAR; PG8_WAIT_L(0); PG8_MMA(0, 1, At, B1); PG8_BAR;
            PG8_LDA(At, 1, 1); PG8_STAGE(PG8_SA(1, 0), a3, voffA);
            PG8_BAR; PG8_WAIT_L(0); PG8_MMA(1, 0, At, B0); PG8_BAR; PG8_SCHED;
            PG8_STAGE(PG8_SB(1, 1), b3 + hstep, voffB);
            PG8_WAIT_V(6); PG8_BAR; PG8_MMA(1, 1, At, B1); PG8_BAR;
            }
        }
        if constexpr (ALIGN_EPI) { if (wr == 0) PG8_BAR; }
        if constexpr (!Epi::AFTER_DRAIN) { E(acc, cur, wr, wc, fr, fq); S.done(cur); }
        if (!has_next) break;
#pragma unroll
        for (int a = 0; a < 2; ++a)
#pragma unroll
            for (int b = 0; b < 2; ++b)
#pragma unroll
                for (int m = 0; m < 4; ++m)
#pragma unroll
                    for (int n = 0; n < 2; ++n) acc[a][b][m][n] = (f32x4){zf_, zf_, zf_, zf_};
        asm volatile("" : "+v"(zf_));
        cur = nxt; cA = nA; cB = nB; ++ui;
        if constexpr (ALIGN_EPI) { if (wr == 1) PG8_BAR; }
    }
    PG8_WAIT_V(0);
    if constexpr (!ALIGN_EPI) { if (wr == 0) PG8_BAR; }
    PG8_BAR;
    if constexpr (Epi::AFTER_DRAIN) { E.fused(acc, cur, wr, wc, fr, fq, lds, wid, lane); S.done(cur); }
#undef PG8_SA
#undef PG8_SB
#undef PG8_STAGE
#undef PG8_LDA
#undef PG8_LDB
#undef PG8_MMA
#undef PG8_WAIT_V
#undef PG8_WAIT_L
#undef PG8_BAR
#undef PG8_SCHED
}
}

#define GAS __attribute__((address_space(1)))
#define LAS __attribute__((address_space(3)))
typedef float f32x4 __attribute__((ext_vector_type(4)));
typedef unsigned u32x4 __attribute__((ext_vector_type(4)));
constexpr int NWAVES = 8, NTHREADS = 512;
constexpr int RING_BYTES = 131072, LDSCTL_OFF = RING_BYTES, LDS_BYTES = 147456;
constexpr int NPAD = 11264;
constexpr size_t WO_WIN = 0;
constexpr size_t WO_WUQ = WO_WIN + (size_t)NPAD * 1024 * 2;
constexpr size_t WO_WUKV = WO_WUQ + (size_t)768 * 384 * 2;
constexpr size_t WO_W1 = WO_WUKV + (size_t)1024 * 128 * 2;
constexpr size_t WO_WABC = WO_W1 + (size_t)2 * 256 * 2048 * 2;
constexpr size_t WO_WOUT = WO_WABC + (size_t)3 * 1024 * 512 * 2;
constexpr size_t WO_WPLG = WO_WOUT + (size_t)1024 * 1024 * 2;
constexpr size_t WO_WPLE = WO_WPLG + (size_t)1024 * 1024 * 2;
constexpr size_t WO_PBF = WO_WPLE + (size_t)1024 * 256 * 2;
constexpr size_t WSET_BYTES = WO_PBF + (size_t)T * 256 * 2;
constexpr size_t WS_WSET = WS_END;
constexpr size_t WS_KV8 = WS_WSET + 2 * WSET_BYTES;
constexpr int KV8_LD = 3072;
constexpr size_t WS_END2 = WS_KV8 + (size_t)T * KV8_LD;
static_assert(WS_END2 <= (size_t)725090304, "fits the guaranteed workspace (4 x the largest tensor)");
constexpr int CW_BAR = 4096;
constexpr int CW_QUEUE = 16384;
constexpr size_t CTL_GRAN = 256 * 1024;

DI unsigned pk2(float lo, float hi) { return (unsigned)f2bf(lo) | ((unsigned)f2bf(hi) << 16); }
typedef float f32x2_t_ __attribute__((ext_vector_type(2))); typedef __bf16 bf16x2_t_ __attribute__((ext_vector_type(2)));
DI unsigned cvt2(float lo, float hi) { f32x2_t_ v = {lo, hi}; bf16x2_t_ b = __builtin_convertvector(v, bf16x2_t_); return __builtin_bit_cast(unsigned, b); }
DI u32x4 pack8(f32x4 a, f32x4 b) { u32x4 w; w.x = cvt2(a[0], a[1]); w.y = cvt2(a[2], a[3]); w.z = cvt2(b[0], b[1]); w.w = cvt2(b[2], b[3]); return w; }
DI float shx(float v, int lane, int m) { return __int_as_float(__builtin_amdgcn_ds_bpermute((lane ^ m) << 2, __float_as_int(v))); }
DI float sigf(float x) { return __builtin_amdgcn_rcpf(1.f + __expf(-x)); }
DI int epi_lane() { int lane; asm volatile("v_mbcnt_lo_u32_b32 %0, -1, 0\n\tv_mbcnt_hi_u32_b32 %0, -1, %0" : "=v"(lane)); return lane; }
DI float bflo(unsigned w) { return __uint_as_float(w << 16); }
DI float bfhi(unsigned w) { return __uint_as_float(w & 0xffff0000u); }

DI int win_rowmap(int c) {
    if (c < 512) return A_AQ + c;
    if (c < 1280) return A_AKV + c - 512;
    if (c < 1304) return LDA + VB_GATE + c - 1280;
    if (c < 1816) return LDA + B_ZA + c - 1304;
    if (c < 2200) return A_BCQ + c - 1816;
    if (c < 2328) return A_BCKV + c - 2200;
    if (c < 2360) return A_BKR + c - 2328;
    if (c < 2872) return LDA + B_ZB + c - 2360;
    if (c < 7480) return A_CQKV + c - 2872;
    if (c < 7992) return LDA + B_ZC + c - 7480;
    return LDA + VB_MG + c - 7992;
}
constexpr int WIN_VALID = LDA + VB_GATE + 24;

using pg8::Unit;
template <int V> struct EpiIC { static constexpr int value = V; };
struct EpiWin { static constexpr bool PERM = true, AFTER_DRAIN = false;
    bf16_t* ua; bf16_t* ub; const float* tab; unsigned char* kv8; bf16_t* dump;
    DI void operator()(const f32x4 (&acc)[2][2][4][2], const Unit& u, int wr, int wc, int, int) const {
        const int tl_ = epi_lane(); const int fr = tl_ & 15, fq = tl_ >> 4;
        const int lane = fr + 16 * fq;
        float rsr[8];
        { extern __shared__ __attribute__((aligned(16))) unsigned char lds_raw_w[];
          PG8_LAS const float* rsl = (PG8_LAS const float*)((PG8_LAS unsigned char*)lds_raw_w + LDSCTL_OFF + 8192) + (u.pm & 7) * 256 + wr * 64 + fr;
#pragma unroll
          for (int i = 0; i < 8; ++i) rsr[i] = rsl[(i >> 2) * 128 + (i & 3) * 16]; }
#pragma unroll
        for (int bj = 0; bj < 2; ++bj) {
            const int c32 = u.pn * 256 + bj * 128 + wc * 32;
            const int n0 = c32 + 8 * fq;
            int kind = 0;
            if (c32 < 512) kind = ((c32 & 63) == 0) ? 1 : 0;
            else if (c32 < 1280) kind = (((((c32 - 512) >> 7) & 1) == 0) && ((c32 & 63) == 0)) ? 1 : 0;
            else if (c32 >= A_BKR && c32 < A_CQKV) kind = 2;
            else if (c32 >= A_CQKV && c32 < LDA) { const int cc = c32 - A_CQKV; kind = (((cc % 1536) < 1024) && ((cc & 63) == 0)) ? 1 : 0; }
            bf16_t* dst; int ld;
            const int cb = c32 - LDA;
            const bool is_mg = cb >= VB_MG && cb < VB_GATE;
            if (n0 < LDA) { dst = ua + n0; ld = LDA; } else if (cb < VB_MG) { dst = ub + (n0 - LDA); ld = LDB; } else { dst = ub + B_GATE + (n0 - LDA - VB_GATE); ld = LDB; }
            if (is_mg) { dst = (bf16_t*)((unsigned char*)ub + B_MG8 + (n0 - LDA - VB_MG)); ld = LDB; }
            bool is_f8 = is_mg; size_t ldb8 = (size_t)LDB * 2;
            if (c32 >= A_CQKV && c32 < LDA) { const int cc = c32 - A_CQKV, gi_ = cc / 1536, wi = cc - 1536 * gi_;
                if (wi >= 512) { const int kvs = (wi >= 1024) ? 1 : 0, hc = wi - 512 - 512 * kvs;
                    is_f8 = true; ldb8 = KV8_LD; dst = (bf16_t*)(kv8 + gi_ * 1024 + (hc >> 6) * 128 + kvs * 64 + (hc & 63) + 8 * fq); } }
            const bool wr_ok = n0 < WIN_VALID;
            const float qs = (c32 < 512 || (c32 >= A_CQKV && c32 < LDA && ((c32 - A_CQKV) % 1536) < 512)) ? 0.125f * 1.4426950408889634f : 1.f;
            auto pieces = [&](auto kind_c, auto f8_c) {
                constexpr int KIND = decltype(kind_c)::value; constexpr bool F8 = decltype(f8_c)::value != 0;
                f32x4 tn[4];
#pragma unroll
                for (int q = 0; q < 4; ++q) tn[q] = (f32x4){0.f, 0.f, 0.f, 0.f};
                auto tload = [&](int idx) { const int row_ = u.pm * 256 + (idx >> 2) * 128 + wr * 64 + (idx & 3) * 16 + fr;
                    if (KIND == 1) { const float* tb = tab + (size_t)row_ * 48; tn[0] = *(const f32x4*)(tb); tn[1] = *(const f32x4*)(tb + 4); tn[2] = *(const f32x4*)(tb + 8); tn[3] = *(const f32x4*)(tb + 12); }
                    else if (KIND == 2) { const float* tb = tab + (size_t)row_ * 48 + 16 + (fq & 1) * 8; tn[0] = *(const f32x4*)(tb); tn[1] = *(const f32x4*)(tb + 4); tn[2] = *(const f32x4*)(tb + 16); tn[3] = *(const f32x4*)(tb + 20); } };
                if (KIND != 0) tload(0);
#pragma unroll
                for (int ai = 0; ai < 2; ++ai)
#pragma unroll
                    for (int m = 0; m < 4; ++m) { __builtin_amdgcn_sched_barrier(0);
                        const int row = u.pm * 256 + ai * 128 + wr * 64 + m * 16 + fr;
                        const f32x4 c0 = tn[0], c1 = tn[1], s0 = tn[2], s1 = tn[3];
                        if (KIND != 0 && ai * 4 + m + 1 < 8) tload(ai * 4 + m + 1);
                        __builtin_amdgcn_sched_barrier(0);
                        f32x4 v0 = acc[ai][bj][m][0] * (rsr[ai * 4 + m] * qs), v1 = acc[ai][bj][m][1] * (rsr[ai * 4 + m] * qs);
                        if (KIND == 1) {
                            f32x4 p0, p1;
#pragma unroll
                            for (int e = 0; e < 4; ++e) { p0[e] = shx(v0[e], lane, 16); p1[e] = shx(v1[e], lane, 16); }
                            const float sg = (fq == 0) ? -1.f : 1.f;
                            const f32x4 r0 = v0 * c0 + sg * (p0 * s0), r1 = v1 * c1 + sg * (p1 * s1);
                            if (fq < 2) { v0 = r0; v1 = r1; }
                        } else if (KIND == 2) {
                            f32x4 p0, p1;
#pragma unroll
                            for (int e = 0; e < 4; ++e) { p0[e] = shx(v0[e], lane, 32); p1[e] = shx(v1[e], lane, 32); }
                            const float sg = (fq < 2) ? -1.f : 1.f;
                            v0 = v0 * c0 + sg * (p0 * s0); v1 = v1 * c1 + sg * (p1 * s1);
                        }
                        if (F8) { int w0 = 0, w1 = 0;
#pragma unroll
                            for (int e = 0; e < 4; ++e) { v0[e] = __builtin_amdgcn_fmed3f(v0[e], -448.f, 448.f); v1[e] = __builtin_amdgcn_fmed3f(v1[e], -448.f, 448.f); }
                            w0 = __builtin_amdgcn_cvt_pk_fp8_f32(v0[0], v0[1], w0, false); w0 = __builtin_amdgcn_cvt_pk_fp8_f32(v0[2], v0[3], w0, true);
                            w1 = __builtin_amdgcn_cvt_pk_fp8_f32(v1[0], v1[1], w1, false); w1 = __builtin_amdgcn_cvt_pk_fp8_f32(v1[2], v1[3], w1, true);
                            *(unsigned long long*)((unsigned char*)dst + (size_t)row * ldb8) = (unsigned long long)(unsigned)w0 | ((unsigned long long)(unsigned)w1 << 32); }
                        else { bf16_t* const pp = wr_ok ? dst + (size_t)row * ld : dump + 8 * lane;
                            *(u32x4*)pp = pack8(v0, v1); }
                    }
            };
            if (kind == 1) { if (is_f8) pieces(EpiIC<1>{}, EpiIC<1>{}); else pieces(EpiIC<1>{}, EpiIC<0>{}); }
            else if (kind == 2) pieces(EpiIC<2>{}, EpiIC<0>{});
            else { if (is_f8) pieces(EpiIC<0>{}, EpiIC<1>{}); else pieces(EpiIC<0>{}, EpiIC<0>{}); }
        }
    }
};
struct EpiQm { static constexpr bool PERM = true, AFTER_DRAIN = false;
    bf16_t* qm; const float* tab;
    DI void operator()(const f32x4 (&acc)[2][2][4][2], const Unit& u, int wr, int wc, int, int) const {
        const int tl_ = epi_lane(); const int fr = tl_ & 15, fq = tl_ >> 4;
        const int lane = fr + 16 * fq;
#pragma unroll
        for (int bj = 0; bj < 2; ++bj) {
            const int c32 = u.pn * 256 + bj * 128 + wc * 32;
            const int n0 = c32 + 8 * fq;
            const bool rope = ((c32 >> 5) % 3) == 2;
#pragma unroll
            for (int ai = 0; ai < 2; ++ai) {
                f32x4 tc0[4], tc1[4], ts0[4], ts1[4];
                if (rope) {
#pragma unroll
                    for (int m = 0; m < 4; ++m) { const float* tb = tab + (size_t)(u.pm * 256 + ai * 128 + wr * 64 + m * 16 + fr) * 48 + 16 + (fq & 1) * 8;
                        tc0[m] = *(const f32x4*)(tb); tc1[m] = *(const f32x4*)(tb + 4); ts0[m] = *(const f32x4*)(tb + 16); ts1[m] = *(const f32x4*)(tb + 20); }
                }
#pragma unroll
                for (int m = 0; m < 4; ++m) {
                    const int row = u.pm * 256 + ai * 128 + wr * 64 + m * 16 + fr;
                    f32x4 v0 = acc[ai][bj][m][0] * (0.10206207261596577f * 1.4426950408889634f), v1 = acc[ai][bj][m][1] * (0.10206207261596577f * 1.4426950408889634f);
                    if (rope) {
                        f32x4 p0, p1;
#pragma unroll
                        for (int e = 0; e < 4; ++e) { p0[e] = shx(v0[e], lane, 32); p1[e] = shx(v1[e], lane, 32); }
                        const float sg = (fq < 2) ? -1.f : 1.f;
                        v0 = v0 * tc0[m] + sg * (p0 * ts0[m]); v1 = v1 * tc1[m] + sg * (p1 * ts1[m]);
                    }
                    *(u32x4*)(qm + (size_t)row * 768 + n0) = pack8(v0, v1);
                }
            }
        }
    }
};
struct EpiBfPlain { static constexpr bool PERM = true, AFTER_DRAIN = false;
    bf16_t* c; int ldc; int pad;
    DI void operator()(const f32x4 (&acc)[2][2][4][2], const Unit& u, int wr, int wc, int, int) const {
        const int tl_ = epi_lane(); const int fr = tl_ & 15, fq = tl_ >> 4;
#pragma unroll
        for (int bj = 0; bj < 2; ++bj) { const int n0 = u.pn * 256 + bj * 128 + wc * 32 + 8 * fq;
#pragma unroll
            for (int ai = 0; ai < 2; ++ai)
#pragma unroll
                for (int m = 0; m < 4; ++m) { __builtin_amdgcn_sched_barrier(0); const int row = u.pm * 256 + ai * 128 + wr * 64 + m * 16 + fr;
                    *(u32x4*)(c + (size_t)row * ldc + n0) = pack8(acc[ai][bj][m][0], acc[ai][bj][m][1]); } }
    }
};
template <int ACT  > struct EpiF32 { static constexpr bool PERM = true, AFTER_DRAIN = false;
    float* c; int ldc; int pnmask;
    DI void operator()(const f32x4 (&acc)[2][2][4][2], const Unit& u, int wr, int wc, int, int) const {
        const int tl_ = epi_lane(); const int fr = tl_ & 15, fq = tl_ >> 4;
#pragma unroll
        for (int bj = 0; bj < 2; ++bj) { const int n0 = (u.pn & pnmask) * 256 + bj * 128 + wc * 32 + 8 * fq;
#pragma unroll
            for (int ai = 0; ai < 2; ++ai)
#pragma unroll
                for (int m = 0; m < 4; ++m) { __builtin_amdgcn_sched_barrier(0); const int row = u.pm * 256 + ai * 128 + wr * 64 + m * 16 + fr;
                    f32x4 v0 = acc[ai][bj][m][0], v1 = acc[ai][bj][m][1];
                    if (ACT == 1) {
#pragma unroll
                        for (int e = 0; e < 4; ++e) { v0[e] = v0[e] * sigf(v0[e]); v1[e] = v1[e] * sigf(v1[e]); } }
                    float* p = c + (size_t)row * ldc + n0; *(f32x4*)p = v0; *(f32x4*)(p + 4) = v1; } }
    }
};
struct EpiYabc { static constexpr bool PERM = true, AFTER_DRAIN = false;
    bf16_t* ymixb; const bf16_t* ub;
    DI void operator()(const f32x4 (&acc)[2][2][4][2], const Unit& u, int wr, int wc, int, int) const {
        const int tl_ = epi_lane(); const int fr = tl_ & 15, fq = tl_ >> 4;
        const int x = u.pm >> 6, pm = u.pm & 63, pn = u.pn & 3;
        const int row0 = pm * 256 + wr * 64 + fr, n00 = pn * 256 + wc * 32 + 8 * fq;
        unsigned long long g8[2][2][4];
#pragma unroll
        for (int bj = 0; bj < 2; ++bj)
#pragma unroll
            for (int ai = 0; ai < 2; ++ai)
#pragma unroll
                for (int m = 0; m < 4; ++m) g8[bj][ai][m] = *(const unsigned long long*)((const unsigned char*)ub + (size_t)(row0 + ai * 128 + m * 16) * (LDB * 2) + B_MG8 + x * 1024 + n00 + bj * 128);
        f32x4 v[2][2][4][2];
#pragma unroll
        for (int bj = 0; bj < 2; ++bj)
#pragma unroll
            for (int ai = 0; ai < 2; ++ai)
#pragma unroll
                for (int m = 0; m < 4; ++m) { const int glo = (int)(unsigned)g8[bj][ai][m], ghi = (int)(unsigned)(g8[bj][ai][m] >> 32);
                    f32x4 g0, g1; g0[0] = sigf(__builtin_amdgcn_cvt_f32_fp8(glo, 0)); g0[1] = sigf(__builtin_amdgcn_cvt_f32_fp8(glo, 1)); g0[2] = sigf(__builtin_amdgcn_cvt_f32_fp8(glo, 2)); g0[3] = sigf(__builtin_amdgcn_cvt_f32_fp8(glo, 3));
                    g1[0] = sigf(__builtin_amdgcn_cvt_f32_fp8(ghi, 0)); g1[1] = sigf(__builtin_amdgcn_cvt_f32_fp8(ghi, 1)); g1[2] = sigf(__builtin_amdgcn_cvt_f32_fp8(ghi, 2)); g1[3] = sigf(__builtin_amdgcn_cvt_f32_fp8(ghi, 3));
                    v[bj][ai][m][0] = acc[ai][bj][m][0] * g0; v[bj][ai][m][1] = acc[ai][bj][m][1] * g1; }
        if (x > 0) {
            u32x4 gw[2][2][4];
#pragma unroll
            for (int bj = 0; bj < 2; ++bj)
#pragma unroll
                for (int ai = 0; ai < 2; ++ai)
#pragma unroll
                    for (int m = 0; m < 4; ++m) gw[bj][ai][m] = *(const u32x4*)(ymixb + (size_t)(row0 + ai * 128 + m * 16) * D + n00 + bj * 128);
#pragma unroll
            for (int bj = 0; bj < 2; ++bj)
#pragma unroll
                for (int ai = 0; ai < 2; ++ai)
#pragma unroll
                    for (int m = 0; m < 4; ++m) { const u32x4 q = gw[bj][ai][m];
                        v[bj][ai][m][0][0] += bflo(q.x); v[bj][ai][m][0][1] += bfhi(q.x); v[bj][ai][m][0][2] += bflo(q.y); v[bj][ai][m][0][3] += bfhi(q.y);
                        v[bj][ai][m][1][0] += bflo(q.z); v[bj][ai][m][1][1] += bfhi(q.z); v[bj][ai][m][1][2] += bflo(q.w); v[bj][ai][m][1][3] += bfhi(q.w); }
        }
#pragma unroll
        for (int bj = 0; bj < 2; ++bj)
#pragma unroll
            for (int ai = 0; ai < 2; ++ai)
#pragma unroll
                for (int m = 0; m < 4; ++m) *(u32x4*)(ymixb + (size_t)(row0 + ai * 128 + m * 16) * D + n00 + bj * 128) = pack8(v[bj][ai][m][0], v[bj][ai][m][1]);
    }
};
struct EpiPlgF { static constexpr bool PERM = true, AFTER_DRAIN = false;
    const bf16_t* xh; float* xo; const bf16_t* e; bf16_t* xb2; float* ssq;
    DI void operator()(const f32x4 (&acc)[2][2][4][2], const Unit& u, int wr, int wc, int, int) const {
        const int tl_ = epi_lane(); const int fr = tl_ & 15, fq = tl_ >> 4;
        extern __shared__ __attribute__((aligned(16))) unsigned char lds_raw_e[];
        PG8_LAS float* red = (PG8_LAS float*)((PG8_LAS unsigned char*)lds_raw_e + LDSCTL_OFF + 4096);
        const int n00 = u.pn * 256 + wc * 32 + 8 * fq;
#pragma unroll
        for (int ai = 0; ai < 2; ++ai) {
            u32x4 ew[4][2], xw[4][2];
#pragma unroll
            for (int m = 0; m < 4; ++m)
#pragma unroll
                for (int bj = 0; bj < 2; ++bj) { const size_t o = (size_t)(u.pm * 256 + ai * 128 + wr * 64 + m * 16 + fr) * D + n00 + bj * 128;
                    ew[m][bj] = *(const u32x4*)(e + o); xw[m][bj] = *(const u32x4*)(xh + o); }
#pragma unroll
            for (int m = 0; m < 4; ++m) {
                float sq = 0.f;
#pragma unroll
                for (int bj = 0; bj < 2; ++bj) { const size_t o = (size_t)(u.pm * 256 + ai * 128 + wr * 64 + m * 16 + fr) * D + n00 + bj * 128;
                    const f32x4 v0 = acc[ai][bj][m][0], v1 = acc[ai][bj][m][1]; const u32x4 w = ew[m][bj], xq = xw[m][bj];
                    const f32x4 e0 = {bflo(w.x), bfhi(w.x), bflo(w.y), bfhi(w.y)}, e1 = {bflo(w.z), bfhi(w.z), bflo(w.w), bfhi(w.w)};
                    f32x4 x0 = {bflo(xq.x), bfhi(xq.x), bflo(xq.y), bfhi(xq.y)}, x1 = {bflo(xq.z), bfhi(xq.z), bflo(xq.w), bfhi(xq.w)};
#pragma unroll
                    for (int k = 0; k < 4; ++k) { x0[k] += sigf(v0[k]) * e0[k]; x1[k] += sigf(v1[k]) * e1[k]; sq += x0[k] * x0[k] + x1[k] * x1[k]; }
                    if (xo) { *(f32x4*)(xo + o) = x0; *(f32x4*)(xo + o + 4) = x1; }
                    else *(u32x4*)(xb2 + o) = pack8(x0, x1); }
                sq += shx(sq, tl_, 16); sq += shx(sq, tl_, 32);
                if (fq == 0) red[(ai * 128 + wr * 64 + m * 16 + fr) * 4 + wc] = sq;
            }
            __builtin_amdgcn_sched_barrier(0);
        }
        asm volatile("s_waitcnt lgkmcnt(0)" ::: "memory"); __builtin_amdgcn_s_barrier(); asm volatile("" ::: "memory");
        { const int t = (wr * 4 + wc) * 64 + tl_;
          if (t < 256) { const f32x4 q = *(PG8_LAS const f32x4*)(red + 4 * t); ssq[(size_t)(u.pm * 256 + t) * 4 + u.pn] = (q[0] + q[1]) + (q[2] + q[3]); } }
    }
};
struct EpiPost { static constexpr bool PERM = true, AFTER_DRAIN = false;
    const bf16_t* xsrc; const float* g; bf16_t* hb; unsigned long long* gran; unsigned epoch; int pad;
    DI void operator()(const f32x4 (&acc)[2][2][4][2], const Unit& u, int wr, int wc, int, int) const {
        const int tl_ = epi_lane(); const int fr = tl_ & 15, fq = tl_ >> 4;
        extern __shared__ __attribute__((aligned(16))) unsigned char lds_raw_p[];
        PG8_LAS float* red = (PG8_LAS float*)((PG8_LAS unsigned char*)lds_raw_p + LDSCTL_OFF + 4096);
        PG8_LAS float* rsl = red + 1024;
#pragma unroll
        for (int ai = 0; ai < 2; ++ai)
#pragma unroll
            for (int m = 0; m < 4; ++m) { float sq = 0.f;
#pragma unroll
                for (int bj = 0; bj < 2; ++bj) { const f32x4 v0 = acc[ai][bj][m][0], v1 = acc[ai][bj][m][1];
                    sq += ((v0[0] * v0[0] + v0[1] * v0[1]) + (v0[2] * v0[2] + v0[3] * v0[3])) + ((v1[0] * v1[0] + v1[1] * v1[1]) + (v1[2] * v1[2] + v1[3] * v1[3])); }
                sq += shx(sq, tl_, 16); sq += shx(sq, tl_, 32);
                if (fq == 0) red[(ai * 128 + wr * 64 + m * 16 + fr) * 4 + wc] = sq; }
        asm volatile("s_waitcnt lgkmcnt(0)" ::: "memory"); __builtin_amdgcn_s_barrier(); asm volatile("" ::: "memory");
        { const int t = (wr * 4 + wc) * 64 + tl_;
          if (t < 256) {
              const f32x4 q = *(PG8_LAS const f32x4*)(red + 4 * t); const float part = (q[0] + q[1]) + (q[2] + q[3]);
              typedef __attribute__((address_space(1))) unsigned long long gu64_t;
              gu64_t* gp = (gu64_t*)gran + (size_t)(u.pm * 256 + t) * 4;
              __hip_atomic_store(gp + u.pn, ((unsigned long long)epoch << 32) | (unsigned long long)__float_as_uint(part), __ATOMIC_RELAXED, __HIP_MEMORY_SCOPE_AGENT);
              float tot = 0.f;
              for (unsigned spin = 0; spin < (1u << 20); ++spin) {
                  const unsigned long long a0 = __hip_atomic_load(gp + 0, __ATOMIC_RELAXED, __HIP_MEMORY_SCOPE_AGENT), a1 = __hip_atomic_load(gp + 1, __ATOMIC_RELAXED, __HIP_MEMORY_SCOPE_AGENT);
                  const unsigned long long a2 = __hip_atomic_load(gp + 2, __ATOMIC_RELAXED, __HIP_MEMORY_SCOPE_AGENT), a3 = __hip_atomic_load(gp + 3, __ATOMIC_RELAXED, __HIP_MEMORY_SCOPE_AGENT);
                  tot = (__uint_as_float((unsigned)a0) + __uint_as_float((unsigned)a1)) + (__uint_as_float((unsigned)a2) + __uint_as_float((unsigned)a3));
                  if ((unsigned)(a0 >> 32) == epoch && (unsigned)(a1 >> 32) == epoch && (unsigned)(a2 >> 32) == epoch && (unsigned)(a3 >> 32) == epoch) break;
                  __builtin_amdgcn_s_sleep(2);
              }
              rsl[t] = rsqrtf(tot * (1.f / 1024.f) + 1e-6f);
          } }
        asm volatile("s_waitcnt lgkmcnt(0)" ::: "memory"); __builtin_amdgcn_s_barrier(); asm volatile("" ::: "memory");
        const int n00 = u.pn * 256 + wc * 32 + 8 * fq;
        f32x4 gg[2][2];
#pragma unroll
        for (int bj = 0; bj < 2; ++bj) { gg[bj][0] = *(const f32x4*)(g + n00 + bj * 128); gg[bj][1] = *(const f32x4*)(g + n00 + bj * 128 + 4); }
        u32x4 xw[2][4][2];
#pragma unroll
        for (int ai = 0; ai < 2; ++ai)
#pragma unroll
            for (int m = 0; m < 4; ++m)
#pragma unroll
                for (int bj = 0; bj < 2; ++bj) xw[ai][m][bj] = *(const u32x4*)(xsrc + (size_t)(u.pm * 256 + ai * 128 + wr * 64 + m * 16 + fr) * D + n00 + bj * 128);
#pragma unroll
        for (int ai = 0; ai < 2; ++ai)
#pragma unroll
            for (int m = 0; m < 4; ++m) { const int rl = ai * 128 + wr * 64 + m * 16 + fr; const float rs = rsl[rl];
#pragma unroll
                for (int bj = 0; bj < 2; ++bj) { const size_t o = (size_t)(u.pm * 256 + rl) * D + n00 + bj * 128; const u32x4 w = xw[ai][m][bj];
                    const f32x4 xa = {bflo(w.x), bfhi(w.x), bflo(w.y), bfhi(w.y)}, xb = {bflo(w.z), bfhi(w.z), bflo(w.w), bfhi(w.w)};
                    const f32x4 x0 = xa + acc[ai][bj][m][0] * rs * gg[bj][0], x1 = xb + acc[ai][bj][m][1] * rs * gg[bj][1];
                    *(u32x4*)(hb + o) = pack8(x0, x1); } }
    }
};
struct YabcOrder {
    int G, vcu;
    DI bool next(int i, Unit& u) const { const int tile = (i / 3) * G + vcu, x = i % 3; if (tile >= 256) return false; u.pm = x * 64 + (tile >> 2); u.pn = x * 4 + (tile & 3); return true; }
    DI void a_ready(const Unit&) const {}
    DI void done(const Unit&) const {}
};
struct HidOrder {
    int G, c;
    DI bool next(int i, Unit& u) const { const int id = c - (G - 64); if (i > 0 || id < 0) return false; u.pm = (id >> 3) * 8 + (id & 7); u.pn = id >> 3; return true; }
    DI void a_ready(const Unit&) const {}
    DI void done(const Unit&) const {}
};
DI void tr_item(const float* W, int K, int N, bf16_t* WT, LAS unsigned char* scr, int item, int lane, bool perm, const float* gk) {
    const int nblk = (N + 63) / 64, kb = item / nblk, nb = item % nblk, k0 = 64 * kb, n0 = 64 * nb;
    const int nn = n0 + lane; const bool ok = nn < N;
    const float* wp = W + (size_t)k0 * N + (ok ? nn : 0);
    float v[64];
#pragma unroll
    for (int i = 0; i < 64; ++i) v[i] = wp[(size_t)i * N];
#pragma unroll
    for (int i = 0; i < 32; ++i) { const float g0 = gk ? gk[k0 + 2 * i] : 1.f, g1 = gk ? gk[k0 + 2 * i + 1] : 1.f;
        *(LAS unsigned*)(scr + lane * 132 + 4 * i) = ok ? pk2(v[2 * i] * g0, v[2 * i + 1] * g1) : 0u; }
    asm volatile("s_waitcnt lgkmcnt(0)" ::: "memory");
    const int c = lane & 7;
#pragma unroll
    for (int j = 0; j < 8; ++j) { const int n = (lane >> 3) + 8 * j; LAS const unsigned* s = (LAS const unsigned*)(scr + n * 132 + 16 * c);
        u32x4 o; o.x = s[0]; o.y = s[1]; o.z = s[2]; o.w = s[3];
        if (n0 + n < N) { const int rr = perm ? win_rowmap(n0 + n) : (n0 + n); *(u32x4*)(WT + (size_t)rr * K + k0 + 8 * c) = o; } }
    asm volatile("s_waitcnt lgkmcnt(0)" ::: "memory");
}
struct RmIdent { int off; DI int operator()(int n) const { return off + n; } };
struct RmWin { DI int operator()(int n) const { return win_rowmap(n); } };

DI float wsum(float v, int lane) {
#pragma unroll
    for (int o = 1; o < 64; o <<= 1) v += shx(v, lane, o);
    return v;
}
DI void rms_row_f32(const float* xrow, const float* g, bf16_t* orow, int lane) {
    const f32x4* xr = (const f32x4*)xrow + lane; const f32x4* gr = (const f32x4*)g + lane;
    f32x4 v[4]; float s = 0.f;
#pragma unroll
    for (int j = 0; j < 4; ++j) { v[j] = xr[64 * j]; s += (v[j][0] * v[j][0] + v[j][1] * v[j][1]) + (v[j][2] * v[j][2] + v[j][3] * v[j][3]); }
    const float rs = rsqrtf(wsum(s, lane) * (1.f / 1024.f) + 1e-6f);
    unsigned long long* o8 = (unsigned long long*)orow + lane;
#pragma unroll
    for (int j = 0; j < 4; ++j) { const f32x4 gg = gr[64 * j];
        o8[64 * j] = (unsigned long long)pk2(v[j][0] * rs * gg[0], v[j][1] * rs * gg[1]) | ((unsigned long long)pk2(v[j][2] * rs * gg[2], v[j][3] * rs * gg[3]) << 32); }
}

constexpr int CI_IN = 16 * 173, CI_UQ = 6 * 12, CI_UKV = 2 * 16, CI_W1 = 32 * 4, CI_ABC = 8 * 16, CI_OUT = 16 * 16, CI_PLE = 4 * 16;
constexpr int CI_NTR = CI_IN + CI_UQ + CI_UKV + 2 * CI_W1 + 3 * CI_ABC + 2 * CI_OUT + CI_PLE;
constexpr int CB_TOTAL = 256;
static_assert(CI_NTR <= CB_TOTAL * 16 && T * 256 / 8 == CB_TOTAL * 2048 && (NPAD - WIN_VALID) * 1024 / 8 == CB_TOTAL * 100, "conversion work splits evenly");
typedef __attribute__((address_space(4))) const char* kptr2_t;
DI const float* conv_in(int idx) { kptr2_t p = (kptr2_t)__builtin_amdgcn_kernarg_segment_ptr(); asm volatile("" : "+s"(p)); typedef const float* fp_t; return *(__attribute__((address_space(4))) const fp_t*)(p + 8 * idx); }
DI void conv_block_item(LAS unsigned char* lds, int tid, int bi, int Lc, unsigned char* wset) {
    const int lane = tid & 63, wave = __builtin_amdgcn_readfirstlane(tid >> 6);
    {
        const float* ps = conv_in(1) + (size_t)Lc * T * 256; bf16_t* PBF = (bf16_t*)(wset + WO_PBF);
#pragma unroll
        for (int q = 0; q < 4; ++q) { const size_t i = (size_t)bi * 2048 + q * 512 + tid;
            const f32x4 a = *(const f32x4*)(ps + i * 8), b = *(const f32x4*)(ps + i * 8 + 4);
            u32x4 w; w.x = pk2(a[0], a[1]); w.y = pk2(a[2], a[3]); w.z = pk2(b[0], b[1]); w.w = pk2(b[2], b[3]); *(u32x4*)(PBF + i * 8) = w; }
        if (tid < 100) { unsigned z0 = 0u; asm volatile("" : "+v"(z0)); const u32x4 z = {z0, z0, z0, z0};
            *(u32x4*)((bf16_t*)(wset + WO_WIN) + (size_t)WIN_VALID * 1024 + ((size_t)bi * 100 + tid) * 8) = z; }
    }
    LAS unsigned char* scr = lds + wave * 16384;
#pragma unroll 1
    for (int q = 0; q < 2; ++q) {
        int r = bi * 16 + q * 8 + wave; if (r >= CI_NTR) break;
        int widx; size_t soff, doff; int K_, N_; bool perm = false;
        if (r < CI_IN) { widx = 5; soff = (size_t)Lc * D * DIN; doff = WO_WIN; K_ = D; N_ = DIN; perm = true; }
        else if ((r -= CI_IN) < CI_UQ) { widx = 11; soff = (size_t)Lc * 384 * 768; doff = WO_WUQ; K_ = 384; N_ = 768; }
        else if ((r -= CI_UQ) < CI_UKV) { widx = 13; soff = (size_t)Lc * 128 * 1024; doff = WO_WUKV; K_ = 128; N_ = 1024; }
        else if ((r -= CI_UKV) < 2 * CI_W1) { const int kv = r / CI_W1; r %= CI_W1; const int ks = r / 32;
            widx = 7; soff = ((size_t)Lc * 2 + kv) * 2048 * 256 + (size_t)ks * 512 * 256; doff = WO_W1 + (size_t)(ks * 2 + kv) * 256 * 512 * 2; K_ = 512; N_ = 256; r %= 32; }
        else if ((r -= 2 * CI_W1) < 3 * CI_ABC) { const int x = r / CI_ABC; r %= CI_ABC; widx = (x == 0) ? 9 : (x == 1) ? 14 : 15; soff = (size_t)Lc * 512 * D; doff = WO_WABC + (size_t)x * 1024 * 512 * 2; K_ = 512; N_ = D; }
        else if ((r -= 3 * CI_ABC) < CI_OUT) { widx = 16; soff = (size_t)Lc * D * D; doff = WO_WOUT; K_ = D; N_ = D; }
        else if ((r -= CI_OUT) < CI_OUT) { widx = 18; soff = (size_t)Lc * D * D; doff = WO_WPLG; K_ = D; N_ = D; }
        else { r -= CI_OUT; widx = 17; soff = (size_t)Lc * 256 * D; doff = WO_WPLE; K_ = 256; N_ = D; }
        tr_item(conv_in(widx) + soff, K_, N_, (bf16_t*)(wset + doff), scr, r, lane, perm, perm ? conv_in(3) + (size_t)Lc * D : nullptr);
    }
}

namespace fa {
typedef short bf16x8 __attribute__((ext_vector_type(8)));
typedef float f32x16 __attribute__((ext_vector_type(16)));
typedef short v4i16 __attribute__((ext_vector_type(4)));
constexpr int KCS = 1040, VPS = 1040;
constexpr int KBUF = 0, KBUF_SZ = 12800, VBUF = 25600, VBUF_SZ = 8448, OVBUF = 42496, IMP_OFF = 51200, IMP_LD = 65, SELM_OFF = IMP_OFF + 4 * 64 * IMP_LD * 4, UNI_OFF = SELM_OFF + 512, WQ_OFF = UNI_OFF + 64, PM_OFF = WQ_OFF + 16, GATE_OFF = 120832;
static_assert(WQ_OFF + 64 <= GATE_OFF && GATE_OFF + 512 * 8 <= 131072, "attention LDS map");
constexpr float LOG2E = 1.4426950408889634f;

DI int crow(int r, int hi) { return (r & 3) + 8 * (r >> 2) + 4 * hi; }
DI float xhalf_max(float v) { auto rr = __builtin_amdgcn_permlane32_swap(__float_as_uint(v), __float_as_uint(v), false, false); return fmaxf(__uint_as_float(rr[0]), __uint_as_float(rr[1])); }
DI float xhalf_sum(float v) { auto rr = __builtin_amdgcn_permlane32_swap(__float_as_uint(v), __float_as_uint(v), false, false); return __uint_as_float(rr[0]) + __uint_as_float(rr[1]); }
typedef float f32x2_t __attribute__((ext_vector_type(2))); typedef __bf16 bf16x2_t __attribute__((ext_vector_type(2)));
DI unsigned cvtpk(float lo, float hi) { f32x2_t v = {lo, hi}; bf16x2_t b = __builtin_convertvector(v, bf16x2_t); return __builtin_bit_cast(unsigned, b); }

DI u32x4 fp8x8_to_bf16x8(unsigned long long w) {
    const unsigned lo = (unsigned)w, hi = (unsigned)(w >> 32);
    const f32x2_t a = __builtin_amdgcn_cvt_pk_f32_fp8(lo, false), b = __builtin_amdgcn_cvt_pk_f32_fp8(lo, true), c = __builtin_amdgcn_cvt_pk_f32_fp8(hi, false), d = __builtin_amdgcn_cvt_pk_f32_fp8(hi, true);
    u32x4 r; r.x = cvtpk(a[0], a[1]); r.y = cvtpk(b[0], b[1]); r.z = cvtpk(c[0], c[1]); r.w = cvtpk(d[0], d[1]); return r;
}
struct St { f32x16 o[2]; f32x16 ol; float m; };
DI void st_init(St& s) {
#pragma unroll
    for (int i = 0; i < 16; ++i) { s.o[0][i] = 0.f; s.o[1][i] = 0.f; s.ol[i] = 0.f; }
    s.m = -1e30f;
}

template <int NQ> DI void qk_tile(f32x16& p0, f32x16& p1, LAS const unsigned char* kt, const bf16x8 (&qf)[NQ], int r32, int hi, const f32x16& ci) {
    LAS const unsigned char* kb = kt + hi * KCS + r32 * 16;
    bf16x8 kf[2 * NQ];
#pragma unroll
    for (int d0 = 0; d0 < NQ; ++d0) { kf[2 * d0] = *(LAS const bf16x8*)(kb + d0 * 2 * KCS); kf[2 * d0 + 1] = *(LAS const bf16x8*)(kb + d0 * 2 * KCS + 512); }
    __builtin_amdgcn_sched_barrier(0);
    p0 = __builtin_amdgcn_mfma_f32_32x32x16_bf16(kf[0], qf[0], ci, 0, 0, 0);
    p1 = __builtin_amdgcn_mfma_f32_32x32x16_bf16(kf[1], qf[0], ci, 0, 0, 0);
#pragma unroll
    for (int d0 = 1; d0 < NQ; ++d0) {
        p0 = __builtin_amdgcn_mfma_f32_32x32x16_bf16(kf[2 * d0], qf[d0], p0, 0, 0, 0);
        p1 = __builtin_amdgcn_mfma_f32_32x32x16_bf16(kf[2 * d0 + 1], qf[d0], p1, 0, 0, 0);
    }
    __builtin_amdgcn_sched_barrier(0);
}
template <int NQ> DI void qk_tile_lean(f32x16& p0, f32x16& p1, LAS const unsigned char* kt, const bf16x8 (&qf)[NQ], int r32, int hi, const f32x16& ci) {
    LAS const unsigned char* kb = kt + hi * KCS + r32 * 16;
#pragma unroll
    for (int d0 = 0; d0 < NQ; ++d0) {
        const bf16x8 k0 = *(LAS const bf16x8*)(kb + d0 * 2 * KCS), k1 = *(LAS const bf16x8*)(kb + d0 * 2 * KCS + 512);
        __builtin_amdgcn_sched_barrier(0);
        if (d0 == 0) { p0 = __builtin_amdgcn_mfma_f32_32x32x16_bf16(k0, qf[0], ci, 0, 0, 0); p1 = __builtin_amdgcn_mfma_f32_32x32x16_bf16(k1, qf[0], ci, 0, 0, 0); }
        else { p0 = __builtin_amdgcn_mfma_f32_32x32x16_bf16(k0, qf[d0], p0, 0, 0, 0); p1 = __builtin_amdgcn_mfma_f32_32x32x16_bf16(k1, qf[d0], p1, 0, 0, 0); }
        __builtin_amdgcn_sched_barrier(0);
    }
}
template <bool MMASUM = true> DI float softmax_tile(St& s, f32x16& p0, f32x16& p1, float c, bf16x8 (&pa)[4], bool row_on) {
    float mx = fmaxf(p0[0], p1[0]);
#pragma unroll
    for (int i = 1; i < 16; ++i) mx = __builtin_fmaxf(__builtin_fmaxf(p0[i], p1[i]), mx);
    mx = xhalf_max(mx);
    if (!row_on) mx = -INFINITY;
    const float mn = fmaxf(s.m, mx);
    const float alpha = __builtin_amdgcn_exp2f((s.m - mn) * c);
    s.m = mn;
    const float nmc = row_on ? -mn * c : -INFINITY;
#pragma unroll
    for (int i = 0; i < 16; ++i) { p0[i] = __builtin_amdgcn_exp2f(fmaf(p0[i], c, nmc)); p1[i] = __builtin_amdgcn_exp2f(fmaf(p1[i], c, nmc)); }
    if (!__all(alpha == 1.f)) {
#pragma unroll
        for (int i = 0; i < 16; ++i) { s.o[0][i] *= alpha; s.o[1][i] *= alpha; s.ol[i] *= alpha; }
    }
    u32x4 w;
    w.x = cvtpk(p0[0], p0[1]); w.y = cvtpk(p0[2], p0[3]); w.z = cvtpk(p0[4], p0[5]); w.w = cvtpk(p0[6], p0[7]); pa[0] = __builtin_bit_cast(bf16x8, w);
    w.x = cvtpk(p0[8], p0[9]); w.y = cvtpk(p0[10], p0[11]); w.z = cvtpk(p0[12], p0[13]); w.w = cvtpk(p0[14], p0[15]); pa[1] = __builtin_bit_cast(bf16x8, w);
    w.x = cvtpk(p1[0], p1[1]); w.y = cvtpk(p1[2], p1[3]); w.z = cvtpk(p1[4], p1[5]); w.w = cvtpk(p1[6], p1[7]); pa[2] = __builtin_bit_cast(bf16x8, w);
    w.x = cvtpk(p1[8], p1[9]); w.y = cvtpk(p1[10], p1[11]); w.z = cvtpk(p1[12], p1[13]); w.w = cvtpk(p1[14], p1[15]); pa[3] = __builtin_bit_cast(bf16x8, w);
    if constexpr (MMASUM) {
        const bf16x8 ones = {0x3F80, 0x3F80, 0x3F80, 0x3F80, 0x3F80, 0x3F80, 0x3F80, 0x3F80};
#pragma unroll
        for (int ks = 0; ks < 4; ++ks) s.ol = __builtin_amdgcn_mfma_f32_32x32x16_bf16(ones, pa[ks], s.ol, 0, 0, 0);
    } else {
        float sum = 0.f;
#pragma unroll
        for (int i = 0; i < 16; ++i) sum += p0[i] + p1[i];
        s.ol[0] += sum;
    }
    return alpha;
}
template <bool MMASUM> DI void softmax_ref(St& s, f32x16& p0, f32x16& p1, bf16x8 (&pa)[4]) {
#pragma unroll
    for (int i = 0; i < 16; ++i) { p0[i] = __builtin_amdgcn_exp2f(p0[i]); p1[i] = __builtin_amdgcn_exp2f(p1[i]); }
    u32x4 w;
    w.x = cvtpk(p0[0], p0[1]); w.y = cvtpk(p0[2], p0[3]); w.z = cvtpk(p0[4], p0[5]); w.w = cvtpk(p0[6], p0[7]); pa[0] = __builtin_bit_cast(bf16x8, w);
    w.x = cvtpk(p0[8], p0[9]); w.y = cvtpk(p0[10], p0[11]); w.z = cvtpk(p0[12], p0[13]); w.w = cvtpk(p0[14], p0[15]); pa[1] = __builtin_bit_cast(bf16x8, w);
    w.x = cvtpk(p1[0], p1[1]); w.y = cvtpk(p1[2], p1[3]); w.z = cvtpk(p1[4], p1[5]); w.w = cvtpk(p1[6], p1[7]); pa[2] = __builtin_bit_cast(bf16x8, w);
    w.x = cvtpk(p1[8], p1[9]); w.y = cvtpk(p1[10], p1[11]); w.z = cvtpk(p1[12], p1[13]); w.w = cvtpk(p1[14], p1[15]); pa[3] = __builtin_bit_cast(bf16x8, w);
    if constexpr (MMASUM) {
        const bf16x8 ones = {0x3F80, 0x3F80, 0x3F80, 0x3F80, 0x3F80, 0x3F80, 0x3F80, 0x3F80};
#pragma unroll
        for (int ks = 0; ks < 4; ++ks) s.ol = __builtin_amdgcn_mfma_f32_32x32x16_bf16(ones, pa[ks], s.ol, 0, 0, 0);
    } else {
        float sum = 0.f;
#pragma unroll
        for (int i = 0; i < 16; ++i) sum += p0[i] + p1[i];
        s.ol[0] += sum;
    }
}
DI void pv_tile(f32x16 (&o)[2], LAS const unsigned char* vt, const bf16x8 (&pa)[4], int lane) {
    const int hi = lane >> 5;
    LAS const unsigned char* vb = vt + ((lane >> 4) & 1) * 32 + (lane & 3) * 8 + (4 * hi + ((lane & 15) >> 2)) * 64;
#pragma unroll
    for (int d0 = 0; d0 < 2; ++d0) {
        v4i16 lo[4], hv[4];
#pragma unroll
        for (int ks = 0; ks < 4; ++ks) {
            lo[ks] = __builtin_amdgcn_ds_read_tr16_b64_v4i16((LAS v4i16*)(vb + d0 * 4 * VPS + ks * VPS));
            hv[ks] = __builtin_amdgcn_ds_read_tr16_b64_v4i16((LAS v4i16*)(vb + d0 * 4 * VPS + ks * VPS + 512));
        }
        __builtin_amdgcn_sched_barrier(0);
#pragma unroll
        for (int ks = 0; ks < 4; ++ks) {
            const bf16x8 vf = (bf16x8){lo[ks][0], lo[ks][1], lo[ks][2], lo[ks][3], hv[ks][0], hv[ks][1], hv[ks][2], hv[ks][3]};
            o[d0] = __builtin_amdgcn_mfma_f32_32x32x16_bf16(vf, pa[ks], o[d0], 0, 0, 0);
        }
        __builtin_amdgcn_sched_barrier(0);
    }
}
template <int NQ, int VAR = 0> DI void fused_step(f32x16& n0, f32x16& n1, LAS const unsigned char* kt, const bf16x8 (&qf)[NQ], int r32, int hi, const f32x16& ci, f32x16& c0, f32x16& c1,
                                     St& st, LAS const unsigned char* vt, int lane) {
    LAS const unsigned char* kb = kt + hi * KCS + r32 * 16;
    LAS const unsigned char* vb = vt + ((lane >> 4) & 1) * 32 + (lane & 3) * 8 + (4 * hi + ((lane & 15) >> 2)) * 64;
    constexpr int M = 2 * NQ, W = 4, NOP = 64, VG = M - 2;
    bf16x8 kf[M];
    if (!(VAR & 16)) {
#pragma unroll
    for (int g = 0; g < W; ++g) kf[g] = *(LAS const bf16x8*)(kb + (g >> 1) * 2 * KCS + (g & 1) * 512);
    }
    __builtin_amdgcn_sched_barrier(0);
    unsigned pw[16];
    f32x2_t acc = {st.ol[0], st.ol[1]};
    v4i16 lo0[4], hv0[4], lo1[4], hv1[4];
#pragma unroll
    for (int g = 0; g < M; ++g) {
        if (g + W < M && !(VAR & 16)) kf[g + W] = *(LAS const bf16x8*)(kb + ((g + W) >> 1) * 2 * KCS + ((g + W) & 1) * 512);
        if (g == VG && !(VAR & 2)) {
#pragma unroll
            for (int ks = 0; ks < 4; ++ks) {
                lo0[ks] = __builtin_amdgcn_ds_read_tr16_b64_v4i16((LAS v4i16*)(vb + ks * VPS));
                hv0[ks] = __builtin_amdgcn_ds_read_tr16_b64_v4i16((LAS v4i16*)(vb + ks * VPS + 512));
            }
        }
        if (!(VAR & 16)) {
        if (g & 1) n1 = __builtin_amdgcn_mfma_f32_32x32x16_bf16(kf[g], qf[g >> 1], g == 1 ? ci : n1, 0, 0, 0);
        else       n0 = __builtin_amdgcn_mfma_f32_32x32x16_bf16(kf[g], qf[g >> 1], g == 0 ? ci : n0, 0, 0, 0);
        } else if (g < 2) { if (g & 1) n1 = ci; else n0 = ci; }
#pragma unroll
        for (int i = (g * NOP) / M; i < ((g + 1) * NOP) / M; ++i) {
            if (VAR & 1) { if (i < 16) pw[i] = 0x3F803F80u; continue; }
            const int blk = i >> 4, w = i & 15;
            if (w < 8) { const int e = blk * 8 + w;
                if (e < 16) c0[e] = __builtin_amdgcn_exp2f(c0[e]); else c1[e - 16] = __builtin_amdgcn_exp2f(c1[e - 16]); }
            else { const int k = (w & 1) + 2 * ((w - 8) >> 2), e = blk * 8 + 2 * k;
                const float x = (e < 16) ? c0[e] : c1[e - 16], y = (e < 16) ? c0[e + 1] : c1[e - 15];
                if (((w - 8) & 2) == 0) { pw[blk * 4 + k] = cvtpk(x, y); asm volatile("" : "+v"(pw[blk * 4 + k])); }
                else { acc[0] += x; asm volatile("" : "+v"(acc[0])); acc[1] += y; asm volatile("" : "+v"(acc[1])); } }
        }
        __builtin_amdgcn_sched_barrier(0);
    }
    st.ol[0] = acc[0]; st.ol[1] = acc[1];
    bf16x8 pa[4];
#pragma unroll
    for (int b = 0; b < 4; ++b) { u32x4 w; w.x = pw[4 * b]; w.y = pw[4 * b + 1]; w.z = pw[4 * b + 2]; w.w = pw[4 * b + 3]; pa[b] = __builtin_bit_cast(bf16x8, w); }
    if (VAR & 2) return;
#pragma unroll
    for (int ks = 0; ks < 4; ++ks) {
        lo1[ks] = __builtin_amdgcn_ds_read_tr16_b64_v4i16((LAS v4i16*)(vb + 4 * VPS + ks * VPS));
        hv1[ks] = __builtin_amdgcn_ds_read_tr16_b64_v4i16((LAS v4i16*)(vb + 4 * VPS + ks * VPS + 512));
    }
    __builtin_amdgcn_sched_barrier(0);
#pragma unroll
    for (int ks = 0; ks < 4; ++ks) {
        const bf16x8 vf = (bf16x8){lo0[ks][0], lo0[ks][1], lo0[ks][2], lo0[ks][3], hv0[ks][0], hv0[ks][1], hv0[ks][2], hv0[ks][3]};
        st.o[0] = __builtin_amdgcn_mfma_f32_32x32x16_bf16(vf, pa[ks], st.o[0], 0, 0, 0);
    }
    __builtin_amdgcn_sched_barrier(0);
#pragma unroll
    for (int ks = 0; ks < 4; ++ks) {
        const bf16x8 vf = (bf16x8){lo1[ks][0], lo1[ks][1], lo1[ks][2], lo1[ks][3], hv1[ks][0], hv1[ks][1], hv1[ks][2], hv1[ks][3]};
        st.o[1] = __builtin_amdgcn_mfma_f32_32x32x16_bf16(vf, pa[ks], st.o[1], 0, 0, 0);
    }
    __builtin_amdgcn_sched_barrier(0);
}
template <int NQ, int VAR = 0> DI void fused3(f32x16& n0, f32x16& n1, LAS const unsigned char* kt, const bf16x8 (&qf)[NQ], int r32, int hi, const f32x16& ci, f32x16& c0, f32x16& c1,
                                             St& st, bf16x8 (&pa)[4], LAS const unsigned char* vt, int lane) {
    LAS const unsigned char* kb = kt + hi * KCS + r32 * 16;
    LAS const unsigned char* vb = vt + ((lane >> 4) & 1) * 32 + (lane & 3) * 8 + (4 * hi + ((lane & 15) >> 2)) * 64;
    constexpr int MQ = 2 * NQ, MT = MQ + 8, DL = 3, NOP2 = 48;
    bf16x8 kf[MQ];
    v4i16 lo[8], hv[8];
    unsigned pw[16];
    float s0 = st.ol[0], s1 = st.ol[1];
#define F3_FETCH(s) do { if ((s) < MT) { \
        if ((s) < 8) { if (!(VAR & 2)) { const int p_ = (s); lo[p_] = __builtin_amdgcn_ds_read_tr16_b64_v4i16((LAS v4i16*)(vb + (p_ >> 2) * 4 * VPS + (p_ & 3) * VPS)); \
                                                       hv[p_] = __builtin_amdgcn_ds_read_tr16_b64_v4i16((LAS v4i16*)(vb + (p_ >> 2) * 4 * VPS + (p_ & 3) * VPS + 512)); } } \
        else if (!(VAR & 16)) { const int g_ = (s) - 8; kf[g_] = *(LAS const bf16x8*)(kb + (g_ >> 1) * 2 * KCS + (g_ & 1) * 512); } } } while (0)
#pragma unroll
    for (int s = 0; s < DL; ++s) F3_FETCH(s);
    __builtin_amdgcn_s_setprio(1);
    __builtin_amdgcn_sched_barrier(0);
#pragma unroll
    for (int s = 0; s < MT; ++s) {
        F3_FETCH(s + DL);
        if (s < 8) {
            if (!(VAR & 2)) { const int p = s;
                const bf16x8 vf = (bf16x8){lo[p][0], lo[p][1], lo[p][2], lo[p][3], hv[p][0], hv[p][1], hv[p][2], hv[p][3]};
                if (p < 4) st.o[0] = __builtin_amdgcn_mfma_f32_32x32x16_bf16(vf, pa[p & 3], st.o[0], 0, 0, 0);
                else       st.o[1] = __builtin_amdgcn_mfma_f32_32x32x16_bf16(vf, pa[p & 3], st.o[1], 0, 0, 0); }
            if (!(VAR & 1)) {
#pragma unroll
                for (int w = 0; w < 4; ++w) { const int e = 4 * s + w;
                    if (e < 16) c0[e] = __builtin_amdgcn_exp2f(c0[e]); else c1[e - 16] = __builtin_amdgcn_exp2f(c1[e - 16]); }
            }
        } else { const int g = s - 8;
            if (!(VAR & 16)) {
                if (g & 1) n1 = __builtin_amdgcn_mfma_f32_32x32x16_bf16(kf[g], qf[g >> 1], g == 1 ? ci : n1, 0, 0, 0);
                else       n0 = __builtin_amdgcn_mfma_f32_32x32x16_bf16(kf[g], qf[g >> 1], g == 0 ? ci : n0, 0, 0, 0);
            } else if (g < 2) { if (g & 1) n1 = ci; else n0 = ci; }
#pragma unroll
            for (int i = (g * NOP2) / MQ; i < ((g + 1) * NOP2) / MQ; ++i) {
                if (VAR & 1) { if (i < 16) pw[i] = 0x3F803F80u; continue; }
                const int q = i / 3, r = i % 3, e = 2 * q;
                const float x = (e < 16) ? c0[e] : c1[e - 16], y = (e < 16) ? c0[e + 1] : c1[e - 15];
                if (r == 0) { pw[q] = cvtpk(x, y); asm volatile("" : "+v"(pw[q])); }
                else if (r == 1) { s0 += x; asm volatile("" : "+v"(s0)); }
                else { s1 += y; asm volatile("" : "+v"(s1)); }
            }
        }
        __builtin_amdgcn_sched_barrier(0);
    }
#undef F3_FETCH
    __builtin_amdgcn_s_setprio(0);
    st.ol[0] = s0; st.ol[1] = s1;
#pragma unroll
    for (int b = 0; b < 4; ++b) { u32x4 w; w.x = pw[4 * b]; w.y = pw[4 * b + 1]; w.z = pw[4 * b + 2]; w.w = pw[4 * b + 3]; pa[b] = __builtin_bit_cast(bf16x8, w); }
}
DI void softmax_pack(St& st, f32x16& p0, f32x16& p1, bf16x8 (&pa)[4]) {
#pragma unroll
    for (int i = 0; i < 16; ++i) { p0[i] = __builtin_amdgcn_exp2f(p0[i]); p1[i] = __builtin_amdgcn_exp2f(p1[i]); }
    u32x4 w;
    w.x = cvtpk(p0[0], p0[1]); w.y = cvtpk(p0[2], p0[3]); w.z = cvtpk(p0[4], p0[5]); w.w = cvtpk(p0[6], p0[7]); pa[0] = __builtin_bit_cast(bf16x8, w);
    w.x = cvtpk(p0[8], p0[9]); w.y = cvtpk(p0[10], p0[11]); w.z = cvtpk(p0[12], p0[13]); w.w = cvtpk(p0[14], p0[15]); pa[1] = __builtin_bit_cast(bf16x8, w);
    w.x = cvtpk(p1[0], p1[1]); w.y = cvtpk(p1[2], p1[3]); w.z = cvtpk(p1[4], p1[5]); w.w = cvtpk(p1[6], p1[7]); pa[2] = __builtin_bit_cast(bf16x8, w);
    w.x = cvtpk(p1[8], p1[9]); w.y = cvtpk(p1[10], p1[11]); w.z = cvtpk(p1[12], p1[13]); w.w = cvtpk(p1[14], p1[15]); pa[3] = __builtin_bit_cast(bf16x8, w);
    float s0 = 0.f, s1 = 0.f;
#pragma unroll
    for (int i = 0; i < 16; i += 2) { s0 += p0[i] + p1[i]; s1 += p0[i + 1] + p1[i + 1]; }
    st.ol[0] += s0; st.ol[1] += s1;
}
DI int k_lds_off(int key, int chunk) { return chunk * KCS + key * 16; }
DI int v_lds_off(int key, int c8) { return ((c8 >> 2) * 4 + (key >> 4)) * VPS + (key & 15) * 64 + (c8 & 3) * 16; }

constexpr int TEND = 1 << 20;
struct SeqRange { int j0, j1; DI int first() const { return j0 < j1 ? j0 : TEND; } DI int next(int j) const { return j + 1 < j1 ? j + 1 : TEND; } };
struct SeqMask { unsigned long long m;
    DI int first() const { return m ? (int)__builtin_ctzll(m) : TEND; }
    DI int next(int j) const { const unsigned long long r = (j >= 63) ? 0ull : (m >> (j + 1)); return r ? j + 1 + (int)__builtin_ctzll(r) : TEND; } };
template <int NQ, int VAR, class Src, class Mask, class Seq>
DI void run_stage(LAS unsigned char* lds, const Src& src, const Mask& mask, const Seq& seq, int jw0, int jw1, const bf16x8 (&qf)[NQ], St& st, int tid, int qpos) {
    int tk_ = tid; asm volatile("" : "+v"(tk_));
    const int lane = tk_ & 63, r32 = lane & 31, hi = lane >> 5;
    const int key = tk_ >> 3, ch = tk_ & 7;
    u32x4 rk, rk2, rv;
    rk2 = (u32x4){0u, 0u, 0u, 0u};
#ifdef PROBE_PM
    const int pm_ = *(LAS const int*)(lds + PM_OFF);
#else
    constexpr int pm_ = -1;
#endif
    auto gloadK = [&](int j) {
        const int kpos = (64 * j + key) & pm_;
        rk = *(const u32x4*)(src.krow(kpos) + ch * 8);
        if (NQ == 6 && ch < 4) rk2 = *(const u32x4*)(src.krow2(kpos) + ch * 8);
    };
    auto gloadV = [&](int j) { rv = *(const u32x4*)(src.vrow((64 * j + key) & pm_) + ch * 8); };
    auto storeK = [&](int buf) {
        *(LAS u32x4*)(lds + KBUF + buf * KBUF_SZ + k_lds_off(key, ch)) = rk;
        if (NQ == 6 && ch < 4) *(LAS u32x4*)(lds + KBUF + buf * KBUF_SZ + k_lds_off(key, 8 + ch)) = rk2;
    };
    auto storeV = [&](int buf) { *(LAS u32x4*)(lds + VBUF + buf * VBUF_SZ + v_lds_off(key, ch)) = rv; };
    int j = seq.first();
    if (j == TEND) return;
    int j1 = seq.next(j);
    gloadK(j); storeK(0);
    if (j1 != TEND) { gloadK(j1); storeK(1); }
    { unsigned z0_ = 0u; asm volatile("" : "+v"(z0_)); *(LAS u32x4*)(lds + VBUF + VBUF_SZ + v_lds_off(key, ch)) = (u32x4){z0_, z0_, z0_, z0_}; }
    __syncthreads();
    f32x16 sa0, sa1, sb0, sb1;
    f32x16 negm;
#pragma unroll
    for (int i = 0; i < 16; ++i) { sa0[i] = 0.f; sa1[i] = 0.f; sb0[i] = 0.f; sb1[i] = 0.f; negm[i] = 0.f; }
    bf16x8 pA[4];
#pragma unroll
    for (int i = 0; i < 4; ++i) pA[i] = (bf16x8){0, 0, 0, 0, 0, 0, 0, 0};
    bool a_prev = false;
    bool have_ref = false;
    st.m = 0.f;
    bool a_cur = (j >= jw0 && j < jw1 && !mask.skip(j));
#define FA_ESTABLISH(P0, P1, KT, JJ) do { \
        { const f32x16 ci = mask.cinit(negm, JJ); qk_tile_lean<NQ>(P0, P1, KT, qf, r32, hi, ci); } \
        mask.apply(P0, P1, JJ, qpos, hi); \
        float mx = fmaxf(P0[0], P1[0]); \
        _Pragma("unroll") for (int i = 1; i < 16; ++i) mx = __builtin_fmaxf(__builtin_fmaxf(P0[i], P1[i]), mx); \
        mx = xhalf_max(mx); \
        const float mref = (mx > -3.0e38f) ? mx : 0.f; \
        _Pragma("unroll") for (int i = 0; i < 16; ++i) { negm[i] = -mref; P0[i] -= mref; P1[i] -= mref; } \
        st.m = mref; have_ref = true; } while (0)
    if (a_cur) FA_ESTABLISH(sa0, sa1, lds + KBUF, j);
    __syncthreads();
    int pb = 0;
#define FA_STEP(C0, C1, N0, N1) do { \
        const int j2 = (j1 != TEND) ? seq.next(j1) : TEND; \
        if (!(VAR & 4)) { if (j2 != TEND) gloadK(j2); \
        gloadV(j); } \
        const bool a_next = (j1 != TEND) && (j1 >= jw0 && j1 < jw1 && !mask.skip(j1)); \
        if (a_cur) {     \
            mask.apply(C0, C1, j, qpos, hi); \
            const f32x16 ci = mask.cinit(negm, j1); \
            fused3<NQ, VAR>(N0, N1, lds + KBUF + (pb ^ 1) * KBUF_SZ, qf, r32, hi, ci, C0, C1, st, pA, lds + VBUF + (pb ^ 1) * VBUF_SZ, lane); \
        } else { \
            if (a_next) { \
                if (!have_ref) FA_ESTABLISH(N0, N1, lds + KBUF + (pb ^ 1) * KBUF_SZ, j1); \
                else { const f32x16 ci = mask.cinit(negm, j1); qk_tile<NQ>(N0, N1, lds + KBUF + (pb ^ 1) * KBUF_SZ, qf, r32, hi, ci); } } \
            if (a_prev) pv_tile(st.o, lds + VBUF + (pb ^ 1) * VBUF_SZ, pA, lane); \
            _Pragma("unroll") for (int i = 0; i < 4; ++i) pA[i] = (bf16x8){0, 0, 0, 0, 0, 0, 0, 0}; \
        } \
        if (!(VAR & 4)) { if (j2 != TEND) storeK(pb); \
        storeV(pb); } \
        if (!(VAR & 8)) __syncthreads(); \
        a_prev = a_cur; a_cur = a_next; j = j1; j1 = j2; pb ^= 1; } while (0)
    for (;;) {
        FA_STEP(sa0, sa1, sb0, sb1); if (j == TEND) break;
        FA_STEP(sb0, sb1, sa0, sa1); if (j == TEND) break;
    }
    if (a_prev) pv_tile(st.o, lds + VBUF + (pb ^ 1) * VBUF_SZ, pA, lane);
    __syncthreads();
#undef FA_STEP
#undef FA_ESTABLISH
    st.ol[0] = xhalf_sum(st.ol[0] + st.ol[1]);
}
DI void dma16(const bf16_t* gsrc, LAS const unsigned char* dst) {
    const unsigned m0v = (unsigned)(size_t)dst;
    asm volatile("s_mov_b32 m0, %1\n\ts_nop 0\n\tglobal_load_lds_dwordx4 %0, off" :: "v"(gsrc), "s"(m0v) : "memory", "m0");
}
template <int NQ, int VAR, class Src, class Mask, class Seq>
DI void run_stage_dma(LAS unsigned char* lds, const Src& src, const Mask& mask, const Seq& seq, int jw0, int jw1, const bf16x8 (&qf)[NQ], St& st, int tid, int qpos) {
    constexpr int KTS = 2 * NQ * KCS, VTS = 8 * VPS, VB0 = 3 * KTS;
    static_assert(NQ == 6 || VB0 + 3 * VTS <= IMP_OFF, "64-dim rings stay below the importance / gated-sum region");
    int tk_ = tid; asm volatile("" : "+v"(tk_));
    const int lane = tk_ & 63, r32 = lane & 31, hi = lane >> 5;
    const int w = __builtin_amdgcn_readfirstlane(tk_ >> 6);
    const bf16_t* const kl_ = src.krow(lane) + w * 8;
    const bf16_t* const rl_ = src.krow2(lane) + w * 8;
    const bf16_t* const vl_ = src.vrow(16 * (w & 3) + (lane >> 2)) + (w >> 2) * 32 + (lane & 3) * 8;
    auto dmaK = [&](int jt, int buf) {
        dma16(kl_ + (size_t)jt * (64 * Src::KST), lds + buf * KTS + w * KCS);
        if (NQ == 6 && w < 4) dma16(rl_ + (size_t)jt * (64 * Src::K2ST), lds + buf * KTS + (8 + w) * KCS);
    };
    auto dmaV = [&](int jt, int buf) { dma16(vl_ + (size_t)jt * (64 * Src::VST), lds + VB0 + buf * VTS + w * VPS); };
    int j = seq.first();
    if (j == TEND) return;
    int j1 = seq.next(j);
    int j2 = (j1 != TEND) ? seq.next(j1) : TEND;
    dmaK(j, 0); dmaK(j1 != TEND ? j1 : j, 1); dmaK(j2 != TEND ? j2 : j, 2); dmaV(j, 0);
    asm volatile("s_waitcnt vmcnt(0)" ::: "memory");
    __syncthreads();
    f32x16 sa0, sa1, sb0, sb1;
    f32x16 negm;
#pragma unroll
    for (int i = 0; i < 16; ++i) { sa0[i] = 0.f; sa1[i] = 0.f; sb0[i] = 0.f; sb1[i] = 0.f; negm[i] = 0.f; }
    bf16x8 pA[4];
#pragma unroll
    for (int i = 0; i < 4; ++i) pA[i] = (bf16x8){0, 0, 0, 0, 0, 0, 0, 0};
    bool a_prev = false, have_ref = false;
    st.m = 0.f;
    bool a_cur = (j >= jw0 && j < jw1 && !mask.skip(j));
#define FA_ESTABLISH(P0, P1, KT, JJ) do { \
        { const f32x16 ci = mask.cinit(negm, JJ); qk_tile_lean<NQ>(P0, P1, KT, qf, r32, hi, ci); } \
        mask.apply(P0, P1, JJ, qpos, hi); \
        float mx = fmaxf(P0[0], P1[0]); \
        _Pragma("unroll") for (int i = 1; i < 16; ++i) mx = __builtin_fmaxf(__builtin_fmaxf(P0[i], P1[i]), mx); \
        mx = xhalf_max(mx); \
        const float mref = (mx > -3.0e38f) ? mx : 0.f; \
        _Pragma("unroll") for (int i = 0; i < 16; ++i) { negm[i] = -mref; P0[i] -= mref; P1[i] -= mref; } \
        st.m = mref; have_ref = true; } while (0)
    if (a_cur) FA_ESTABLISH(sa0, sa1, lds, j);
    asm volatile("s_waitcnt lgkmcnt(0)" ::: "memory");
    __builtin_amdgcn_s_barrier();
    int ic = 0, in1 = 1, ip = 2;
    bool first = true;
#define FA_STEP(C0, C1, N0, N1) do { \
        const int j3 = (j2 != TEND) ? seq.next(j2) : TEND; \
        dmaK(j3 != TEND ? j3 : j, ic); \
        dmaV(j1 != TEND ? j1 : j, in1); \
        const bool a_next = (j1 != TEND) && (j1 >= jw0 && j1 < jw1 && !mask.skip(j1)); \
        LAS const unsigned char* kn_ = lds + in1 * KTS; \
        LAS const unsigned char* vp_ = lds + VB0 + (first ? ic : ip) * VTS;     \
        if (a_cur) { \
            mask.apply(C0, C1, j, qpos, hi); \
            const f32x16 ci = mask.cinit(negm, j1); \
            fused3<NQ, VAR>(N0, N1, kn_, qf, r32, hi, ci, C0, C1, st, pA, vp_, lane); \
        } else { \
            if (a_next) { \
                if (!have_ref) FA_ESTABLISH(N0, N1, kn_, j1); \
                else { const f32x16 ci = mask.cinit(negm, j1); qk_tile<NQ>(N0, N1, kn_, qf, r32, hi, ci); } } \
            if (a_prev) pv_tile(st.o, vp_, pA, lane); \
            _Pragma("unroll") for (int i = 0; i < 4; ++i) pA[i] = (bf16x8){0, 0, 0, 0, 0, 0, 0, 0}; \
        } \
        if (NQ == 6 && w < 4) asm volatile("s_waitcnt vmcnt(3) lgkmcnt(0)" ::: "memory"); else asm volatile("s_waitcnt vmcnt(2) lgkmcnt(0)" ::: "memory");     \
        __builtin_amdgcn_s_barrier();     \
        a_prev = a_cur; a_cur = a_next; j = j1; j1 = j2; j2 = j3; first = false; \
        { const int t_ = ic; ic = in1; in1 = ip; ip = t_; } } while (0)
    for (;;) {
        FA_STEP(sa0, sa1, sb0, sb1); if (j == TEND) break;
        FA_STEP(sb0, sb1, sa0, sa1); if (j == TEND) break;
    }
    if (a_prev) pv_tile(st.o, lds + VB0 + ip * VTS, pA, lane);
    asm volatile("s_waitcnt vmcnt(0)" ::: "memory");
    __syncthreads();
#undef FA_STEP
#undef FA_ESTABLISH
    st.ol[0] = xhalf_sum(st.ol[0] + st.ol[1]);
}
template <int NQ, int VAR, class Src, class Mask, class Seq>
DI void run_stage2(LAS unsigned char* lds, const Src& src, const Mask& mask, const Seq& seq, int jw0, int jw1, const bf16x8 (&qf)[NQ], St& st, int tid, int qpos) {
    const int lane = tid & 63, r32 = lane & 31, hi = lane >> 5;
    int tk_ = tid; asm volatile("" : "+v"(tk_));
    const int key = tk_ >> 3, ch = tk_ & 7;
    u32x4 rk, rk2, rv;
    rk2 = (u32x4){0u, 0u, 0u, 0u};
    auto gloadK = [&](int j) {
        const int kpos = 64 * j + key;
        rk = *(const u32x4*)(src.krow(kpos) + ch * 8);
        if (NQ == 6 && ch < 4) rk2 = *(const u32x4*)(src.krow2(kpos) + ch * 8);
    };
    auto gloadV = [&](int j) { rv = *(const u32x4*)(src.vrow(64 * j + key) + ch * 8); };
    auto storeK = [&](int buf) {
        *(LAS u32x4*)(lds + KBUF + buf * KBUF_SZ + k_lds_off(key, ch)) = rk;
        if (NQ == 6 && ch < 4) *(LAS u32x4*)(lds + KBUF + buf * KBUF_SZ + k_lds_off(key, 8 + ch)) = rk2;
    };
    auto storeV = [&](int buf) { *(LAS u32x4*)(lds + VBUF + buf * VBUF_SZ + v_lds_off(key, ch)) = rv; };
    int j = seq.first();
    if (j == TEND) return;
    int j1 = seq.next(j);
    gloadK(j); gloadV(j); storeK(0); storeV(0);
    if (j1 != TEND) { gloadK(j1); storeK(1); }
    __syncthreads();
    f32x16 sa0, sa1, sb0, sb1;
    f32x16 negm;
#pragma unroll
    for (int i = 0; i < 16; ++i) { sa0[i] = 0.f; sa1[i] = 0.f; sb0[i] = 0.f; sb1[i] = 0.f; negm[i] = 0.f; }
    bool have_ref = false;
    st.m = 0.f;
    bool a_cur = (j >= jw0 && j < jw1 && !mask.skip(j));
#define FA_ESTABLISH(P0, P1, KT, JJ) do { \
        { const f32x16 ci = mask.cinit(negm, JJ); qk_tile_lean<NQ>(P0, P1, KT, qf, r32, hi, ci); } \
        mask.apply(P0, P1, JJ, qpos, hi); \
        float mx = fmaxf(P0[0], P1[0]); \
        _Pragma("unroll") for (int i = 1; i < 16; ++i) mx = __builtin_fmaxf(__builtin_fmaxf(P0[i], P1[i]), mx); \
        mx = xhalf_max(mx); \
        const float mref = (mx > -3.0e38f) ? mx : 0.f; \
        _Pragma("unroll") for (int i = 0; i < 16; ++i) { negm[i] = -mref; P0[i] -= mref; P1[i] -= mref; } \
        st.m = mref; have_ref = true; } while (0)
    if (a_cur) FA_ESTABLISH(sa0, sa1, lds + KBUF, j);
    __syncthreads();
    int pb = 0;
#define FA_STEP(C0, C1, N0, N1) do { \
        const int j2 = (j1 != TEND) ? seq.next(j1) : TEND; \
        if (!(VAR & 4)) { if (j2 != TEND) gloadK(j2); \
        if (j1 != TEND) gloadV(j1); } \
        const bool a_next = (j1 != TEND) && (j1 >= jw0 && j1 < jw1 && !mask.skip(j1)); \
        if (a_cur) {     \
            mask.apply(C0, C1, j, qpos, hi); \
            const f32x16 ci = mask.cinit(negm, j1); \
            fused_step<NQ, VAR>(N0, N1, lds + KBUF + (pb ^ 1) * KBUF_SZ, qf, r32, hi, ci, C0, C1, st, lds + VBUF + pb * VBUF_SZ, lane); \
        } else if (a_next) { \
            if (!have_ref) FA_ESTABLISH(N0, N1, lds + KBUF + (pb ^ 1) * KBUF_SZ, j1); \
            else { const f32x16 ci = mask.cinit(negm, j1); qk_tile<NQ>(N0, N1, lds + KBUF + (pb ^ 1) * KBUF_SZ, qf, r32, hi, ci); } } \
        if (!(VAR & 4)) { if (j2 != TEND) storeK(pb); \
        if (j1 != TEND) storeV(pb ^ 1); } \
        if (!(VAR & 8)) __syncthreads(); \
        a_cur = a_next; j = j1; j1 = j2; pb ^= 1; } while (0)
    for (;;) {
        FA_STEP(sa0, sa1, sb0, sb1); if (j == TEND) break;
        FA_STEP(sb0, sb1, sa0, sa1); if (j == TEND) break;
    }
#undef FA_STEP
#undef FA_ESTABLISH
    st.ol[0] = xhalf_sum(st.ol[0] + st.ol[1]);
}
struct MaskBand { int maxd;
    DI bool skip(int) const { return false; }
    DI bool rowon(int) const { return true; }
    DI const f32x16& cinit(const f32x16& negm, int) const { return negm; }
    DI void apply(f32x16& p0, f32x16& p1, int j, int qpos, int hi) const {
        const int kb = 64 * j + 4 * hi, q0 = qpos & ~31;
        if (64 * j + 63 <= q0 && q0 + 31 - (64 * j) <= maxd) return;
        int db = qpos - kb; asm volatile("" : "+v"(db));
#pragma unroll
        for (int r = 0; r < 16; ++r) { const int cr = (r & 3) + 8 * (r >> 2);
            if (db < cr || db > maxd + cr) p0[r] = -INFINITY; if (db < cr + 32 || db > maxd + cr + 32) p1[r] = -INFINITY; }
    } };
constexpr int RT_V = 8 * KCS, RT_TILE = 8 * KCS + 8 * VPS;
static_assert(7 * RT_TILE <= SELM_OFF, "resident tiles (and the one-tile lookahead read past them) stay below the control words");
template <int VAR>
DI void resident_walk(LAS unsigned char* lds, int maxd, int jt0, int jt1, int jw0, int jw1, const bf16x8 (&qf)[4], St& st, int tid, int qpos) {
    int tk_ = tid; asm volatile("" : "+v"(tk_));
    const int lane = tk_ & 63, r32 = lane & 31, hi = lane >> 5;
    const int ja = jt0 > jw0 ? jt0 : jw0, jb = jt1 < jw1 ? jt1 : jw1;
    st.m = 0.f;
    if (ja < jb) {
        const MaskBand mask{maxd};
        f32x16 sa0, sa1, sb0, sb1, negm;
#pragma unroll
        for (int i = 0; i < 16; ++i) { sb0[i] = 0.f; sb1[i] = 0.f; negm[i] = 0.f; }
        bf16x8 pA[4];
#pragma unroll
        for (int i = 0; i < 4; ++i) pA[i] = (bf16x8){0, 0, 0, 0, 0, 0, 0, 0};
        { qk_tile_lean<4>(sa0, sa1, lds + (ja - jt0) * RT_TILE, qf, r32, hi, negm);
          mask.apply(sa0, sa1, ja, qpos, hi);
          float mx = fmaxf(sa0[0], sa1[0]);
#pragma unroll
          for (int i = 1; i < 16; ++i) mx = __builtin_fmaxf(__builtin_fmaxf(sa0[i], sa1[i]), mx);
          mx = xhalf_max(mx);
          const float mref = (mx > -3.0e38f) ? mx : 0.f;
#pragma unroll
          for (int i = 0; i < 16; ++i) { negm[i] = -mref; sa0[i] -= mref; sa1[i] -= mref; }
          st.m = mref; }
        int j = ja;
#define RT_STEP(C0, C1, N0, N1) do { \
            mask.apply(C0, C1, j, qpos, hi); \
            const int jp = (j > ja) ? j - 1 : ja; \
            fused3<4, VAR>(N0, N1, lds + (j + 1 - jt0) * RT_TILE, qf, r32, hi, negm, C0, C1, st, pA, lds + (jp - jt0) * RT_TILE + RT_V, lane); \
            ++j; } while (0)
        for (;;) {
            RT_STEP(sa0, sa1, sb0, sb1); if (j == jb) break;
            RT_STEP(sb0, sb1, sa0, sa1); if (j == jb) break;
        }
#undef RT_STEP
        pv_tile(st.o, lds + (jb - 1 - jt0) * RT_TILE + RT_V, pA, lane);
    }
}
template <int VAR, class Src>
DI void run_resident(LAS unsigned char* lds, const Src& src, int maxd, int jt0, int jt1, int jw0, int jw1, const bf16x8 (&qf)[4], St& st, int tid, int qpos) {
    int tk_ = tid; asm volatile("" : "+v"(tk_));
    const int lane = tk_ & 63, r32 = lane & 31, hi = lane >> 5;
    const int key = tk_ >> 3, ch = tk_ & 7;
    const int nt = jt1 - jt0;
    { unsigned long long rkk[6], rvv[6];
#pragma unroll
      for (int t = 0; t < 6; ++t) if (t < nt) { const int kpos = 64 * (jt0 + t) + key; rkk[t] = *(const unsigned long long*)(src.krow(kpos) + ch * 8); rvv[t] = *(const unsigned long long*)(src.vrow(kpos) + ch * 8); }
#pragma unroll
      for (int t = 0; t < 6; ++t) if (t < nt) { *(LAS u32x4*)(lds + t * RT_TILE + k_lds_off(key, ch)) = fp8x8_to_bf16x8(rkk[t]); *(LAS u32x4*)(lds + t * RT_TILE + RT_V + v_lds_off(key, ch)) = fp8x8_to_bf16x8(rvv[t]); } }
    __syncthreads();
    resident_walk<VAR>(lds, maxd, jt0, jt1, jw0, jw1, qf, st, tid, qpos);
    __syncthreads();
    st.ol[0] = xhalf_sum(st.ol[0] + st.ol[1]);
}
struct SrcMla { const bf16_t* kvu; const bf16_t* ua; int b, h;
    DI const bf16_t* krow(int kpos) const { return kvu + (size_t)(b * S + kpos) * 1024 + h * 128; }
    DI const bf16_t* vrow(int kpos) const { return kvu + (size_t)(b * S + kpos) * 1024 + h * 128 + 64; }
    DI const bf16_t* krow2(int kpos) const { return ua + (size_t)(b * S + kpos) * LDA + A_BKR; }
    static constexpr int KST = 1024, K2ST = LDA, VST = 1024; };

constexpr int OT_PITCH = 144, OT_WAVE = 32 * OT_PITCH;
static_assert(8 * OT_WAVE <= VBUF + 2 * VBUF_SZ, "output images fit in the staging buffers");
DI void tile_rows_out(LAS unsigned char* wl, int lane_, bf16_t* out0, size_t rstride) {
    int lane = lane_; asm volatile("" : "+v"(lane));
#pragma unroll
    for (int k = 0; k < 4; ++k) { const int row = (lane >> 3) + 8 * k;
        const u32x4 v = *(LAS const u32x4*)(wl + row * OT_PITCH + (lane & 7) * 16);
        *(u32x4*)(out0 + (size_t)row * rstride + (lane & 7) * 8) = v; }
}
DI void store_o(const f32x16 (&o)[2], float inv, LAS unsigned char* wl, int lane, bf16_t* out0, size_t rstride) {
    const int r32 = lane & 31, hi = lane >> 5;
#pragma unroll
    for (int d0 = 0; d0 < 2; ++d0)
#pragma unroll
        for (int i = 0; i < 4; ++i) {
            const unsigned lo = cvtpk(o[d0][4 * i] * inv, o[d0][4 * i + 1] * inv), hv = cvtpk(o[d0][4 * i + 2] * inv, o[d0][4 * i + 3] * inv);
            *(LAS unsigned long long*)(wl + r32 * OT_PITCH + (32 * d0 + 8 * i + 4 * hi) * 2) = (unsigned long long)lo | ((unsigned long long)hv << 32);
        }
    tile_rows_out(wl, lane, out0, rstride);
}
DI void gated_store(const f32x16 (&o)[2], float scale, const bf16_t* zrow, LAS unsigned char* wl, int lane, bf16_t* out0, size_t rstride) {
    const int r32 = lane & 31, hi = lane >> 5;
    unsigned long long zw[2][4];
#pragma unroll
    for (int d0 = 0; d0 < 2; ++d0)
#pragma unroll
        for (int i = 0; i < 4; ++i) zw[d0][i] = *(const unsigned long long*)(zrow + 32 * d0 + 8 * i + 4 * hi);
#pragma unroll
    for (int d0 = 0; d0 < 2; ++d0)
#pragma unroll
        for (int i = 0; i < 4; ++i) {
            const unsigned long long w = zw[d0][i];
            const float z0 = bflo((unsigned)w), z1 = bfhi((unsigned)w), z2 = bflo((unsigned)(w >> 32)), z3 = bfhi((unsigned)(w >> 32));
            const unsigned lo = cvtpk(o[d0][4 * i] * scale * z0 * sigf(z0), o[d0][4 * i + 1] * scale * z1 * sigf(z1)), hv = cvtpk(o[d0][4 * i + 2] * scale * z2 * sigf(z2), o[d0][4 * i + 3] * scale * z3 * sigf(z3));
            *(LAS unsigned long long*)(wl + r32 * OT_PITCH + (32 * d0 + 8 * i + 4 * hi) * 2) = (unsigned long long)lo | ((unsigned long long)hv << 32);
        }
    tile_rows_out(wl, lane, out0, rstride);
}
template <int VAR = 0> DI unsigned unit_mla(LAS unsigned char* lds, int tid, int b, int h, int qblk, const bf16_t* qm, const bf16_t* kvu, const bf16_t* ua, const bf16_t* ub, bf16_t* ob, unsigned* qctr) {
    const int lane = tid & 63, r32 = lane & 31, hi = lane >> 5, wave = __builtin_amdgcn_readfirstlane(tid >> 6);
    const int q0 = 256 * qblk + 32 * wave, qpos = q0 + r32;
    const bf16_t* qrow = qm + (size_t)(b * S + qpos) * 768 + h * 96;
    bf16x8 qf[6];
#pragma unroll
    for (int d0 = 0; d0 < 6; ++d0) qf[d0] = *(const bf16x8*)(qrow + d0 * 16 + hi * 8);
    St st; st_init(st);
    SrcMla src{kvu, ua, b, h};
    MaskBand mk{1 << 30};
    run_stage_dma<6, VAR>(lds, src, mk, SeqRange{0, 4 * qblk + 4}, 0, (q0 + 31) / 64 + 1, qf, st, tid, qpos);
    unsigned nxt_ = 0u;
    if (tid == 0) nxt_ = atomicAdd(qctr, 1u);
    const float lt = st.ol[0], inv = __builtin_amdgcn_rcpf(lt);
    const bf16_t* zrow = ub + (size_t)(b * S + qpos) * LDB + B_ZB + h * 64;
    if (!(VAR & 32)) gated_store(st.o, inv, zrow, lds + wave * OT_WAVE, lane, ob + (size_t)(b * S + q0) * 512 + h * 64, 512);
    return nxt_;
}
struct SrcDil { const unsigned char* kv;  int dil;
    DI const unsigned char* krow(int kpos) const { return kv + (size_t)kpos * dil * KV8_LD; }
    DI const unsigned char* vrow(int kpos) const { return kv + (size_t)kpos * dil * KV8_LD + 64; } };
template <int VAR = 0> DI unsigned unit_dil(LAS unsigned char* lds, int tid, int gi, int b, int h, int r, int qblk, const bf16_t* ua, const unsigned char* kv8, bf16_t* od, float* lse, unsigned* qctr) {
    const int lane = tid & 63, r32 = lane & 31, hi = lane >> 5, wave = __builtin_amdgcn_readfirstlane(tid >> 6);
    const int dil = (gi == 0) ? 1 : (gi == 1) ? 4 : 16;
    const int q0 = 256 * qblk + 32 * wave, qpos = q0 + r32;
    const bf16_t* base = ua + (size_t)(b * S + r) * LDA + A_CQKV + gi * 1536 + h * 64;
    const size_t tok = (size_t)b * S + (size_t)qpos * dil + r;
    const bf16_t* qrow = base + (size_t)qpos * dil * LDA;
    bf16x8 qf[4];
#pragma unroll
    for (int d0 = 0; d0 < 4; ++d0) qf[d0] = *(const bf16x8*)(qrow + d0 * 16 + hi * 8);
    St st; st_init(st);
    SrcDil src{kv8 + (size_t)(b * S + r) * KV8_LD + gi * 1024 + h * 128, dil};
    MaskBand mk{128};
    const int jt0 = (4 * qblk - 2) > 0 ? (4 * qblk - 2) : 0, jw0 = ((q0 - 128) >> 6) > 0 ? ((q0 - 128) >> 6) : 0;
    run_resident<VAR>(lds, src, 128, jt0, 4 * qblk + 4, jw0, (q0 + 31) / 64 + 1, qf, st, tid, qpos);
    unsigned nxt_ = 0u;
    if (tid == 0) nxt_ = atomicAdd(qctr, 1u);
    const float lt = st.ol[0];
    if (!(VAR & 32)) store_o(st.o, __builtin_amdgcn_rcpf(lt), lds + wave * OT_WAVE, lane, od + ((size_t)b * S + (size_t)q0 * dil + r) * 512 + h * 64, (size_t)dil * 512);
    if (hi == 0) lse[tok * 8 + h] = st.m * 0.6931471805599453f + __logf(lt);
    return nxt_;
}
template <int VAR = 0> DI void dil_chain(LAS unsigned char* lds, int tid, int id, const bf16_t* ua, const unsigned char* kv8, bf16_t* o7, float* lse_base, unsigned* qctr, LAS unsigned* wq) {
    const int lane = tid & 63, r32 = lane & 31, hi = lane >> 5, wave = __builtin_amdgcn_readfirstlane(tid >> 6);
    const int key = tid >> 3, ch = tid & 7;
    unsigned tick = 0u;
    if (tid == 0) tick = atomicAdd(qctr, 1u);
    unsigned long long rkk[6], rvv[6];
    bf16x8 qf[4], qn[4];
    int gi, b, h, r, qblk, dil;
#define DC_DECODE(ID) do { const int e_ = (ID) - 1024; gi = e_ >> 9; dil = (gi == 0) ? 1 : (gi == 1) ? 4 : 16; const int bh_ = e_ & 31, rest_ = (e_ >> 5) & 15; b = bh_ >> 3; h = bh_ & 7; r = rest_ % dil; qblk = rest_ / dil; } while (0)
#define DC_ISSUE(QF) do { \
        const bf16_t* qrow_ = ua + (size_t)(b * S + r) * LDA + A_CQKV + gi * 1536 + h * 64 + (size_t)(256 * qblk + 32 * wave + r32) * dil * LDA; \
        _Pragma("unroll") for (int d0 = 0; d0 < 4; ++d0) QF[d0] = *(const bf16x8*)(qrow_ + d0 * 16 + hi * 8); \
        const unsigned char* kv_ = kv8 + (size_t)(b * S + r) * KV8_LD + gi * 1024 + h * 128 + ch * 8; \
        const int jt0_ = (4 * qblk - 2) > 0 ? (4 * qblk - 2) : 0, nt_ = 4 * qblk + 4 - jt0_; \
        _Pragma("unroll") for (int t = 0; t < 6; ++t) if (t < nt_) { const unsigned char* p_ = kv_ + (size_t)(64 * (jt0_ + t) + key) * dil * KV8_LD; \
            rkk[t] = *(const unsigned long long*)p_; rvv[t] = *(const unsigned long long*)(p_ + 64); } } while (0)
    DC_DECODE(id);
    DC_ISSUE(qf);
    for (unsigned it = 0;; ++it) {
        const int q0 = 256 * qblk + 32 * wave, qpos = q0 + r32;
        const int jt0 = (4 * qblk - 2) > 0 ? (4 * qblk - 2) : 0, jt1 = 4 * qblk + 4, nt = jt1 - jt0, jw0 = ((q0 - 128) >> 6) > 0 ? ((q0 - 128) >> 6) : 0, jw1 = (q0 + 31) / 64 + 1;
        const size_t tok = (size_t)b * S + (size_t)qpos * dil + r;
        bf16_t* od0 = o7 + (size_t)(gi == 0 ? 2 : gi == 1 ? 5 : 6) * ((size_t)T * 512) + ((size_t)b * S + (size_t)q0 * dil + r) * 512 + h * 64;
        float* lsep = lse_base + (size_t)gi * T * 8 + tok * 8 + h;
        const size_t rstride = (size_t)dil * 512;
        __syncthreads();
#pragma unroll
        for (int t = 0; t < 6; ++t) if (t < nt) { *(LAS u32x4*)(lds + t * RT_TILE + k_lds_off(key, ch)) = fp8x8_to_bf16x8(rkk[t]); *(LAS u32x4*)(lds + t * RT_TILE + RT_V + v_lds_off(key, ch)) = fp8x8_to_bf16x8(rvv[t]); }
        if (tid == 0) wq[it & 1u] = tick;
        __syncthreads();
        const int idn = __builtin_amdgcn_readfirstlane((int)wq[it & 1u]);
        const bool more = idn < 2560;
        if (more) { DC_DECODE(idn); DC_ISSUE(qn); if (tid == 0) tick = atomicAdd(qctr, 1u); }
        St st; st_init(st);
        resident_walk<VAR>(lds, 128, jt0, jt1, jw0, jw1, qf, st, tid, qpos);
        __syncthreads();
        const float lt = xhalf_sum(st.ol[0] + st.ol[1]);
        if (!(VAR & 32)) store_o(st.o, __builtin_amdgcn_rcpf(lt), lds + wave * OT_WAVE, lane, od0, rstride);
        if (hi == 0) *lsep = st.m * 0.6931471805599453f + __logf(lt);
        if (!more) break;
#pragma unroll
        for (int d0 = 0; d0 < 4; ++d0) qf[d0] = qn[d0];
    }
#undef DC_ISSUE
#undef DC_DECODE
}
struct MaskSel { unsigned lo, hi32;
    DI bool bit(int j) const { return ((j < 32 ? lo >> j : hi32 >> (j - 32)) & 1u) != 0u; }
    DI bool skip(int j) const { return !__any(bit(j)); }
    DI bool rowon(int j) const { return bit(j); }
    DI f32x16 cinit(const f32x16& negm, int j) const { f32x16 r; const bool on = bit(j);
#pragma unroll
        for (int i = 0; i < 16; ++i) r[i] = on ? negm[i] : -INFINITY;
        return r; }
    DI void apply(f32x16& p0, f32x16& p1, int j, int qpos, int hi) const {
        if (64 * j + 63 <= (qpos & ~31)) return;
        const int kb = 64 * j + 4 * hi;
        int db = qpos - kb; asm volatile("" : "+v"(db));
#pragma unroll
        for (int r = 0; r < 16; ++r) { const int cr = (r & 3) + 8 * (r >> 2);
            if (db < cr) p0[r] = -INFINITY; if (db < cr + 32) p1[r] = -INFINITY; }
    } };
struct SrcAkv { const bf16_t* base;
    DI const bf16_t* krow(int kpos) const { return base + (size_t)kpos * LDA; }
    DI const bf16_t* vrow(int kpos) const { return base + (size_t)kpos * LDA + 128; }
    DI const bf16_t* krow2(int) const { return base; }
    static constexpr int KST = LDA, K2ST = 0, VST = LDA; };

template <int VAR = 0> DI unsigned unit_nsa(LAS unsigned char* lds, int tid, int b, int hk, int qb, const bf16_t* ua, const bf16_t* ub, const bf16_t* kc, bf16_t* oa, unsigned* qctr) {
    const int lane = tid & 63, r32 = lane & 31, hi = lane >> 5, wave = __builtin_amdgcn_readfirstlane(tid >> 6);
    const int g = wave >> 1, half = wave & 1, hq = hk * 4 + g;
    const int q0 = 64 * qb + 32 * half, qpos = q0 + r32;
    const size_t tok = (size_t)b * S + qpos;
    auto tokf = [&]() { int q_ = qpos; asm volatile("" : "+v"(q_)); return (size_t)b * S + q_; };
    bf16x8 qf[4];
    { const bf16_t* qrow = ua + tok * LDA + A_AQ + hq * 64;
#pragma unroll
      for (int d0 = 0; d0 < 4; ++d0) qf[d0] = *(const bf16x8*)(qrow + d0 * 16 + hi * 8); }
    unsigned short gw0, gw1, gw2;
    { const bf16_t* gp = ub + tok * LDB + B_GATE + hq * 3; gw0 = gp[0]; gw1 = gp[1]; gw2 = gp[2]; }
    const float c = 1.f;
    LAS float* oaccl = (LAS float*)(lds + IMP_OFF) + wave * 2048 + lane;
    f32x16 ocmp[2];
    {
        St st; st_init(st);
        f32x16 o2[2];
#pragma unroll
        for (int i = 0; i < 16; ++i) { o2[0][i] = 0.f; o2[1][i] = 0.f; }
        const int ntile = (VAR & 128) ? 0 : ((4 * qb + 2) >> 6) + 1;
        const int key = tid >> 3, ch = tid & 7;
        u32x4 rk, rv;
        { const int cc = key < NC ? key : NC - 1; const bf16_t* kr = kc + ((size_t)(b * NC + cc) * 2 + hk) * 64;
          rk = *(const u32x4*)(kr + ch * 8); rv = *(const u32x4*)(kr + (size_t)CROWS * 64 + ch * 8); }
        for (int t = 0; t < ntile; ++t) {
            const int cidx = 64 * t + key;
            *(LAS u32x4*)(lds + KBUF + k_lds_off(key, ch)) = rk;
            *(LAS u32x4*)(lds + VBUF + v_lds_off(key, ch)) = rv;
            if (t + 1 < ntile) {
                const int cn = cidx + 64, cc = cn < NC ? cn : NC - 1; const bf16_t* kr = kc + ((size_t)(b * NC + cc) * 2 + hk) * 64;
                rk = *(const u32x4*)(kr + ch * 8); rv = *(const u32x4*)(kr + (size_t)CROWS * 64 + ch * 8); }
            {
              const int jb = cidx >> 2, e3 = cidx & 3; unsigned short w[8];
#pragma unroll
              for (int e = 0; e < 8; ++e) { const int j = 8 * ch + e; w[e] = (cidx >= NC) ? 0 : (j == jb) ? (e3 < 3 ? 0x3F80 : 0x3F00) : (j == jb + 1 && e3 == 3) ? 0x3F00 : 0; }
              u32x4 ov; ov.x = w[0] | ((unsigned)w[1] << 16); ov.y = w[2] | ((unsigned)w[3] << 16); ov.z = w[4] | ((unsigned)w[5] << 16); ov.w = w[6] | ((unsigned)w[7] << 16);
              *(LAS u32x4*)(lds + OVBUF + v_lds_off(key, ch)) = ov; }
            __syncthreads();
            {
                f32x16 p0, p1; bf16x8 pa[4];
                { const f32x16 z16 = {0.f, 0.f, 0.f, 0.f, 0.f, 0.f, 0.f, 0.f, 0.f, 0.f, 0.f, 0.f, 0.f, 0.f, 0.f, 0.f}; qk_tile<4>(p0, p1, lds + KBUF, qf, r32, hi, z16); }
                int db = qpos - 31 - 16 * (64 * t + 4 * hi); asm volatile("" : "+v"(db));
#pragma unroll
                for (int r = 0; r < 16; ++r) { const int cr = (r & 3) + 8 * (r >> 2);
                    if (db < 16 * cr) p0[r] = -INFINITY; if (db < 16 * (cr + 32)) p1[r] = -INFINITY; }
                const float alpha = softmax_tile(st, p0, p1, c, pa, true);
#pragma unroll
                for (int i = 0; i < 16; ++i) { o2[0][i] *= alpha; o2[1][i] *= alpha; }
                pv_tile(st.o, lds + VBUF, pa, lane);
                pv_tile(o2, lds + OVBUF, pa, lane);
            }
            __syncthreads();
        }
        const float lt = st.ol[0], inv = lt > 0.f ? __builtin_amdgcn_rcpf(lt) : 0.f;
        const float g0 = sigf(bf2f(gw0)) * inv;
        { int t_ = tid; asm volatile("" : "+v"(t_)); LAS float* gl = (LAS float*)(lds + GATE_OFF) + 2 * t_; gl[0] = sigf(bf2f(gw1)); gl[1] = sigf(bf2f(gw2)); }
#pragma unroll
        for (int i = 0; i < 16; ++i) { ocmp[0][i] = st.o[0][i] * g0; ocmp[1][i] = st.o[1][i] * g0; }
        LAS float* imp = (LAS float*)(lds + IMP_OFF) + (g * 64 + 32 * half + r32) * IMP_LD;
#pragma unroll
        for (int d0 = 0; d0 < 2; ++d0)
#pragma unroll
            for (int r = 0; r < 16; ++r) imp[32 * d0 + crow(r, hi)] = o2[d0][r] * inv;
    }
    __syncthreads();
    {
        LAS const float* impb = (LAS const float*)(lds + IMP_OFF);
        unsigned long long uw = 0ull;
        int ln = lane; asm volatile("" : "+v"(ln));
        const bool valid = ln <= qb, forced = (ln == 0) || (ln == qb) || (ln == qb - 1);
        unsigned kv[8], thr[8];
#pragma unroll
        for (int i = 0; i < 8; ++i) { const int tk = wave * 8 + i;
            float v = impb[(0 * 64 + tk) * IMP_LD + ln]; v += impb[(1 * 64 + tk) * IMP_LD + ln]; v += impb[(2 * 64 + tk) * IMP_LD + ln]; v += impb[(3 * 64 + tk) * IMP_LD + ln];
            kv[i] = forced ? 0x7FFFFFFFu : (valid ? __float_as_uint(v) + 1u : 0u); thr[i] = 0u; }
        if (!(VAR & 64)) {
#pragma clang loop unroll(disable)
            for (int bit = 30; bit >= 0; --bit) {
#pragma unroll
                for (int i = 0; i < 8; ++i) { const unsigned cand = thr[i] | (1u << bit); if (__builtin_popcountll(__ballot(kv[i] >= cand)) >= 16) thr[i] = cand; }
            }
        }
#pragma unroll
        for (int i = 0; i < 8; ++i) { const int tk = wave * 8 + i;
            const unsigned long long gt = __ballot(kv[i] > thr[i]), eq = __ballot(kv[i] == thr[i]);
            const int below = (int)__builtin_amdgcn_mbcnt_hi((unsigned)(eq >> 32), __builtin_amdgcn_mbcnt_lo((unsigned)eq, 0u));
            const bool sel = (kv[i] > thr[i]) || (kv[i] == thr[i] && (int)__builtin_popcountll(gt) + below < 16);
            const unsigned long long m = __ballot(sel && valid);
            if (lane == 0) *(LAS unsigned long long*)(lds + SELM_OFF + 8 * tk) = m;
            uw |= m;
        }
        if (lane == 0) *(LAS unsigned long long*)(lds + UNI_OFF + 8 * wave) = uw;
    }
    __syncthreads();
#pragma unroll
    for (int i = 0; i < 16; ++i) { oaccl[i * 64] = ocmp[0][i]; oaccl[(16 + i) * 64] = ocmp[1][i]; }
    {
        St st; st_init(st);
        const unsigned long long m = *(LAS const unsigned long long*)(lds + SELM_OFF + 8 * (32 * half + r32));
        unsigned long long um = 0ull;
#pragma unroll
        for (int w8 = 0; w8 < 8; ++w8) um |= *(LAS const unsigned long long*)(lds + UNI_OFF + 8 * w8);
        um = ((unsigned long long)__builtin_amdgcn_readfirstlane((unsigned)(um >> 32)) << 32) | (unsigned)__builtin_amdgcn_readfirstlane((unsigned)um);
        MaskSel mk{(unsigned)m, (unsigned)(m >> 32)};
        SrcAkv src{ua + (size_t)b * S * LDA + A_AKV + 2 * 128 + hk * 64};
        run_stage_dma<4, VAR>(lds, src, mk, SeqMask{um}, 0, qb + 1, qf, st, tid, qpos);
        const float lt = st.ol[0];
        float g1; { int t_ = tid; asm volatile("" : "+v"(t_)); g1 = ((LAS const float*)(lds + GATE_OFF))[2 * t_] * __builtin_amdgcn_rcpf(lt); }
#pragma unroll
        for (int i = 0; i < 16; ++i) { oaccl[i * 64] += st.o[0][i] * g1; oaccl[(16 + i) * 64] += st.o[1][i] * g1; }
    }
    unsigned nxt_ = 0u;
    if (tid == 0) nxt_ = atomicAdd(qctr, 1u);
    {
        f32x16 oacc[2];
        St st; st_init(st);
        MaskBand mk{511};
        SrcAkv src{ua + (size_t)b * S * LDA + A_AKV + 4 * 128 + hk * 64};
        const int jt0 = qb > 8 ? qb - 8 : 0;
        int jw0 = (q0 - 511) >> 6; jw0 = jw0 > jt0 ? jw0 : jt0;
        run_stage_dma<4, VAR>(lds, src, mk, SeqRange{jt0, qb + 1}, jw0, qb + 1, qf, st, tid, qpos);
        const float lt = st.ol[0];
        float g2; { int t_ = tid; asm volatile("" : "+v"(t_)); g2 = ((LAS const float*)(lds + GATE_OFF))[2 * t_ + 1] * __builtin_amdgcn_rcpf(lt); }
#pragma unroll
        for (int i = 0; i < 16; ++i) { oacc[0][i] = oaccl[i * 64] + st.o[0][i] * g2; oacc[1][i] = oaccl[(16 + i) * 64] + st.o[1][i] * g2; }
        if (!(VAR & 32)) { const size_t t3 = tokf(); gated_store(oacc, 1.f, ub + t3 * LDB + B_ZA + hq * 64, lds + wave * OT_WAVE, lane, oa + ((size_t)b * S + q0) * 512 + hq * 64, 512); }
    }
    return nxt_;
}
}
#define XB_TMO      128
#define XB_XCNT(j)  (256  + 64 * (j))
#define XB_XSUB(j)  (1280 + 64 * (j))
#define XB_XGEN(j)  (2304 + 64 * (j))
#define XB_TOP      3328
#define XB_TOPGEN   3392
#define XCD_BAR_WORDS 3456
#define XB_SPIN_CAP (1u << 18)

__device__ __forceinline__ unsigned xb_ld(unsigned* p)              { return __hip_atomic_load(p, __ATOMIC_RELAXED, __HIP_MEMORY_SCOPE_AGENT); }
__device__ __forceinline__ unsigned xb_add(unsigned* p, unsigned v) { return __hip_atomic_fetch_add(p, v, __ATOMIC_RELAXED, __HIP_MEMORY_SCOPE_AGENT); }
__device__ __forceinline__ unsigned xb_xcc_id() { return (unsigned)__builtin_amdgcn_s_getreg((3 << 11) | 20) & 0xFu; }
#define XB_SPIN(cond, bar) do { unsigned _sp = 0; while (cond) { __builtin_amdgcn_s_sleep(1); \
    if ((++_sp & 255u) == 0u) { if (xb_ld(&(bar)[XB_TMO])) break; if (_sp > XB_SPIN_CAP) { atomicAdd(&(bar)[XB_TMO], 1u); break; } } } } while (0)

struct XcdBarrier {
    unsigned* bar; unsigned x;
    volatile LAS unsigned* st;
};

__device__ __forceinline__ XcdBarrier xcd_barrier_post(unsigned* bar, volatile LAS unsigned* st) {
    XcdBarrier b; b.bar = bar; b.x = xb_xcc_id(); b.st = st;
    if (threadIdx.x == 0) (void)xb_add(&bar[XB_XCNT(b.x)], 1u);
    return b;
}
__device__ __forceinline__ void xcd_barrier_complete(unsigned* bar, unsigned x, unsigned& nloc, unsigned& nx) {
    const unsigned G = gridDim.x * gridDim.y * gridDim.z;
    unsigned sum, cnt, mine, sp = 0u;
    for (;;) {
        sum = 0u; cnt = 0u; mine = 0u;
#pragma unroll
        for (unsigned j = 0; j < 16; ++j) { const unsigned c = xb_ld(&bar[XB_XCNT(j)]); sum += c; cnt += (c > 0u) ? 1u : 0u; mine = (j == x) ? c : mine; }
        if (sum == G) break;
        __builtin_amdgcn_s_sleep(1);
        if ((++sp & 255u) == 0u) { if (xb_ld(&bar[XB_TMO])) break; if (sp > XB_SPIN_CAP) { atomicAdd(&bar[XB_TMO], 1u); break; } }
    }
    nloc = mine > 0u ? mine : 1u; nx = cnt > 0u ? cnt : 1u;
}

__device__ __forceinline__ void xcd_barrier(const XcdBarrier& b) {
    asm volatile("s_waitcnt vmcnt(0)" ::: "memory");
    __syncthreads();
    if (threadIdx.x == 0) {
        unsigned* bar = b.bar;
        __builtin_amdgcn_s_waitcnt(0);
        unsigned nloc = b.st[0], nx = b.st[1];
        if (nloc == 0u) { xcd_barrier_complete(bar, b.x, nloc, nx); b.st[0] = nloc; b.st[1] = nx; }
        const unsigned old = xb_add(&bar[XB_XSUB(b.x)], 1u);
        const unsigned gen = old / nloc;
        if (old + 1u == (gen + 1u) * nloc) {
            __builtin_amdgcn_fence(__ATOMIC_RELEASE, "agent");
            asm volatile("s_waitcnt vmcnt(0)" ::: "memory");
            const unsigned og = xb_add(&bar[XB_TOP], 1u);
            const unsigned tg = og / nx;
            if (og + 1u == (tg + 1u) * nx) xb_add(&bar[XB_TOPGEN], 1u);
            else XB_SPIN(xb_ld(&bar[XB_TOPGEN]) == tg, bar);
            __builtin_amdgcn_fence(__ATOMIC_ACQUIRE, "agent");
            xb_add(&bar[XB_XGEN(b.x)], 1u);
            asm volatile("s_waitcnt vmcnt(0)" ::: "memory");
        } else {
            XB_SPIN(xb_ld(&bar[XB_XGEN(b.x)]) == gen, bar);
            __builtin_amdgcn_fence(__ATOMIC_ACQUIRE, "agent");
            asm volatile("s_waitcnt vmcnt(0)" ::: "memory");
        }
    }
    __syncthreads();
}

enum { PH_CONV = 0, PH_WIN, PH_PREP, PH_G2, PH_KC, PH_ATT1, PH_COMB, PH_YABC, PH_WOUT, PH_PLE, PH_COUNT };
struct MArgs { const void* in[19]; float* out; unsigned char* ws; int ph_lo, ph_hi, l_lo, l_hi; };
static_assert(sizeof(MArgs) == 19 * 8 + 8 + 8 + 16, "no padding");

typedef __attribute__((address_space(4))) const char* kptr_t;
DI kptr_t kbase() { kptr_t p = (kptr_t)__builtin_amdgcn_kernarg_segment_ptr(); asm volatile("" : "+s"(p)); return p; }
template <typename Tp> DI Tp* kload_ptr(int off) { typedef Tp* ptr_t; typedef __attribute__((address_space(4))) const ptr_t* slot_t; return *(slot_t)(kbase() + off); }
DI int kload_int(int off) { typedef __attribute__((address_space(4))) const int* slot_t; return *(slot_t)(kbase() + off); }
#define KIN(type, i) kload_ptr<type>(8 * (i))
#define KOUT() kload_ptr<float>(152)
#define KWS() kload_ptr<unsigned char>(160)
#define KINT(off) kload_int(off)
#define WSP(type, off) ((type*)(KWS() + (off)))
#define WSETP(type, off) ((type*)(KWS() + WS_WSET + (size_t)(L & 1) * WSET_BYTES + (off)))

DI void grid_barrier(unsigned* barw) {
    extern __shared__ __attribute__((aligned(16))) unsigned char lds_raw[];
    XcdBarrier b; b.bar = barw; b.x = xb_xcc_id(); b.st = (volatile LAS unsigned*)((LAS unsigned char*)lds_raw + LDSCTL_OFF + 64);
    xcd_barrier(b);
}

__global__ void __launch_bounds__(NTHREADS, 2) mega(MArgs) {
    extern __shared__ __attribute__((aligned(16))) unsigned char lds_raw[];
    LAS unsigned char* lds = (LAS unsigned char*)lds_raw;
#define G ((int)gridDim.x)
#define bx ((int)blockIdx.x)
#define vcu ((G % 8 == 0) ? (bx % 8) * (G / 8) + bx / 8 : bx)
#define NGW (G * NWAVES)
    for (int u = threadIdx.x; u < (LDS_BYTES - LDSCTL_OFF) / 4; u += NTHREADS) ((LAS unsigned*)(lds + LDSCTL_OFF))[u] = 0u;
    __syncthreads();
    pg8::hw_tid_init(lds);
    __syncthreads();
    (void)xcd_barrier_post(WSP(unsigned, WS_CTL) + CW_BAR, (volatile LAS unsigned*)(lds + LDSCTL_OFF + 64));
#define GRID_BAR() grid_barrier(WSP(unsigned, WS_CTL) + CW_BAR)

#define IN(k) (KINT(168) <= (k) && (k) < KINT(172))
#define SEAM(k) do { if (IN(k) && (IN((k) + 1) || ((k) == PH_COUNT - 1 && L + 1 < KINT(180) && KINT(168) == 0))) GRID_BAR(); } while (0)

    for (int L = KINT(176); L < KINT(180); ++L) {
        if (IN(PH_CONV) && L == 0) {
            int tid_ = pg8::hw_tid(lds); asm volatile("" : "+v"(tid_)); const int tid = tid_, lane = tid & 63, wave = __builtin_amdgcn_readfirstlane(tid >> 6); const int gw = vcu * NWAVES + wave;
            for (int bi = vcu; bi < CB_TOTAL; bi += G) { conv_block_item(lds, tid, bi, 0, KWS() + WS_WSET); __syncthreads(); }
            { const int* pos = KIN(const int, 2); float* TAB = WSP(float, WS_TAB);
              for (int i = gw * 64 + lane; i < T * 24; i += NGW * 64) {
                  const int t = i / 24, j = i % 24; const float p = (float)pos[t];
                  if (j < 8) { const float a = p * powf(500000.0f, -(float)(2 * j) / 16.0f); TAB[(size_t)t * 48 + j] = cosf(a); TAB[(size_t)t * 48 + 8 + j] = sinf(a); }
                  else { const int jj = j - 8; const float a = p * powf(500000.0f, -(float)(2 * jj) / 32.0f); TAB[(size_t)t * 48 + 16 + jj] = cosf(a); TAB[(size_t)t * 48 + 32 + jj] = sinf(a); }
              } }
            { const float* x = KIN(const float, 0); bf16_t* XB2 = WSP(bf16_t, WS_XB2); float* SSQ = WSP(float, WS_SSQ);
              for (int m = gw; m < T; m += NGW) {
                  const f32x4* xr = (const f32x4*)(x + (size_t)m * D) + lane; unsigned long long* o8 = (unsigned long long*)(XB2 + (size_t)m * D) + lane; float s = 0.f;
#pragma unroll
                  for (int j = 0; j < 4; ++j) { const f32x4 v = xr[64 * j]; s += (v[0] * v[0] + v[1] * v[1]) + (v[2] * v[2] + v[3] * v[3]);
                      o8[64 * j] = (unsigned long long)pk2(v[0], v[1]) | ((unsigned long long)pk2(v[2], v[3]) << 32); }
                  s = wsum(s, lane);
                  if (lane < 4) SSQ[(size_t)m * 4 + lane] = (lane == 0) ? s : 0.f;
              } }
        }
        if (L == 0) SEAM(PH_CONV);
        if (IN(PH_WIN)) {
            {
              int tid_ = pg8::hw_tid(lds); asm volatile("" : "+v"(tid_));
              const float* SSQ = WSP(float, WS_SSQ) + (size_t)(bx & 7) * 2048 * 4; LAS float* rsl = (LAS float*)(lds + LDSCTL_OFF + 8192);
#pragma unroll
              for (int q = 0; q < 4; ++q) { const int r = q * 512 + tid_; const f32x4 a = *(const f32x4*)(SSQ + (size_t)r * 4); rsl[r] = rsqrtf(((a[0] + a[1]) + (a[2] + a[3])) * (1.f / 1024.f) + 1e-6f); }
              __syncthreads(); }
            pg8::Gemm g{WSP(bf16_t, WS_XB2), WSETP(bf16_t, WO_WIN), T, NPAD, D}; pg8::StaticOrder S; S.init(T, NPAD, G, bx);
            EpiWin Ep{WSP(bf16_t, WS_UA), WSP(bf16_t, WS_UB), WSP(float, WS_TAB), WSP(unsigned char, WS_KV8), (bf16_t*)(KWS() + WS_CTL + 917504)};
            pg8::gemm_phase<EpiWin, pg8::StaticOrder, true, true>(lds, g, S, Ep);
        }
        SEAM(PH_WIN);
        if (IN(PH_PREP)) {
            int tid_ = pg8::hw_tid(lds); asm volatile("" : "+v"(tid_)); const int tid = tid_, lane = tid & 63, wave = __builtin_amdgcn_readfirstlane(tid >> 6); const int gw = vcu * NWAVES + wave;
            { const bf16_t* UA = WSP(bf16_t, WS_UA); bf16_t* QN = WSP(bf16_t, WS_QN); bf16_t* KVN = WSP(bf16_t, WS_KVN);
              const float* gq = KIN(const float, 10) + (size_t)L * 384; const float* gkv = KIN(const float, 12) + (size_t)L * 128;
#pragma unroll 2
              for (int m = gw; m < T; m += NGW) {
                  const bool isq = lane < 48; const int e0 = isq ? lane * 8 : (lane - 48) * 8;
                  const u32x4 w = *(const u32x4*)(UA + (size_t)m * LDA + (isq ? A_BCQ : A_BCKV) + e0);
                  float v[8] = {bflo(w.x), bfhi(w.x), bflo(w.y), bfhi(w.y), bflo(w.z), bfhi(w.z), bflo(w.w), bfhi(w.w)};
                  float ss = 0.f;
#pragma unroll
                  for (int e = 0; e < 8; ++e) ss += v[e] * v[e];
                  const float sq = wsum(isq ? ss : 0.f, lane), sk = wsum(isq ? 0.f : ss, lane);
                  const float rs = isq ? rsqrtf(sq * (1.f / 384.f) + 1e-6f) : rsqrtf(sk * (1.f / 128.f) + 1e-6f);
                  const float* gp = (isq ? gq : gkv) + e0;
                  const f32x4 g0 = *(const f32x4*)gp, g1 = *(const f32x4*)(gp + 4);
                  u32x4 o; o.x = pk2(v[0] * rs * g0[0], v[1] * rs * g0[1]); o.y = pk2(v[2] * rs * g0[2], v[3] * rs * g0[3]); o.z = pk2(v[4] * rs * g1[0], v[5] * rs * g1[1]); o.w = pk2(v[6] * rs * g1[2], v[7] * rs * g1[3]);
                  if (isq) *(u32x4*)(QN + (size_t)m * 384 + e0) = o; else *(u32x4*)(KVN + (size_t)m * 128 + e0) = o;
              } }
            { const bf16_t* UA = WSP(bf16_t, WS_UA); bf16_t* FLAT = WSP(bf16_t, WS_FLAT); const float* pe = KIN(const float, 6) + (size_t)L * 2 * 32 * 64;
#pragma unroll 4
              for (int i = gw * 64 + lane; i < 2 * CROWS * 256; i += NGW * 64) {
                  const int kv = i / (CROWS * 256), rem = i % (CROWS * 256), row = rem >> 8, gcol = rem & 255, l = gcol >> 3, d = (gcol & 7) * 8;
                  u32x4 o = {0u, 0u, 0u, 0u};
                  if (row < NB * NC * 2) {
                      const int hk = row & 1, bc = row >> 1, b = bc / NC, c = bc % NC;
                      const u32x4 w = *(const u32x4*)(UA + (size_t)(b * S + 16 * c + l) * LDA + A_AKV + kv * 128 + hk * 64 + d);
                      const float* pp = pe + (kv * 32 + l) * 64 + d; const f32x4 p0 = *(const f32x4*)pp, p1 = *(const f32x4*)(pp + 4);
                      o.x = pk2(bflo(w.x) + p0[0], bfhi(w.x) + p0[1]); o.y = pk2(bflo(w.y) + p0[2], bfhi(w.y) + p0[3]); o.z = pk2(bflo(w.z) + p1[0], bfhi(w.z) + p1[1]); o.w = pk2(bflo(w.w) + p1[2], bfhi(w.w) + p1[3]);
                  }
                  *(u32x4*)(FLAT + ((size_t)(((gcol >> 6) * 2 + kv) * CROWS + row) * 512 + (gcol & 63) * 8)) = o;
              } }
        }
        SEAM(PH_PREP);
        if (IN(PH_G2)) {
            { pg8::Gemm g{WSP(bf16_t, WS_FLAT), WSETP(bf16_t, WO_W1), 8 * CROWS, 8 * 256, 512}; HidOrder S{G, bx};
              EpiF32<0> Ep{WSP(float, WS_HIDP), 256, 0};
              pg8::gemm_phase<EpiF32<0>, HidOrder, true, true>(lds, g, S, Ep); }
            __syncthreads();
            { pg8::Gemm g{WSP(bf16_t, WS_QN), WSETP(bf16_t, WO_WUQ), T, 768, 384}; pg8::StaticOrder S; S.init(T, 768, G, bx); EpiQm Ep{WSP(bf16_t, WS_QM), WSP(float, WS_TAB)};
              pg8::gemm_phase<EpiQm, pg8::StaticOrder, true, true>(lds, g, S, Ep); }
            __syncthreads();
            { pg8::Gemm g{WSP(bf16_t, WS_KVN), WSETP(bf16_t, WO_WUKV), T, 1024, 128}; pg8::StaticOrder S; S.init(T, 1024, G, bx); EpiBfPlain Ep{WSP(bf16_t, WS_KVU), 1024, 0};
              pg8::gemm_phase<EpiBfPlain, pg8::StaticOrder, true, true>(lds, g, S, Ep); }
            __syncthreads();
            { pg8::Gemm g{WSETP(bf16_t, WO_PBF), WSETP(bf16_t, WO_WPLE), T, D, 256}; pg8::StaticOrder S; S.init(T, D, G, bx); EpiBfPlain Ep{WSP(bf16_t, WS_EB), D, 0};
              pg8::gemm_phase<EpiBfPlain, pg8::StaticOrder, true, true>(lds, g, S, Ep); }
        }
        SEAM(PH_G2);
        if (IN(PH_KC)) {
            int tid_ = pg8::hw_tid(lds); asm volatile("" : "+v"(tid_)); const int tid = tid_, lane = tid & 63, wave = __builtin_amdgcn_readfirstlane(tid >> 6);
            const float* HIDP = WSP(float, WS_HIDP); bf16_t* KC = WSP(bf16_t, WS_KC);
            for (int blk = vcu; blk < 2 * CROWS / 16; blk += G) {
                const int kv = blk / (CROWS / 16);
                const float* w2 = KIN(const float, 8) + ((size_t)L * 2 + kv) * 256 * 64;
                for (int i = tid; i < 256 * 64 / 4; i += NTHREADS) *(LAS f32x4*)(lds + 16 * i) = *(const f32x4*)(w2 + 4 * i);
                LAS float* hrow = (LAS float*)(lds + 65536 + wave * 2048);
#pragma unroll
                for (int rr = 0; rr < 2; ++rr) {
                    const size_t r = (size_t)blk * 16 + wave * 2 + rr;
                    f32x4 h = *(const f32x4*)(HIDP + r * 256 + 4 * lane);
#pragma unroll
                    for (int ks = 1; ks < 4; ++ks) { const f32x4 q = *(const f32x4*)(HIDP + ((size_t)ks * 2 * CROWS + r) * 256 + 4 * lane); h = h + q; }
#pragma unroll
                    for (int e = 0; e < 4; ++e) h[e] = h[e] * sigf(h[e]);
                    *(LAS f32x4*)(hrow + rr * 256 + 4 * lane) = h;
                }
                __syncthreads();
                const LAS float* w2s = (const LAS float*)lds;
                float a0 = 0.f, a1 = 0.f;
#pragma unroll 8
                for (int k = 0; k < 256; ++k) { const float w = w2s[k * 64 + lane]; a0 += hrow[k] * w; a1 += hrow[256 + k] * w; }
                const size_t r0 = (size_t)blk * 16 + wave * 2;
                KC[r0 * 64 + lane] = f2bf(a0); KC[(r0 + 1) * 64 + lane] = f2bf(a1);
                __syncthreads();
            }
        }
        SEAM(PH_KC);
        if (IN(PH_ATT1)) {
            unsigned* qctr = WSP(unsigned, WS_CTL) + CW_QUEUE + 64 * L;
            LAS unsigned* wq = (LAS unsigned*)(lds + fa::WQ_OFF);
            unsigned nxt = 0u;
            if (pg8::hw_tid(lds) == 0) nxt = atomicAdd(qctr, 1u);
            for (unsigned it = 0;; ++it) {
                const int tid = pg8::hw_tid(lds);
                if (tid == 0) wq[it & 1u] = nxt;
                __syncthreads();
                const int id = (int)wq[it & 1u];
                if (id >= 2560) break;
                if (id < 1024) {
                    const int pb = id >> 5, r = id & 31;
                    const bool is_m = (pb >= 2) && ((pb == 31) || !(pb & 1));
                    const int gq = (pb < 2) ? pb : (pb == 31) ? 15 : (pb & 1) ? ((pb + 1) >> 1) : ((pb >> 1) - 1);
                    if (is_m) { const int bh = r;
                        nxt = fa::unit_mla(lds, tid, bh >> 3, bh & 7, 15 - gq, WSP(bf16_t, WS_QM), WSP(bf16_t, WS_KVU), WSP(bf16_t, WS_UA), WSP(bf16_t, WS_UB), WSP(bf16_t, WS_O7) + O7_STRIDE, qctr);
                    } else { const int k = r >> 3, bk = r & 7;
                        nxt = fa::unit_nsa(lds, tid, bk >> 1, bk & 1, 63 - 4 * gq - k, WSP(bf16_t, WS_UA), WSP(bf16_t, WS_UB), WSP(bf16_t, WS_KC), WSP(bf16_t, WS_O7), qctr); }
                } else {
                    fa::dil_chain(lds, tid, id, WSP(bf16_t, WS_UA), WSP(unsigned char, WS_KV8), WSP(bf16_t, WS_O7), WSP(float, WS_LSE), qctr, wq);
                    break;
                }
            }
        }
        SEAM(PH_ATT1);
        if (IN(PH_COMB)) {
            int tid_ = pg8::hw_tid(lds); asm volatile("" : "+v"(tid_)); const int tid = tid_, lane = tid & 63, wave = __builtin_amdgcn_readfirstlane(tid >> 6); const int gw = vcu * NWAVES + wave;
            bf16_t* O7 = WSP(bf16_t, WS_O7); const float* LSE = WSP(float, WS_LSE); const bf16_t* UB = WSP(bf16_t, WS_UB);
            bf16_t* od0 = O7 + 2 * O7_STRIDE; const bf16_t* od1 = O7 + 5 * O7_STRIDE; const bf16_t* od2 = O7 + 6 * O7_STRIDE;
#pragma unroll 4
            for (int i = gw * 64 + lane; i < T * 64; i += NGW * 64) {
                const int t = i >> 6, col = (i & 63) * 8, h = col >> 6;
                const float l0 = LSE[((size_t)0 * T + t) * 8 + h], l1 = LSE[((size_t)1 * T + t) * 8 + h], l2 = LSE[((size_t)2 * T + t) * 8 + h];
                const float mx = fmaxf(l0, fmaxf(l1, l2));
                float w0 = __expf(l0 - mx), w1 = __expf(l1 - mx), w2 = __expf(l2 - mx); const float iw = __builtin_amdgcn_rcpf(w0 + w1 + w2); w0 *= iw; w1 *= iw; w2 *= iw;
                const size_t o = (size_t)t * 512 + col;
                const u32x4 a = *(const u32x4*)(od0 + o), b = *(const u32x4*)(od1 + o), c = *(const u32x4*)(od2 + o), z = *(const u32x4*)(UB + (size_t)t * LDB + B_ZC + col);
                const unsigned aw[4] = {a.x, a.y, a.z, a.w}, bw[4] = {b.x, b.y, b.z, b.w}, cw[4] = {c.x, c.y, c.z, c.w}, zw[4] = {z.x, z.y, z.z, z.w}; unsigned ow[4];
#pragma unroll
                for (int e = 0; e < 4; ++e) { const float z0 = bflo(zw[e]), z1 = bfhi(zw[e]);
                    ow[e] = pk2((w0 * bflo(aw[e]) + w1 * bflo(bw[e]) + w2 * bflo(cw[e])) * z0 * sigf(z0), (w0 * bfhi(aw[e]) + w1 * bfhi(bw[e]) + w2 * bfhi(cw[e])) * z1 * sigf(z1)); }
                *(u32x4*)(od0 + o) = (u32x4){ow[0], ow[1], ow[2], ow[3]};
            }
            if (L + 1 < DEPTH) for (int bi = vcu; bi < CB_TOTAL; bi += G) { __syncthreads(); conv_block_item(lds, tid, bi, L + 1, KWS() + WS_WSET + (size_t)((L + 1) & 1) * WSET_BYTES); }
        }
        SEAM(PH_COMB);
        if (IN(PH_YABC)) {
            pg8::Gemm g{WSP(bf16_t, WS_O7), WSETP(bf16_t, WO_WABC), 3 * T, 3 * 1024, 512}; YabcOrder S{G, vcu};
            EpiYabc Ep{WSP(bf16_t, WS_YMIXB), WSP(bf16_t, WS_UB)};
            pg8::gemm_phase<EpiYabc, YabcOrder, true, true>(lds, g, S, Ep);
        }
        SEAM(PH_YABC);
        if (IN(PH_WOUT)) {
            pg8::Gemm g{WSP(bf16_t, WS_YMIXB), WSETP(bf16_t, WO_WOUT), T, D, D}; pg8::StaticOrder S; S.init(T, D, G, bx);
            EpiPost Ep{WSP(bf16_t, WS_XB2), KIN(const float, 4) + (size_t)L * D, WSP(bf16_t, WS_H), (unsigned long long*)(KWS() + WS_CTL + CTL_GRAN), (unsigned)(L + 1), 0};
            pg8::gemm_phase<EpiPost, pg8::StaticOrder, true, true>(lds, g, S, Ep);
        }
        SEAM(PH_WOUT);
        if (IN(PH_PLE)) {
            pg8::Gemm g{WSP(bf16_t, WS_H), WSETP(bf16_t, WO_WPLG), T, D, D}; pg8::StaticOrder S; S.init(T, D, G, bx); EpiPlgF Ep{WSP(bf16_t, WS_H), (L == DEPTH - 1) ? KOUT() : (float*)nullptr, WSP(bf16_t, WS_EB), WSP(bf16_t, WS_XB2), WSP(float, WS_SSQ)};
            pg8::gemm_phase<EpiPlgF, pg8::StaticOrder, true, true>(lds, g, S, Ep);
        }
        SEAM(PH_PLE);
    }
#undef IN
#undef SEAM
#undef G
#undef bx
#undef vcu
#undef NGW
}

static void launch_mega(hipStream_t st, void* const* d_in, void* d_out, void* d_ws, int ph_lo, int ph_hi, int l_lo, int l_hi) {
    MArgs a{};
    for (int i = 0; i < 19; ++i) a.in[i] = d_in[i];
    a.out = (float*)d_out; a.ws = (unsigned char*)d_ws; a.ph_lo = ph_lo; a.ph_hi = ph_hi; a.l_lo = l_lo; a.l_hi = l_hi;
    (void)hipMemsetAsync((char*)d_ws + WS_CTL, 0, 1 << 20, st);
    hipLaunchKernelGGL(mega, dim3(256), dim3(NTHREADS), LDS_BYTES, st, a);
}
extern "C" void kernel_launch(void* const* d_in, const int* in_sizes, int n_in, void* d_out, int out_size, void* d_ws, size_t ws_size, hipStream_t stream) {
    if (ws_size < WS_END2 || n_in != 19) return;
    (void)hipFuncSetAttribute((const void*)mega, hipFuncAttributeMaxDynamicSharedMemorySize, LDS_BYTES);
    launch_mega(stream, d_in, d_out, d_ws, 0, PH_COUNT, 0, DEPTH);
}
```
